# Optimizing an MI355X kernel written in HIP

```python
import math
import jax
import jax.numpy as jnp
from jax import lax
import numpy as np

D_MODEL = 1024
BATCH = 2
SEQ = 8192
DEPTH = 2

ROPE_THETA = 10000.0
NORM_EPS = 1e-6
Q_BLOCK = 128

DIFF_HEADS = 4
DIFF_HEAD_DIM = 64
DIFF_QK_WIDTH = DIFF_HEADS * 2 * DIFF_HEAD_DIM
DIFF_WIDTH = DIFF_HEADS * 2 * DIFF_HEAD_DIM
DIFF_SUBLN_EPS = 1e-5

MLA_HEADS = 4
MLA_NOPE_DIM = 64
MLA_ROPE_DIM = 32
MLA_V_DIM = 64
MLA_Q_RANK = 256
MLA_KV_RANK = 128
MLA_WIDTH = MLA_HEADS * MLA_V_DIM

RET_HEADS = 4
RET_QK_DIM = 64
RET_V_DIM = 64
RET_CHUNK = 128
RET_QK_WIDTH = RET_HEADS * RET_QK_DIM
RET_WIDTH = RET_HEADS * RET_V_DIM
RET_GN_EPS = 1e-6

MIX_WIDTH = DIFF_WIDTH + MLA_WIDTH + RET_WIDTH

IN_SIZES = (DIFF_QK_WIDTH, DIFF_QK_WIDTH, DIFF_WIDTH,
            MLA_Q_RANK, MLA_KV_RANK, MLA_ROPE_DIM,
            RET_QK_WIDTH, RET_QK_WIDTH, RET_WIDTH, RET_WIDTH)
IN_COLS = sum(IN_SIZES)

FFN_HIDDEN = -(-8 * D_MODEL // (3 * 256)) * 256

kernel_name = "hybrid_diff_mla_retention_block"


def _rms_norm(t, gain, eps=NORM_EPS):
    t32 = t.astype(jnp.float32)
    t32 = t32 * lax.rsqrt(jnp.mean(t32 * t32, axis=-1, keepdims=True) + eps)
    return t32.astype(t.dtype) * gain


def _rope_tables(positions, dim, dtype):
    inv_freq = 1.0 / (ROPE_THETA ** (jnp.arange(0, dim, 2, dtype=jnp.float32) / dim))
    ang = positions.astype(jnp.float32)[:, :, None] * inv_freq
    return (jnp.cos(ang)[:, :, None, :].astype(dtype),
            jnp.sin(ang)[:, :, None, :].astype(dtype))


def _apply_rope(t, cos, sin):
    t1, t2 = jnp.split(t, 2, axis=-1)
    return jnp.concatenate([t1 * cos - t2 * sin, t2 * cos + t1 * sin], axis=-1)


def _split_cols(t):
    out = []
    start = 0
    for n in IN_SIZES:
        out.append(t[..., start:start + n])
        start += n
    return out


def _sweep_query_blocks(block_fn, *qs):
    b, s = qs[0].shape[:2]
    nb = s // Q_BLOCK

    def to_blocks(t):
        return jnp.moveaxis(t.reshape((b, nb, Q_BLOCK) + t.shape[2:]), 1, 0)

    def body(args):
        return block_fn(args[0] * Q_BLOCK, *args[1:])

    out = lax.map(body, (jnp.arange(nb), *[to_blocks(t) for t in qs]))
    out = jnp.moveaxis(out, 0, 1)
    return out.reshape((b, s) + out.shape[3:])


def _causal_mask(q_start, s):
    q_pos = q_start + jnp.arange(Q_BLOCK)
    return jnp.arange(s)[None, :] <= q_pos[:, None]


def _masked_softmax(scores, mask):
    return jax.nn.softmax(jnp.where(mask, scores, -jnp.inf), axis=-1)


def _diff_attention(q, k, v, lam_q1, lam_k1, lam_q2, lam_k2, subln, lam_init, cos, sin):
    b, s, _ = q.shape
    q = q.reshape(b, s, DIFF_HEADS, 2, DIFF_HEAD_DIM)
    k = k.reshape(b, s, DIFF_HEADS, 2, DIFF_HEAD_DIM)
    q1 = _apply_rope(q[..., 0, :], cos, sin)
    q2 = _apply_rope(q[..., 1, :], cos, sin)
    k1 = _apply_rope(k[..., 0, :], cos, sin)
    k2 = _apply_rope(k[..., 1, :], cos, sin)
    v = v.reshape(b, s, DIFF_HEADS, 2 * DIFF_HEAD_DIM)
    f32 = jnp.float32
    lam = (jnp.exp(jnp.sum(lam_q1.astype(f32) * lam_k1.astype(f32)))
           - jnp.exp(jnp.sum(lam_q2.astype(f32) * lam_k2.astype(f32))) + lam_init)
    scale = DIFF_HEAD_DIM ** -0.5

    def block(q_start, q1b, q2b):
        mask = _causal_mask(q_start, s)
        a1 = _masked_softmax(jnp.einsum('bqhd,bkhd->bhqk', q1b, k1).astype(f32) * scale, mask)
        a2 = _masked_softmax(jnp.einsum('bqhd,bkhd->bhqk', q2b, k2).astype(f32) * scale, mask)
        return jnp.einsum('bhqk,bkhe->bqhe', (a1 - lam * a2).astype(v.dtype), v)

    o = _sweep_query_blocks(block, q1, q2)
    o = _rms_norm(o, subln, DIFF_SUBLN_EPS) * (1.0 - lam_init)
    return o.reshape(b, s, DIFF_WIDTH)


def _mla(c_q, c_kv, k_rope, q_norm, w_uq, kv_norm, w_ukv, cos, sin):
    b, s, _ = c_q.shape
    q = (_rms_norm(c_q, q_norm) @ w_uq).reshape(b, s, MLA_HEADS, MLA_NOPE_DIM + MLA_ROPE_DIM)
    q_nope = q[..., :MLA_NOPE_DIM]
    q_rope = _apply_rope(q[..., MLA_NOPE_DIM:], cos, sin)
    kv = (_rms_norm(c_kv, kv_norm) @ w_ukv).reshape(b, s, MLA_HEADS, MLA_NOPE_DIM + MLA_V_DIM)
    k_nope = kv[..., :MLA_NOPE_DIM]
    v = kv[..., MLA_NOPE_DIM:]
    k_rope = _apply_rope(k_rope[:, :, None, :], cos, sin)[:, :, 0, :]
    scale = (MLA_NOPE_DIM + MLA_ROPE_DIM) ** -0.5

    def block(q_start, qn, qr):
        mask = _causal_mask(q_start, s)
        scores = (jnp.einsum('bqhd,bkhd->bhqk', qn, k_nope)
                  + jnp.einsum('bqhr,bkr->bhqk', qr, k_rope))
        p = _masked_softmax(scores.astype(jnp.float32) * scale, mask)
        return jnp.einsum('bhqk,bkhe->bqhe', p.astype(v.dtype), v)

    o = _sweep_query_blocks(block, q_nope, q_rope)
    return o.reshape(b, s, MLA_WIDTH)


def _retention(q, k, v, g, gn_w, gn_b, cos, sin):
    b, s, _ = q.shape
    h, dk, dv, c = RET_HEADS, RET_QK_DIM, RET_V_DIM, RET_CHUNK
    nc = s // c
    dt = q.dtype
    q = _apply_rope(q.reshape(b, s, h, dk), cos, sin)
    k = _apply_rope(k.reshape(b, s, h, dk), cos, sin) * (dk ** -0.5)
    v = v.reshape(b, s, h, dv)
    log_gamma = jnp.log1p(-jnp.exp2(-5.0 - jnp.arange(h, dtype=jnp.float32)))
    pos = jnp.arange(c, dtype=jnp.float32)
    rel = pos[:, None] - pos[None, :]
    decay = jnp.where(rel[None] >= 0,
                      jnp.exp(jnp.maximum(rel, 0.0)[None] * log_gamma[:, None, None]),
                      0.0).astype(dt)
    xi = jnp.exp((pos[:, None] + 1.0) * log_gamma[None, :]).astype(dt)
    zeta = jnp.exp((c - 1.0 - pos)[:, None] * log_gamma[None, :]).astype(dt)
    chunk_decay = jnp.exp(c * log_gamma).astype(dt)
    qc = q.reshape(b, nc, c, h, dk)
    kc = k.reshape(b, nc, c, h, dk)
    vc = v.reshape(b, nc, c, h, dv)
    inner = jnp.einsum('bnihd,bnjhd->bnhij', qc, kc) * decay
    inner = jnp.einsum('bnhij,bnjhe->bnihe', inner, vc)

    def step(state, kv_chunk):
        k_i, v_i = kv_chunk
        new_state = (jnp.einsum('bjhd,bjhe->bhde', k_i * zeta[None, :, :, None], v_i)
                     + chunk_decay[None, :, None, None] * state)
        return new_state, state

    state0 = jnp.zeros((b, h, dk, dv), dt)
    _, prev_states = lax.scan(step, state0, (jnp.moveaxis(kc, 1, 0), jnp.moveaxis(vc, 1, 0)))
    cross = jnp.einsum('bnihd,nbhde->bnihe', qc, prev_states) * xi[None, None, :, :, None]
    o = (inner + cross).reshape(b, s, h, dv)
    o32 = o.astype(jnp.float32)
    mu = jnp.mean(o32, axis=-1, keepdims=True)
    var = jnp.mean(jnp.square(o32 - mu), axis=-1, keepdims=True)
    o = ((o32 - mu) * lax.rsqrt(var + RET_GN_EPS)).astype(dt).reshape(b, s, RET_WIDTH)
    o = o * gn_w + gn_b
    return jax.nn.silu(g) * o


def setup_inputs(seed: int = 0) -> dict:
    key = jax.random.key(seed)
    ks = jax.random.split(key, 24)
    f32 = jnp.float32
    L = DEPTH

    def dense(k, shape, fan_in):
        return jax.random.normal(k, shape, f32) * (fan_in ** -0.5)

    def gain(k, shape):
        return 1.0 + 0.01 * jax.random.normal(k, shape, f32)

    x = jax.random.normal(ks[0], (BATCH, SEQ, D_MODEL), f32)
    positions = (jnp.arange(SEQ, dtype=jnp.int32)[None, :]
                 + jax.random.randint(ks[1], (BATCH, 1), 0, 1024, dtype=jnp.int32))
    return {
        "x": x,
        "positions": positions,
        "attn_norm": gain(ks[2], (L, D_MODEL)),
        "w_in": dense(ks[3], (L, D_MODEL, IN_COLS), D_MODEL),
        "diff_lam_q1": 0.1 * jax.random.normal(ks[4], (L, DIFF_HEAD_DIM), f32),
        "diff_lam_k1": 0.1 * jax.random.normal(ks[5], (L, DIFF_HEAD_DIM), f32),
        "diff_lam_q2": 0.1 * jax.random.normal(ks[6], (L, DIFF_HEAD_DIM), f32),
        "diff_lam_k2": 0.1 * jax.random.normal(ks[7], (L, DIFF_HEAD_DIM), f32),
        "diff_subln": gain(ks[8], (L, 2 * DIFF_HEAD_DIM)),
        "mla_q_norm": gain(ks[9], (L, MLA_Q_RANK)),
        "mla_w_uq": dense(ks[10], (L, MLA_Q_RANK, MLA_HEADS * (MLA_NOPE_DIM + MLA_ROPE_DIM)), MLA_Q_RANK),
        "mla_kv_norm": gain(ks[11], (L, MLA_KV_RANK)),
        "mla_w_ukv": dense(ks[12], (L, MLA_KV_RANK, MLA_HEADS * (MLA_NOPE_DIM + MLA_V_DIM)), MLA_KV_RANK),
        "ret_gn_w": gain(ks[13], (L, RET_WIDTH)),
        "ret_gn_b": 0.01 * jax.random.normal(ks[14], (L, RET_WIDTH), f32),
        "w_out": dense(ks[15], (L, MIX_WIDTH, D_MODEL), MIX_WIDTH),
        "ffn_norm": gain(ks[16], (L, D_MODEL)),
        "w_gate": dense(ks[17], (L, D_MODEL, FFN_HIDDEN), D_MODEL),
        "w_up": dense(ks[18], (L, D_MODEL, FFN_HIDDEN), D_MODEL),
        "w_down": dense(ks[19], (L, FFN_HIDDEN, D_MODEL), FFN_HIDDEN),
        "final_norm": gain(ks[20], (D_MODEL,)),
    }


def reference(x, positions, attn_norm, w_in, diff_lam_q1, diff_lam_k1, diff_lam_q2,
              diff_lam_k2, diff_subln, mla_q_norm, mla_w_uq, mla_kv_norm, mla_w_ukv,
              ret_gn_w, ret_gn_b, w_out, ffn_norm, w_gate, w_up, w_down, final_norm):
    dt = x.dtype
    cos_d, sin_d = _rope_tables(positions, DIFF_HEAD_DIM, dt)
    cos_m, sin_m = _rope_tables(positions, MLA_ROPE_DIM, dt)
    cos_r, sin_r = _rope_tables(positions, RET_QK_DIM, dt)
    for layer in range(DEPTH):
        h = _rms_norm(x, attn_norm[layer])
        (d_q, d_k, d_v, m_cq, m_ckv, m_krope,
         r_q, r_k, r_v, r_g) = _split_cols(h @ w_in[layer])
        lam_init = 0.8 - 0.6 * math.exp(-0.3 * layer)
        o_diff = _diff_attention(d_q, d_k, d_v, diff_lam_q1[layer], diff_lam_k1[layer],
                                 diff_lam_q2[layer], diff_lam_k2[layer], diff_subln[layer],
                                 lam_init, cos_d, sin_d)
        o_mla = _mla(m_cq, m_ckv, m_krope, mla_q_norm[layer], mla_w_uq[layer],
                     mla_kv_norm[layer], mla_w_ukv[layer], cos_m, sin_m)
        o_ret = _retention(r_q, r_k, r_v, r_g, ret_gn_w[layer], ret_gn_b[layer], cos_r, sin_r)
        mixed = jnp.concatenate([o_diff, o_mla, o_ret], axis=-1)
        x = x + mixed @ w_out[layer]
        h = _rms_norm(x, ffn_norm[layer])
        x = x + (jax.nn.silu(h @ w_gate[layer]) * (h @ w_up[layer])) @ w_down[layer]
    return _rms_norm(x, final_norm)
```

```cpp
#include <hip/hip_runtime.h>
#include <hip/hip_bf16.h>
#include <cstdio>
#include <cstdint>
#include <cmath>
namespace pg8 {
#define PG8_LAS __attribute__((address_space(3)))
typedef unsigned short bf16_t;
typedef short bf16x8 __attribute__((ext_vector_type(8)));
typedef float f32x4 __attribute__((ext_vector_type(4)));
typedef unsigned u32x4 __attribute__((ext_vector_type(4)));
constexpr int BM = 256, BK = 64, HALF = 128, HTB = HALF * BK * 2  , STAGE_BYTES = 8 * HTB, NXCD = 8, WGM = 8;

__host__ __device__ __forceinline__ int lds_byte(int r, int c) { const int st = (r >> 4) * 2 + (c >> 5), rr = r & 15, cc = c & 31, ob = rr * 64 + cc * 2; return st * 1024 + (ob ^ (((ob >> 9) & 1) << 5)); }
__host__ __device__ __forceinline__ void stage_rc(int b, int& R, int& C) { const int st = b / 1024, sb = b % 1024, swz = sb ^ (((sb >> 9) & 1) << 5); R = (st >> 1) * 16 + swz / 64; C = (st & 1) * 32 + (swz % 64) / 2; }
__host__ __device__ __forceinline__ int perm32(int rho) { const int n = rho >> 4, i = rho & 15; return 8 * (i >> 2) + 4 * n + (i & 3); }

struct Unit { int pm, pn; };
struct Gemm { const bf16_t* A; const bf16_t* Bt; int M, N, K; };

struct StaticOrder {
    int nM, nN, nwg, G, c;
    __host__ __device__ void init(int M, int N, int G_, int c_) { nM = M / BM; nN = N / BM; nwg = nM * nN; G = G_; c = c_; }
    __host__ __device__ bool next(int i, Unit& u) const {
        const long L = (long)i * G + c; if (L >= nwg) return false;
        int wgid = (int)L; { const int q = nwg / NXCD, r = nwg % NXCD, xcd = wgid % NXCD, off = wgid / NXCD; wgid = (xcd < r ? xcd * (q + 1) : r * (q + 1) + (xcd - r) * q) + off; }
        const int nig = WGM * nN, gid = wgid / nig, fm = gid * WGM, gsz = (nM - fm) < WGM ? (nM - fm) : WGM;
        u.pm = fm + ((wgid % nig) % gsz); u.pn = (wgid % nig) / gsz; return true;
    }
    __device__ __forceinline__ void a_ready(const Unit&) const {}
    __device__ __forceinline__ void done(const Unit&) const {}
};
__device__ __forceinline__ unsigned cvt_pk_bf16(float lo, float hi) { unsigned r; asm volatile("v_cvt_pk_bf16_f32 %0, %1, %2" : "=v"(r) : "v"(lo), "v"(hi)); return r; }
typedef float f32x2 __attribute__((ext_vector_type(2)));
template <class Epi, class Sched, bool ALIGN_EPI = false, bool SP2 = false>
__device__ __forceinline__ void gemm_phase(PG8_LAS unsigned char* lds, const Gemm g, const Sched& S, const Epi& E) {
    int tid_ = threadIdx.x; asm volatile("" : "+v"(tid_));
    const int tid = tid_, wid = __builtin_amdgcn_readfirstlane(tid >> 6), lane = tid & 63, wr = wid >> 2, wc = wid & 3, fr = lane & 15, fq = lane >> 4;
    const int K = g.K, nt = K / BK;
    unsigned voffA[2], voffB[2];
#pragma unroll
    for (int i = 0; i < 2; ++i) { int R, C; stage_rc(tid * 16 + i * 8192, R, C); const int Rb = Epi::PERM ? ((R & ~31) + perm32(R & 31)) : R;
        voffA[i] = (unsigned)(R * K + C) * 2u; voffB[i] = (unsigned)(Rb * K + C) * 2u; }
    const size_t kstep = (size_t)(BK * 2);
    const size_t hstep = (size_t)HALF * K * 2;
    const size_t tstep = 2 * hstep;
    const unsigned ldsw = (unsigned)wid * 1024u;
    const int aoff = lds_byte(wr * 64 + fr, fq * 8), boff = lds_byte(wc * 32 + fr, fq * 8);
#define PG8_SA(b, h) (((b) * 2 + (h)) * HTB)
#define PG8_SB(b, h) ((4 + (b) * 2 + (h)) * HTB)
#define PG8_STAGE(bufoff, gbase, voff) do { _Pragma("unroll") for (int _i = 0; _i < 2; ++_i) \
        __builtin_amdgcn_global_load_lds((const unsigned*)((const char*)(gbase) + (voff)[_i]), (PG8_LAS unsigned*)(lds + (bufoff) + ldsw + _i * 8192), 16, 0, 0); } while (0)
#define PG8_LDA(dst, b, h) do { _Pragma("unroll") for (int m = 0; m < 4; ++m) _Pragma("unroll") for (int k = 0; k < 2; ++k) dst[m][k] = *(const PG8_LAS bf16x8*)(lds + PG8_SA(b, h) + aoff + m * 2048 + k * 1024); } while (0)
#define PG8_LDB(dst, b, h) do { _Pragma("unroll") for (int n = 0; n < 2; ++n) _Pragma("unroll") for (int k = 0; k < 2; ++k) dst[n][k] = *(const PG8_LAS bf16x8*)(lds + PG8_SB(b, h) + boff + n * 2048 + k * 1024); } while (0)
#define PG8_MMA(ai, bj, At, Bt) do { __builtin_amdgcn_s_setprio(1); _Pragma("unroll") for (int m = 0; m < 4; ++m) _Pragma("unroll") for (int n = 0; n < 2; ++n) _Pragma("unroll") for (int k = 0; k < 2; ++k) \
        acc[ai][bj][m][n] = __builtin_amdgcn_mfma_f32_16x16x32_bf16(Bt[n][k], At[m][k], acc[ai][bj][m][n], 0, 0, 0); __builtin_amdgcn_s_setprio(0); } while (0)
#define PG8_WAIT_V(n) asm volatile("s_waitcnt vmcnt(" #n ")" ::: "memory")
#define PG8_WAIT_L(n) asm volatile("s_waitcnt lgkmcnt(" #n ")" ::: "memory")
#define PG8_BAR __builtin_amdgcn_s_barrier()
#define PG8_SCHED __builtin_amdgcn_sched_barrier(0)
    Unit cur, nxt; int ui = 0;
    if (!S.next(0, cur)) return;
    f32x4 acc[2][2][4][2];
#pragma unroll
    for (int a = 0; a < 2; ++a)
#pragma unroll
        for (int b = 0; b < 2; ++b)
#pragma unroll
            for (int m = 0; m < 4; ++m)
#pragma unroll
                for (int n = 0; n < 2; ++n) acc[a][b][m][n] = (f32x4){0.f, 0.f, 0.f, 0.f};
    bf16x8 At[4][2], B0[2][2], B1[2][2];
    const char* cA = (const char*)g.A + (size_t)cur.pm * tstep; const char* cB = (const char*)g.Bt + (size_t)cur.pn * tstep;
    S.a_ready(cur);
    if constexpr (SP2) {
        PG8_STAGE(PG8_SB(0, 0), cB, voffB); PG8_STAGE(PG8_SB(0, 1), cB + hstep, voffB); PG8_STAGE(PG8_SA(0, 0), cA, voffA); PG8_STAGE(PG8_SA(0, 1), cA + hstep, voffA);
        if (wr == 1) PG8_BAR;
        PG8_WAIT_V(2); PG8_BAR;
        PG8_STAGE(PG8_SB(1, 0), cB + kstep, voffB); PG8_STAGE(PG8_SA(1, 0), cA + kstep, voffA); PG8_STAGE(PG8_SB(1, 1), cB + hstep + kstep, voffB);
        PG8_WAIT_V(6); PG8_BAR;
    } else {
        PG8_STAGE(PG8_SB(0, 0), cB, voffB); PG8_STAGE(PG8_SA(0, 0), cA, voffA); PG8_STAGE(PG8_SB(0, 1), cB + hstep, voffB); PG8_STAGE(PG8_SA(0, 1), cA + hstep, voffA);
        if (wr == 1) PG8_BAR;
        PG8_WAIT_V(4); PG8_BAR;
        PG8_STAGE(PG8_SB(1, 0), cB + kstep, voffB); PG8_STAGE(PG8_SA(1, 0), cA + kstep, voffA); PG8_STAGE(PG8_SB(1, 1), cB + hstep + kstep, voffB);
        PG8_WAIT_V(6); PG8_BAR;
    }
    for (;;) {
        const bool has_next = S.next(ui + 1, nxt);
        const char* nA = has_next ? (const char*)g.A + (size_t)nxt.pm * tstep : cA; const char* nB = has_next ? (const char*)g.Bt + (size_t)nxt.pn * tstep : cB;
        for (int t = 0; t < nt; t += 2) {
            const bool last = (t == nt - 2);
            const char* a1 = cA + (size_t)(t + 1) * kstep;
            const char* a2 = last ? nA : cA + (size_t)(t + 2) * kstep; const char* b2 = last ? nB : cB + (size_t)(t + 2) * kstep;
            const char* a3 = a2 + kstep; const char* b3 = b2 + kstep;
            if (last && has_next) S.a_ready(nxt);
            if constexpr (SP2) {
            PG8_LDB(B0, 0, 0); PG8_LDB(B1, 0, 1); PG8_SCHED; PG8_LDA(At, 0, 0); PG8_STAGE(PG8_SA(1, 1), a1 + hstep, voffA);
            PG8_WAIT_V(8); PG8_WAIT_L(0); PG8_BAR; PG8_MMA(0, 0, At, B0); PG8_MMA(0, 1, At, B1); PG8_BAR; PG8_SCHED;
            PG8_LDA(At, 0, 1); PG8_STAGE(PG8_SB(0, 0), b2, voffB); PG8_STAGE(PG8_SB(0, 1), b2 + hstep, voffB); PG8_STAGE(PG8_SA(0, 0), a2, voffA);
            PG8_WAIT_V(8); PG8_WAIT_L(0); PG8_BAR; PG8_MMA(1, 0, At, B0); PG8_MMA(1, 1, At, B1); PG8_BAR; PG8_SCHED;
            PG8_LDB(B0, 1, 0); PG8_LDB(B1, 1, 1); PG8_SCHED; PG8_LDA(At, 1, 0); PG8_STAGE(PG8_SA(0, 1), a2 + hstep, voffA);
            PG8_WAIT_V(8); PG8_WAIT_L(0); PG8_BAR; PG8_MMA(0, 0, At, B0); PG8_MMA(0, 1, At, B1); PG8_BAR; PG8_SCHED;
            PG8_LDA(At, 1, 1); PG8_STAGE(PG8_SB(1, 0), b3, voffB); PG8_STAGE(PG8_SB(1, 1), b3 + hstep, voffB); PG8_STAGE(PG8_SA(1, 0), a3, voffA);
            PG8_WAIT_V(8); PG8_WAIT_L(0); PG8_BAR; PG8_MMA(1, 0, At, B0); PG8_MMA(1, 1, At, B1); PG8_BAR; PG8_SCHED;
            } else {
            PG8_LDB(B0, 0, 0); PG8_SCHED; PG8_LDA(At, 0, 0); PG8_STAGE(PG8_SA(1, 1), a1 + hstep, voffA);
            PG8_WAIT_L(8); PG8_BAR; PG8_WAIT_L(0); PG8_MMA(0, 0, At, B0); PG8_BAR; PG8_SCHED;
            PG8_LDB(B1, 0, 1); PG8_STAGE(PG8_SB(0, 0), b2, voffB);
            PG8_BAR; PG8_WAIT_L(0); PG8_MMA(0, 1, At, B1); PG8_BAR;
            PG8_LDA(At, 0, 1); PG8_STAGE(PG8_SA(0, 0), a2, voffA);
            PG8_BAR; PG8_WAIT_L(0); PG8_MMA(1, 0, At, B0); PG8_BAR; PG8_SCHED;
            PG8_STAGE(PG8_SB(0, 1), b2 + hstep, voffB);
            PG8_WAIT_V(6); PG8_BAR; PG8_MMA(1, 1, At, B1); PG8_BAR;
            PG8_LDB(B0, 1, 0); PG8_SCHED; PG8_LDA(At, 1, 0); PG8_STAGE(PG8_SA(0, 1), a2 + hstep, voffA);
            PG8_WAIT_L(8); PG8_BAR; PG8_WAIT_L(0); PG8_MMA(0, 0, At, B0); PG8_BAR; PG8_SCHED;
            PG8_LDB(B1, 1, 1); PG8_STAGE(PG8_SB(1, 0), b3, voffB);
            PG8_BAR; PG8_WAIT_L(0); PG8_MMA(0, 1, At, B1); PG8_BAR;
            PG8_LDA(At, 1, 1); PG8_STAGE(PG8_SA(1, 0), a3, voffA);
            PG8_BAR; PG8_WAIT_L(0); PG8_MMA(1, 0, At, B0); PG8_BAR; PG8_SCHED;
            PG8_STAGE(PG8_SB(1, 1), b3 + hstep, voffB);
            PG8_WAIT_V(6); PG8_BAR; PG8_MMA(1, 1, At, B1); PG8_BAR;
            }
        }
        if constexpr (ALIGN_EPI) { if (wr == 0) PG8_BAR; }
        if constexpr (!Epi::AFTER_DRAIN) { E(acc, cur, wr, wc, fr, fq); S.done(cur); }
        if (!has_next) break;
#pragma unroll
        for (int a = 0; a < 2; ++a)
#pragma unroll
            for (int b = 0; b < 2; ++b)
#pragma unroll
                for (int m = 0; m < 4; ++m)
#pragma unroll
                    for (int n = 0; n < 2; ++n) acc[a][b][m][n] = (f32x4){0.f, 0.f, 0.f, 0.f};
        cur = nxt; cA = nA; cB = nB; ++ui;
        if constexpr (ALIGN_EPI) { if (wr == 1) PG8_BAR; }
    }
    PG8_WAIT_V(0);
    if constexpr (!ALIGN_EPI) { if (wr == 0) PG8_BAR; }
    PG8_BAR;
    if constexpr (Epi::AFTER_DRAIN) { E.fused(acc, cur, wr, wc, fr, fq, lds, wid, lane); S.done(cur); }
#undef PG8_SA
#undef PG8_SB
#undef PG8_STAGE
#undef PG8_LDA
#undef PG8_LDB
#undef PG8_MMA
#undef PG8_WAIT_V
#undef PG8_WAIT_L
#undef PG8_BAR
#undef PG8_SCHED
}
}

#ifndef PG8_SP2
#define PG8_SP2 true
#endif
#ifndef PG8_ALIGN
#define PG8_ALIGN true
#endif
#define GAS __attribute__((address_space(1)))
#define LAS __attribute__((address_space(3)))
typedef unsigned short bf16;
typedef unsigned v4u __attribute__((ext_vector_type(4)));
typedef float f32x4 __attribute__((ext_vector_type(4)));
typedef short bf16x8 __attribute__((ext_vector_type(8)));
typedef GAS unsigned gu32;
typedef GAS unsigned long long gu64;
#define RLX_AGENT __ATOMIC_RELAXED, __HIP_MEMORY_SCOPE_AGENT
#define LDS_WAIT() asm volatile("s_waitcnt lgkmcnt(0)" ::: "memory")
#define VM_WAIT() asm volatile("s_waitcnt vmcnt(0)" ::: "memory")
__device__ __forceinline__ unsigned long long rt() { return __builtin_amdgcn_s_memrealtime(); }
__device__ __forceinline__ unsigned f2bf(float f) { unsigned u = __builtin_bit_cast(unsigned, f); return (u + 0x7fffu + ((u >> 16) & 1u)) >> 16; }
__device__ __forceinline__ unsigned pk2(float lo, float hi) { return f2bf(lo) | (f2bf(hi) << 16); }

#define XB_TMO      128
#define XB_XCNT(j)  (256  + 64 * (j))
#define XB_XSUB(j)  (1280 + 64 * (j))
#define XB_XGEN(j)  (2304 + 64 * (j))
#define XB_TOP      3328
#define XB_TOPGEN   3392
#define XCD_BAR_WORDS 3456
#define XB_SPIN_CAP (1u << 18)

__device__ __forceinline__ unsigned xb_ld(unsigned* p)              { return __hip_atomic_load(p, __ATOMIC_RELAXED, __HIP_MEMORY_SCOPE_AGENT); }
__device__ __forceinline__ unsigned xb_add(unsigned* p, unsigned v) { return __hip_atomic_fetch_add(p, v, __ATOMIC_RELAXED, __HIP_MEMORY_SCOPE_AGENT); }
__device__ __forceinline__ unsigned xb_xcc_id() { return (unsigned)__builtin_amdgcn_s_getreg((3 << 11) | 20) & 0xFu; }
#define XB_SPIN(cond, bar) do { unsigned _sp = 0; while (cond) { __builtin_amdgcn_s_sleep(1); \
    if ((++_sp & 255u) == 0u) { if (xb_ld(&(bar)[XB_TMO])) break; if (_sp > XB_SPIN_CAP) { atomicAdd(&(bar)[XB_TMO], 1u); break; } } } } while (0)

struct XcdBarrier {
    unsigned* bar; unsigned x;
    volatile LAS unsigned* st;
};

__device__ __forceinline__ XcdBarrier xcd_barrier_post(unsigned* bar, volatile LAS unsigned* st) {
    XcdBarrier b; b.bar = bar; b.x = xb_xcc_id(); b.st = st;
    if (threadIdx.x == 0) (void)xb_add(&bar[XB_XCNT(b.x)], 1u);
    return b;
}
__device__ __forceinline__ void xcd_barrier_complete(unsigned* bar, unsigned x, unsigned& nloc, unsigned& nx) {
    const unsigned G = gridDim.x * gridDim.y * gridDim.z;
    unsigned sum, cnt, mine, sp = 0u;
    for (;;) {
        sum = 0u; cnt = 0u; mine = 0u;
#pragma unroll
        for (unsigned j = 0; j < 16; ++j) { const unsigned c = xb_ld(&bar[XB_XCNT(j)]); sum += c; cnt += (c > 0u) ? 1u : 0u; mine = (j == x) ? c : mine; }
        if (sum == G) break;
        __builtin_amdgcn_s_sleep(1);
        if ((++sp & 255u) == 0u) { if (xb_ld(&bar[XB_TMO])) break; if (sp > XB_SPIN_CAP) { atomicAdd(&bar[XB_TMO], 1u); break; } }
    }
    nloc = mine > 0u ? mine : 1u; nx = cnt > 0u ? cnt : 1u;
}

__device__ __forceinline__ void xcd_barrier(const XcdBarrier& b) {
    asm volatile("s_waitcnt vmcnt(0)" ::: "memory");
    __syncthreads();
    if (threadIdx.x == 0) {
        unsigned* bar = b.bar;
        __builtin_amdgcn_s_waitcnt(0);
        unsigned nloc = b.st[0], nx = b.st[1];
        if (nloc == 0u) { xcd_barrier_complete(bar, b.x, nloc, nx); b.st[0] = nloc; b.st[1] = nx; }
        const unsigned old = xb_add(&bar[XB_XSUB(b.x)], 1u);
        const unsigned gen = old / nloc;
        if (old + 1u == (gen + 1u) * nloc) {
            __builtin_amdgcn_fence(__ATOMIC_RELEASE, "agent");
            asm volatile("s_waitcnt vmcnt(0)" ::: "memory");
            const unsigned og = xb_add(&bar[XB_TOP], 1u);
            const unsigned tg = og / nx;
            if (og + 1u == (tg + 1u) * nx) xb_add(&bar[XB_TOPGEN], 1u);
            else XB_SPIN(xb_ld(&bar[XB_TOPGEN]) == tg, bar);
            __builtin_amdgcn_fence(__ATOMIC_ACQUIRE, "agent");
            xb_add(&bar[XB_XGEN(b.x)], 1u);
            asm volatile("s_waitcnt vmcnt(0)" ::: "memory");
        } else {
            XB_SPIN(xb_ld(&bar[XB_XGEN(b.x)]) == gen, bar);
            __builtin_amdgcn_fence(__ATOMIC_ACQUIRE, "agent");
            asm volatile("s_waitcnt vmcnt(0)" ::: "memory");
        }
    }
    __syncthreads();
}
constexpr int BATCH = 2, SEQ = 8192, DMODEL = 1024, MTOK = BATCH * SEQ, DEPTH = 2;
constexpr int IN_COLS = 2976, NIN = 3072, FFH = 2816, NGU = 2 * FFH;
constexpr float NORM_EPS = 1e-6f;
constexpr float LOG2E = 1.4426950408889634f;
constexpr float C2_DIFF = 0.125f * LOG2E;
constexpr float C2_MLA = 0.10206207261596575f * LOG2E;

namespace pg8 {
typedef float f32x2v __attribute__((ext_vector_type(2)));
__device__ __forceinline__ u32x4 pack8(const f32x4 a, const f32x4 b) { u32x4 w; w.x = cvt_pk_bf16(a[0], a[1]); w.y = cvt_pk_bf16(a[2], a[3]); w.z = cvt_pk_bf16(b[0], b[1]); w.w = cvt_pk_bf16(b[2], b[3]); return w; }
__device__ __forceinline__ float rstd4(const float* p, float inv_n, float eps) { const f32x4 s = *(const f32x4*)p; return 1.0f / sqrtf(((s[0] + s[1]) + (s[2] + s[3])) * inv_n + eps); }
__device__ __forceinline__ float sumsq4(const f32x4 v) { return (v[0] * v[0] + v[1] * v[1]) + (v[2] * v[2] + v[3] * v[3]); }
__device__ __forceinline__ f32x4 silu4(const f32x4 v) { f32x4 r;
#pragma unroll
    for (int i = 0; i < 4; ++i) r[i] = v[i] * __builtin_amdgcn_rcpf(1.0f + __builtin_amdgcn_exp2f(-v[i] * 1.4426950408889634f)); return r; }

struct EpiG1 {
    static constexpr bool PERM = true, AFTER_DRAIN = false;
    const float* ssq;
    const float* t64;
    const float* tm;
    bf16_t *DQ, *DK, *DV, *CQ, *CKV, *MK, *RQ, *RK, *RV, *RG; float *CQS, *CKVS;
    __device__ __forceinline__ void operator()(const f32x4 (&acc)[2][2][4][2], const Unit& u, int wr, int wc, int fr, int fq) const {
        { int t_ = threadIdx.x; asm volatile("" : "+v"(t_)); fr = t_ & 15; fq = (t_ >> 4) & 3; }
        const int pn = u.pn;
#pragma unroll
        for (int ai = 0; ai < 2; ++ai)
#pragma unroll
            for (int m = 0; m < 4; ++m) {
                asm volatile("" ::: "memory");
                const int row = u.pm * BM + ai * HALF + wr * 64 + m * 16 + fr;
                const float rs = rstd4(ssq + (size_t)row * 4, 1.0f / 1024.0f, NORM_EPS);
                const f32x4 l0 = acc[ai][0][m][0] * rs, l1 = acc[ai][0][m][1] * rs, h0 = acc[ai][1][m][0] * rs, h1 = acc[ai][1][m][1] * rs;
                if (pn < 4 || pn == 8 || pn == 9) {
                    const float* tr = t64 + (size_t)row * 64 + 8 * fq;
                    const f32x4 c0 = *(const f32x4*)tr, c1 = *(const f32x4*)(tr + 4), s0 = *(const f32x4*)(tr + 32), s1 = *(const f32x4*)(tr + 36);
                    const float sc = pn < 2 ? C2_DIFF : (pn == 9 ? 0.125f : 1.0f);
                    const f32x4 ol0 = (l0 * c0 - h0 * s0) * sc, ol1 = (l1 * c1 - h1 * s1) * sc, oh0 = (h0 * c0 + l0 * s0) * sc, oh1 = (h1 * c1 + l1 * s1) * sc;
                    bf16_t* dst; if (pn < 2) dst = DQ + (size_t)row * 512 + 256 * pn; else if (pn < 4) dst = DK + (size_t)row * 512 + 256 * (pn - 2); else dst = (pn == 8 ? RQ : RK) + (size_t)row * 256;
                    dst += 64 * wc + 8 * fq;
                    *(u32x4*)dst = pack8(ol0, ol1); *(u32x4*)(dst + 32) = pack8(oh0, oh1);
                } else if (pn == 4 || pn == 5 || pn == 10) {
                    bf16_t* dst = (pn == 10 ? RV + (size_t)row * 256 : DV + (size_t)row * 512 + 256 * (pn - 4)) + 32 * wc + 8 * fq;
                    *(u32x4*)dst = pack8(l0, l1); *(u32x4*)(dst + HALF) = pack8(h0, h1);
                } else if (pn == 11) {
                    bf16_t* dst = RG + (size_t)row * 256 + 32 * wc + 8 * fq;
                    *(u32x4*)dst = pack8(silu4(l0), silu4(l1)); *(u32x4*)(dst + HALF) = pack8(silu4(h0), silu4(h1));
                } else if (pn == 6) {
                    bf16_t* dst = CQ + (size_t)row * 256 + 32 * wc + 8 * fq;
                    *(u32x4*)dst = pack8(l0, l1); *(u32x4*)(dst + HALF) = pack8(h0, h1);
                    float s = (sumsq4(l0) + sumsq4(l1)) + (sumsq4(h0) + sumsq4(h1));
                    s += __shfl_xor(s, 16); s += __shfl_xor(s, 32);
                    if (fq == 0) CQS[(size_t)row * 4 + wc] = s;
                } else {
                    bf16_t* dst = CKV + (size_t)row * 256 + 32 * wc + 8 * fq;
                    *(u32x4*)dst = pack8(l0, l1); *(u32x4*)(dst + HALF) = pack8(h0, h1);
                    const bool kr = (wc == 0) && (fq < 2);
                    float s = kr ? 0.f : (sumsq4(l0) + sumsq4(l1)) + (sumsq4(h0) + sumsq4(h1));
                    s += __shfl_xor(s, 16); s += __shfl_xor(s, 32);
                    if (fq == 0) CKVS[(size_t)row * 4 + wc] = s;
                    if (kr) {
                        const float* tr = tm + (size_t)row * 32 + 8 * fq;
                        const f32x4 c0 = *(const f32x4*)tr, c1 = *(const f32x4*)(tr + 4), s0 = *(const f32x4*)(tr + 16), s1 = *(const f32x4*)(tr + 20);
                        const u32x4 olo = pack8(l0 * c0 - h0 * s0, l1 * c1 - h1 * s1), ohi = pack8(h0 * c0 + l0 * s0, h1 * c1 + l1 * s1);
                        bf16_t* kd = MK + (size_t)row * 384 + 64 + 8 * fq;
#pragma unroll
                        for (int hh = 0; hh < 4; ++hh) { *(u32x4*)(kd + hh * 96) = olo; *(u32x4*)(kd + hh * 96 + 16) = ohi; }
                    }
                }
            }
    }
};

struct EpiMQ {
    static constexpr bool PERM = true, AFTER_DRAIN = false;
    const float* cqs; const float* tm; bf16_t* MQ;
    __device__ __forceinline__ void operator()(const f32x4 (&acc)[2][2][4][2], const Unit& u, int wr, int wc, int fr, int fq) const {
        { int t_ = threadIdx.x; asm volatile("" : "+v"(t_)); fr = t_ & 15; fq = (t_ >> 4) & 3; }
        const int head = 2 * u.pn + (wc >> 1);
#pragma unroll
        for (int ai = 0; ai < 2; ++ai)
#pragma unroll
            for (int m = 0; m < 4; ++m) {
                asm volatile("" ::: "memory");
                const int row = u.pm * BM + ai * HALF + wr * 64 + m * 16 + fr;
                const float rs = rstd4(cqs + (size_t)row * 4, 1.0f / 256.0f, NORM_EPS) * C2_MLA;
                const f32x4 l0 = acc[ai][0][m][0] * rs, l1 = acc[ai][0][m][1] * rs, h0 = acc[ai][1][m][0] * rs, h1 = acc[ai][1][m][1] * rs;
                bf16_t* dst = MQ + (size_t)row * 384 + head * 96;
                if ((wc & 1) == 0) { *(u32x4*)(dst + 8 * fq) = pack8(l0, l1); *(u32x4*)(dst + 32 + 8 * fq) = pack8(h0, h1); }
                else if (fq < 2) {
                    const float* tr = tm + (size_t)row * 32 + 8 * fq;
                    const f32x4 c0 = *(const f32x4*)tr, c1 = *(const f32x4*)(tr + 4), s0 = *(const f32x4*)(tr + 16), s1 = *(const f32x4*)(tr + 20);
                    *(u32x4*)(dst + 64 + 8 * fq) = pack8(l0 * c0 - h0 * s0, l1 * c1 - h1 * s1); *(u32x4*)(dst + 80 + 8 * fq) = pack8(h0 * c0 + l0 * s0, h1 * c1 + l1 * s1);
                }
            }
    }
};
struct EpiMKV {
    static constexpr bool PERM = true, AFTER_DRAIN = false;
    const float* ckvs; bf16_t* MK; bf16_t* MV;
    __device__ __forceinline__ void operator()(const f32x4 (&acc)[2][2][4][2], const Unit& u, int wr, int wc, int fr, int fq) const {
        { int t_ = threadIdx.x; asm volatile("" : "+v"(t_)); fr = t_ & 15; fq = (t_ >> 4) & 3; }
        const int head = 2 * u.pn + (wc >> 1);
#pragma unroll
        for (int ai = 0; ai < 2; ++ai)
#pragma unroll
            for (int m = 0; m < 4; ++m) {
                asm volatile("" ::: "memory");
                const int row = u.pm * BM + ai * HALF + wr * 64 + m * 16 + fr;
                const float rs = rstd4(ckvs + (size_t)row * 4, 1.0f / 128.0f, NORM_EPS);
                const f32x4 l0 = acc[ai][0][m][0] * rs, l1 = acc[ai][0][m][1] * rs, h0 = acc[ai][1][m][0] * rs, h1 = acc[ai][1][m][1] * rs;
                bf16_t* dst = (wc & 1) ? MV + (size_t)row * 256 + head * 64 : MK + (size_t)row * 384 + head * 96;
                *(u32x4*)(dst + 8 * fq) = pack8(l0, l1); *(u32x4*)(dst + 32 + 8 * fq) = pack8(h0, h1);
            }
    }
};

struct EpiGU {
    static constexpr bool PERM = true, AFTER_DRAIN = false;
    const float* ssq; bf16_t* H;
    __device__ __forceinline__ void operator()(const f32x4 (&acc)[2][2][4][2], const Unit& u, int wr, int wc, int fr, int fq) const {
        { int t_ = threadIdx.x; asm volatile("" : "+v"(t_)); fr = t_ & 15; fq = (t_ >> 4) & 3; }
#pragma unroll
        for (int ai = 0; ai < 2; ++ai)
#pragma unroll
            for (int m = 0; m < 4; ++m) {
                asm volatile("" ::: "memory");
                const int row = u.pm * BM + ai * HALF + wr * 64 + m * 16 + fr;
                const float rs = rstd4(ssq + (size_t)row * 4, 1.0f / 1024.0f, NORM_EPS);
                const f32x4 g0 = acc[ai][0][m][0] * rs, g1 = acc[ai][0][m][1] * rs, u0 = acc[ai][1][m][0] * rs, u1 = acc[ai][1][m][1] * rs;
                *(u32x4*)(H + (size_t)row * FFH + u.pn * HALF + 32 * wc + 8 * fq) = pack8(silu4(g0) * u0, silu4(g1) * u1);
            }
    }
};

struct EpiRes {
    static constexpr bool PERM = false, AFTER_DRAIN = true;
    const float* xin; float* xout; bf16_t* xb; float* ssq;
    __device__ __forceinline__ void fused(f32x4 (&acc)[2][2][4][2], const Unit& u, int wr, int wc, int fr, int fq, PG8_LAS unsigned char* lds, int wid, int lane) const {
        { int t_ = threadIdx.x; asm volatile("" : "+v"(t_)); fr = t_ & 15; fq = (t_ >> 4) & 3; }
        typedef unsigned u32x2v __attribute__((ext_vector_type(2)));
        PG8_LAS float* P = (PG8_LAS float*)lds;
        const int col0 = u.pn * BM + wc * 32 + 4 * fq;
#pragma unroll
        for (int ai = 0; ai < 2; ++ai)
#pragma unroll
            for (int m = 0; m < 4; ++m) { const int r = ai * HALF + wr * 64 + m * 16 + fr; const size_t off = (size_t)(u.pm * BM + r) * DMODEL + col0; float s = 0.f;
#pragma unroll
                for (int bj = 0; bj < 2; ++bj)
#pragma unroll
                    for (int n = 0; n < 2; ++n) { const f32x4 v = *(const f32x4*)(xin + off + bj * HALF + n * 16) + acc[ai][bj][m][n];
                        *(f32x4*)(xout + off + bj * HALF + n * 16) = v; u32x2v w; w.x = cvt_pk_bf16(v[0], v[1]); w.y = cvt_pk_bf16(v[2], v[3]); *(u32x2v*)(xb + off + bj * HALF + n * 16) = w; s += sumsq4(v); }
                s += __shfl_xor(s, 16); s += __shfl_xor(s, 32);
                if (fq == 0) P[r * 4 + wc] = s;
                asm volatile("" ::: "memory"); }
        asm volatile("s_waitcnt lgkmcnt(0)" ::: "memory"); __builtin_amdgcn_s_barrier(); asm volatile("" ::: "memory");
        const int t = wid * 64 + lane;
        if (t < 256) { const PG8_LAS f32x4* P4 = (const PG8_LAS f32x4*)lds; const f32x4 p = P4[t]; ssq[(size_t)(u.pm * BM + t) * 4 + u.pn] = (p[0] + p[1]) + (p[2] + p[3]); }
        asm volatile("s_waitcnt lgkmcnt(0)" ::: "memory"); __builtin_amdgcn_s_barrier(); asm volatile("" ::: "memory");
    }
};
}
namespace at {
using bf16 = unsigned short;
using bf16x8 = __attribute__((ext_vector_type(8))) short;
using s16x4 = __attribute__((ext_vector_type(4))) short;
using f32x16 = __attribute__((ext_vector_type(16))) float;
using f32x4 = __attribute__((ext_vector_type(4))) float;
using u32x4 = __attribute__((ext_vector_type(4))) unsigned;
#define SBAR() __builtin_amdgcn_sched_barrier(0)
constexpr float THR2 = 8.f;
__device__ __forceinline__ int crow(int r, int hi) { return (r & 3) + 8 * (r >> 2) + 4 * hi; }
__device__ __forceinline__ unsigned cvtpk(float lo, float hi) { unsigned r; asm volatile("v_cvt_pk_bf16_f32 %0, %1, %2" : "=v"(r) : "v"(lo), "v"(hi)); return r; }
__device__ __forceinline__ float bf2f(short b) { return __uint_as_float(((unsigned)(unsigned short)b) << 16); }
template <int NB> __device__ __forceinline__ int v_st(int k, int c) { const int kk = (k & ~0xC) | ((k & 4) << 1) | ((k & 8) >> 1); return ((kk >> 3) * NB + (c >> 5)) * 512 + ((kk & 7) * 32 + (c & 31)) * 2; }
__device__ __forceinline__ int v_rd_base(int lane) { return ((lane & 3) << 3) | (((lane >> 2) & 3) << 6) | (((lane >> 4) & 1) << 5) | (((lane >> 5) & 1) << 8); }
template <int NB> constexpr int v_rd_off(int d0, int ks, int half) { return d0 * 512 + ks * (2 * NB * 512) + half * (NB * 512); }
template <int KRS> __device__ __forceinline__ int k_swz(int row) { return KRS == 128 ? (((row >> 1) & 7) << 4) : ((row & 7) << 4); }
template <int KRS> __device__ __forceinline__ int k_addr(int row, int chunk) { return row * KRS + ((chunk * 16) ^ k_swz<KRS>(row)); }

__device__ __forceinline__ void mask_tile(f32x16& p0, f32x16& p1, int dq) {
    const float NEG = -__builtin_inff();
#pragma unroll
    for (int r = 0; r < 16; ++r) { const int c = (r & 3) + 8 * (r >> 2); if (dq - c < 0) p0[r] = NEG; if (dq - c - 32 < 0) p1[r] = NEG; }
}
__device__ __forceinline__ void partialSM(f32x16& p0, f32x16& p1, float& m_reg, float& alpha) {
    float pmax = p0[0];
#pragma unroll
    for (int r = 1; r < 16; ++r) pmax = fmaxf(pmax, p0[r]);
#pragma unroll
    for (int r = 0; r < 16; ++r) pmax = fmaxf(pmax, p1[r]);
    { auto rr = __builtin_amdgcn_permlane32_swap(__float_as_uint(pmax), __float_as_uint(pmax), false, false); pmax = fmaxf(__uint_as_float(rr[0]), __uint_as_float(rr[1])); }
    float mn;
    if (__builtin_expect(__all(pmax - m_reg <= THR2), 1)) { mn = m_reg; alpha = 1.f; }
    else { mn = fmaxf(m_reg, pmax); alpha = __builtin_amdgcn_exp2f(m_reg - mn); m_reg = mn; }
#pragma unroll
    for (int r = 0; r < 16; ++r) { p0[r] -= mn; p1[r] -= mn; }
#pragma unroll
    for (int r = 0; r < 16; ++r) p0[r] = __builtin_amdgcn_exp2f(p0[r]);
}
#define AT_PK4(P, B_, OUT) do { unsigned a0 = cvtpk(P[B_ + 0], P[B_ + 1]), a1 = cvtpk(P[B_ + 2], P[B_ + 3]); unsigned b0 = cvtpk(P[B_ + 4], P[B_ + 5]), b1 = cvtpk(P[B_ + 6], P[B_ + 7]); \
        auto r0 = __builtin_amdgcn_permlane32_swap(a0, b0, false, false); auto r1 = __builtin_amdgcn_permlane32_swap(a1, b1, false, false); \
        u32x4 w = {r0[0], r1[0], r0[1], r1[1]}; OUT = *reinterpret_cast<bf16x8*>(&w); } while (0)
__device__ __forceinline__ void pack_p(const f32x16& p0, const f32x16& p1, bf16x8& pa0, bf16x8& pa1, bf16x8& pa2, bf16x8& pa3) { AT_PK4(p0, 0, pa0); AT_PK4(p0, 8, pa1); AT_PK4(p1, 0, pa2); AT_PK4(p1, 8, pa3); }
__device__ __forceinline__ void finishSM(f32x16& p0, f32x16& p1, float alpha, float& l_reg, bf16x8& pa0, bf16x8& pa1, bf16x8& pa2, bf16x8& pa3) {
#pragma unroll
    for (int r = 0; r < 16; ++r) p1[r] = __builtin_amdgcn_exp2f(p1[r]);
    float ps = 0;
#pragma unroll
    for (int r = 0; r < 16; ++r) ps += p0[r];
#pragma unroll
    for (int r = 0; r < 16; ++r) ps += p1[r];
    { auto rr = __builtin_amdgcn_permlane32_swap(__float_as_uint(ps), __float_as_uint(ps), false, false); ps = __uint_as_float(rr[0]) + __uint_as_float(rr[1]); }
    l_reg = l_reg * alpha + ps;
    pack_p(p0, p1, pa0, pa1, pa2, pa3);
}
template <int DQK, int KRS> __device__ __forceinline__ void qkt(f32x16& p0, f32x16& p1, const char* Kimg, int r32, int hi, const bf16x8* qr) {
    p0 = f32x16{}; p1 = f32x16{};
    const char* kb[4];
#pragma unroll
    for (int dd = 0; dd < 4; ++dd) kb[dd] = Kimg + k_addr<KRS>(r32, 2 * dd + hi);
#pragma unroll
    for (int d0 = 0; d0 < DQK / 16; ++d0) { const char* a = kb[d0 & 3] + (d0 >> 2) * 128;
        const bf16x8 b0 = *reinterpret_cast<const bf16x8*>(a), b1 = *reinterpret_cast<const bf16x8*>(a + 32 * KRS);
        p0 = __builtin_amdgcn_mfma_f32_32x32x16_bf16(b0, qr[d0], p0, 0, 0, 0);
        p1 = __builtin_amdgcn_mfma_f32_32x32x16_bf16(b1, qr[d0], p1, 0, 0, 0); }
}
template <int NB, int D0> __device__ __forceinline__ void pv_one(f32x16& od, int vb, bf16x8 pa0, bf16x8 pa1, bf16x8 pa2, bf16x8 pa3) {
    s16x4 l0, l1, l2, l3, h0, h1, h2, h3;
#define AT_TRRD(dst, off) asm volatile("ds_read_b64_tr_b16 %0, %1 offset:%2" : "=&v"(dst) : "v"(vb), "i"(off) : "memory")
    AT_TRRD(l0, (v_rd_off<NB>(D0, 0, 0))); AT_TRRD(h0, (v_rd_off<NB>(D0, 0, 1))); AT_TRRD(l1, (v_rd_off<NB>(D0, 1, 0))); AT_TRRD(h1, (v_rd_off<NB>(D0, 1, 1)));
    AT_TRRD(l2, (v_rd_off<NB>(D0, 2, 0))); AT_TRRD(h2, (v_rd_off<NB>(D0, 2, 1))); AT_TRRD(l3, (v_rd_off<NB>(D0, 3, 0))); AT_TRRD(h3, (v_rd_off<NB>(D0, 3, 1)));
#undef AT_TRRD
    asm volatile("s_waitcnt lgkmcnt(0)" ::: "memory"); SBAR();
#define AT_PK(L, H) (bf16x8){L[0], L[1], L[2], L[3], H[0], H[1], H[2], H[3]}
    od = __builtin_amdgcn_mfma_f32_32x32x16_bf16(pa0, AT_PK(l0, h0), od, 0, 0, 0);
    od = __builtin_amdgcn_mfma_f32_32x32x16_bf16(pa1, AT_PK(l1, h1), od, 0, 0, 0);
    od = __builtin_amdgcn_mfma_f32_32x32x16_bf16(pa2, AT_PK(l2, h2), od, 0, 0, 0);
    od = __builtin_amdgcn_mfma_f32_32x32x16_bf16(pa3, AT_PK(l3, h3), od, 0, 0, 0);
#undef AT_PK
}
template <int NB> __device__ __forceinline__ void pv_all(f32x16* o, int vb, bf16x8 pa0, bf16x8 pa1, bf16x8 pa2, bf16x8 pa3) {
    pv_one<NB, 0>(o[0], vb, pa0, pa1, pa2, pa3); pv_one<NB, 1>(o[1], vb, pa0, pa1, pa2, pa3);
    if constexpr (NB == 4) { pv_one<NB, 2>(o[2], vb, pa0, pa1, pa2, pa3); pv_one<NB, 3>(o[3], vb, pa0, pa1, pa2, pa3); }
}

template <int DQK, int DV, int LDQ, int LDK, int LDV, int LDO>
__device__ __forceinline__ void attn_unit(const bf16* __restrict__ Qb, const bf16* __restrict__ Kh, const bf16* __restrict__ Vh, bf16* __restrict__ Ob, int qb, char* lds) {
    constexpr int KRS = DQK == 64 ? 128 : 256, KB = 64 * KRS, NB = DV / 32, VB = 64 * DV * 2, KCH = DQK / 8, NKP = (64 * KCH + 511) / 512, VCH = DV / 8, NVP = 64 * VCH / 512;
    static_assert(NKP <= 2 && (NVP == 1 || NVP == 2), "staging piece counts");
    int tid_ = threadIdx.x; asm volatile("" : "+v"(tid_));
    const int tid = tid_, wid = __builtin_amdgcn_readfirstlane(tid >> 6), lane = tid & 63, r32 = lane & 31, hi = lane >> 5;
    char* V_lds = lds; char* K_lds = lds + 2 * VB;
    float* ws = (float*)(lds + 2 * VB + 2 * KB) + wid * 64; float* li_l = ws; float* al_l = ws + 32;
    float m_reg = -1e30f, l_reg = 0; f32x16 o[NB];
#pragma unroll
    for (int d = 0; d < NB; ++d) o[d] = f32x16{};
    bf16x8 qr[DQK / 16];
    const bf16* Qw = Qb + (size_t)(wid * 32 + r32) * LDQ + hi * 8;
#pragma unroll
    for (int d0 = 0; d0 < DQK / 16; ++d0) qr[d0] = *reinterpret_cast<const bf16x8*>(Qw + d0 * 16);
    const int kr0 = tid / KCH, kc0 = tid % KCH, kr1 = (tid + 512) / KCH, kc1 = (tid + 512) % KCH; const bool k2 = (NKP == 2) && (tid + 512 < 64 * KCH);
    const int kw0 = k_addr<KRS>(kr0, kc0), kw1 = k_addr<KRS>(kr1 & 63, kc1);
    const int vr = tid / VCH, vc = (tid % VCH) * 8, vst0 = v_st<NB>(vr, vc), vst1 = v_st<NB>((32 + vr) & 63, vc);
    const int vb0 = (int)(uintptr_t)V_lds + v_rd_base(lane);
    bf16x8 sk0, sk1, sv0, sv1;
#define AT_SLOAD(k0) do { sv0 = *reinterpret_cast<const bf16x8*>(Vh + (size_t)((k0) + vr) * LDV + vc); if (NVP == 2) sv1 = *reinterpret_cast<const bf16x8*>(Vh + (size_t)((k0) + 32 + vr) * LDV + vc); \
        sk0 = *reinterpret_cast<const bf16x8*>(Kh + (size_t)((k0) + kr0) * LDK + kc0 * 8); if (k2) sk1 = *reinterpret_cast<const bf16x8*>(Kh + (size_t)((k0) + kr1) * LDK + kc1 * 8); } while (0)
#define AT_SWRITE(b) do { *(bf16x8*)(V_lds + (b) * VB + vst0) = sv0; if (NVP == 2) *(bf16x8*)(V_lds + (b) * VB + vst1) = sv1; \
        *(bf16x8*)(K_lds + (b) * KB + kw0) = sk0; if (k2) *(bf16x8*)(K_lds + (b) * KB + kw1) = sk1; } while (0)
#define AT_VMW() asm volatile("s_waitcnt vmcnt(0)" ::: "memory")
#define AT_RESC(a) do { if (__any((a) < 1.f)) { if (hi == 0) al_l[r32] = (a); asm volatile("s_waitcnt lgkmcnt(0)" ::: "memory"); \
        _Pragma("unroll") for (int d_ = 0; d_ < NB; ++d_) _Pragma("unroll") for (int r = 0; r < 16; ++r) o[d_][r] *= al_l[crow(r, hi)]; } } while (0)
    const int NT = 4 * (qb + 1);
    const int qlo = 256 * qb + wid * 32, qm = qlo + r32 - 4 * hi;
#define AT_MASK(P0_, P1_, t) do { const int kb_ = (t) * 64; if (kb_ + 63 > qlo) mask_tile(P0_, P1_, qm - kb_); } while (0)
    f32x16 pA0, pA1, pB0, pB1; float alA, alB; bf16x8 pa0, pa1, pa2, pa3;
    AT_SLOAD(0); AT_VMW(); AT_SWRITE(0); __syncthreads();
    qkt<DQK, KRS>(pA0, pA1, K_lds, r32, hi, qr); AT_MASK(pA0, pA1, 0); partialSM(pA0, pA1, m_reg, alA);
    AT_SLOAD(64); AT_VMW(); AT_SWRITE(1); __syncthreads();
    for (int j = 1; j + 1 < NT; j += 2) {
        SBAR(); qkt<DQK, KRS>(pB0, pB1, K_lds + KB, r32, hi, qr);
        finishSM(pA0, pA1, alA, l_reg, pa0, pa1, pa2, pa3); SBAR();
        AT_SLOAD((j + 1) * 64); SBAR();
        pv_all<NB>(o, vb0, pa0, pa1, pa2, pa3); AT_MASK(pB0, pB1, j); partialSM(pB0, pB1, m_reg, alB);
        __syncthreads(); AT_VMW(); AT_SWRITE(0);
        AT_RESC(alB); __syncthreads();
        SBAR(); qkt<DQK, KRS>(pA0, pA1, K_lds, r32, hi, qr);
        finishSM(pB0, pB1, alB, l_reg, pa0, pa1, pa2, pa3); SBAR();
        AT_SLOAD((j + 2) * 64); SBAR();
        pv_all<NB>(o, vb0 + VB, pa0, pa1, pa2, pa3); AT_MASK(pA0, pA1, j + 1); partialSM(pA0, pA1, m_reg, alA);
        __syncthreads(); AT_VMW(); AT_SWRITE(1);
        AT_RESC(alA); __syncthreads();
    }
    SBAR(); qkt<DQK, KRS>(pB0, pB1, K_lds + KB, r32, hi, qr);
    finishSM(pA0, pA1, alA, l_reg, pa0, pa1, pa2, pa3); SBAR();
    pv_all<NB>(o, vb0, pa0, pa1, pa2, pa3); AT_MASK(pB0, pB1, NT - 1); partialSM(pB0, pB1, m_reg, alB);
    AT_RESC(alB);
    finishSM(pB0, pB1, alB, l_reg, pa0, pa1, pa2, pa3); SBAR();
    pv_all<NB>(o, vb0 + VB, pa0, pa1, pa2, pa3);
    if (hi == 0) li_l[r32] = l_reg; asm volatile("s_waitcnt lgkmcnt(0)" ::: "memory");
    float rli[16];
#pragma unroll
    for (int r = 0; r < 16; ++r) rli[r] = __builtin_amdgcn_rcpf(li_l[crow(r, hi)]);
    bf16* Ow = Ob + (size_t)(wid * 32) * LDO;
#pragma unroll
    for (int r = 0; r < 16; ++r) { const int orow = crow(r, hi);
#pragma unroll
        for (int d0 = 0; d0 < NB; ++d0) { const float v = o[d0][r] * rli[r]; const float vn = __shfl_xor(v, 1);
            if ((r32 & 1) == 0) *(unsigned*)(Ow + (size_t)orow * LDO + d0 * 32 + r32) = cvtpk(v, vn); } }
    __syncthreads();
#undef AT_SLOAD
#undef AT_SWRITE
#undef AT_VMW
#undef AT_RESC
#undef AT_MASK
}
}
namespace ret {
using namespace at;
__device__ __forceinline__ float log2_gamma(int h) { return h == 0 ? -0.04580368961312479f : h == 1 ? -0.02272007650008353f : h == 2 ? -0.011315313227834146f : -0.005646563141142063f; }
constexpr int IMG = 8192;
template <int OFF> __device__ __forceinline__ s16x4 trr(int vb) { s16x4 r; asm volatile("ds_read_b64_tr_b16 %0, %1 offset:%2" : "=&v"(r) : "v"(vb), "i"(OFF) : "memory"); return r; }

__device__ __forceinline__ void state_item(const bf16* __restrict__ RK, const bf16* __restrict__ RV, float* __restrict__ AST, int b, int h, int cp, char* lds) {
    int tid_ = threadIdx.x; asm volatile("" : "+v"(tid_));
    const int tid = tid_, wid = __builtin_amdgcn_readfirstlane(tid >> 6), lane = tid & 63, r32 = lane & 31, hi = lane >> 5;
    const float l2g = log2_gamma(h);
    const size_t row0 = (size_t)b * SEQ + 256 * cp;
    const int key = tid >> 3, c = (tid & 7) * 8, vst = v_st<2>(key, c);
    bf16x8 kk[4], vv[4];
#pragma unroll
    for (int t = 0; t < 4; ++t) { kk[t] = *reinterpret_cast<const bf16x8*>(RK + (row0 + 64 * t + key) * 256 + h * 64 + c); vv[t] = *reinterpret_cast<const bf16x8*>(RV + (row0 + 64 * t + key) * 256 + h * 64 + c); }
#pragma unroll
    for (int t = 0; t < 4; ++t) { const int j = (64 * t + key) & 127; const float z = __builtin_amdgcn_exp2f((float)(127 - j) * l2g);
        u32x4 w; w.x = cvtpk(bf2f(kk[t][0]) * z, bf2f(kk[t][1]) * z); w.y = cvtpk(bf2f(kk[t][2]) * z, bf2f(kk[t][3]) * z); w.z = cvtpk(bf2f(kk[t][4]) * z, bf2f(kk[t][5]) * z); w.w = cvtpk(bf2f(kk[t][6]) * z, bf2f(kk[t][7]) * z);
        *(u32x4*)(lds + t * IMG + vst) = w; *(bf16x8*)(lds + (4 + t) * IMG + vst) = vv[t]; }
    __syncthreads();
    const int half = wid >> 2, db = (wid >> 1) & 1, eb = wid & 1;
    const int va = (int)(uintptr_t)lds + v_rd_base(lane) + db * 512, vb = (int)(uintptr_t)lds + 4 * IMG + v_rd_base(lane) + eb * 512;
    f32x16 acc = f32x16{};
#define RT_STEP(T, KS) do { const s16x4 al = trr<(T) * IMG + v_rd_off<2>(0, KS, 0)>(va2), ah = trr<(T) * IMG + v_rd_off<2>(0, KS, 1)>(va2), bl = trr<(T) * IMG + v_rd_off<2>(0, KS, 0)>(vb2), bh = trr<(T) * IMG + v_rd_off<2>(0, KS, 1)>(vb2); \
        asm volatile("s_waitcnt lgkmcnt(0)" ::: "memory"); SBAR(); \
        acc = __builtin_amdgcn_mfma_f32_32x32x16_bf16((bf16x8){al[0], al[1], al[2], al[3], ah[0], ah[1], ah[2], ah[3]}, (bf16x8){bl[0], bl[1], bl[2], bl[3], bh[0], bh[1], bh[2], bh[3]}, acc, 0, 0, 0); } while (0)
    { const int va2 = va + half * 2 * IMG, vb2 = vb + half * 2 * IMG;
      RT_STEP(0, 0); RT_STEP(0, 1); RT_STEP(0, 2); RT_STEP(0, 3); RT_STEP(1, 0); RT_STEP(1, 1); RT_STEP(1, 2); RT_STEP(1, 3); }
#undef RT_STEP
    float* dst = AST + ((size_t)((b * 4 + h) * 64 + 2 * cp + half)) * 4096 + (size_t)(32 * db) * 64 + 32 * eb + r32;
#pragma unroll
    for (int r = 0; r < 16; ++r) dst[crow(r, hi) * 64] = acc[r];
    __syncthreads();
}

__device__ __forceinline__ void ret_unit(const bf16* __restrict__ RQ, const bf16* __restrict__ RK, const bf16* __restrict__ RV, const bf16* __restrict__ RG, const float* __restrict__ AST,
                                         const float* __restrict__ gnw, const float* __restrict__ gnb, bf16* __restrict__ MIX, int b, int h, int cp, char* lds) {
    int tid_ = threadIdx.x; asm volatile("" : "+v"(tid_));
    const int tid = tid_, wid = __builtin_amdgcn_readfirstlane(tid >> 6), lane = tid & 63, r32 = lane & 31, hi = lane >> 5;
    const float l2g = log2_gamma(h);
    const size_t row0 = (size_t)b * SEQ + 256 * cp;
    char* K_lds = lds; char* V_lds = lds + 4 * IMG; char* R_lds = lds + 8 * IMG; char* S_lds = lds;
    { const int key = tid >> 3, ch = tid & 7, c = ch * 8, vst = v_st<2>(key, c), kst = k_addr<128>(key, ch);
      bf16x8 kk[4], vv[4];
#pragma unroll
      for (int t = 0; t < 4; ++t) { kk[t] = *reinterpret_cast<const bf16x8*>(RK + (row0 + 64 * t + key) * 256 + h * 64 + c); vv[t] = *reinterpret_cast<const bf16x8*>(RV + (row0 + 64 * t + key) * 256 + h * 64 + c); }
      const float gC = __builtin_amdgcn_exp2f(128.f * l2g);
      const float* ap = AST + (size_t)((b * 4 + h) * 64) * 4096 + (size_t)key * 64 + c;
      f32x4 r0 = {0.f, 0.f, 0.f, 0.f}, r1 = {0.f, 0.f, 0.f, 0.f};
      const int nprev = 2 * cp;
      for (int j = 0; j < nprev; j += 2) {
          const f32x4 a0 = *(const f32x4*)(ap + (size_t)j * 4096), a1 = *(const f32x4*)(ap + (size_t)j * 4096 + 4), b0 = *(const f32x4*)(ap + (size_t)(j + 1) * 4096), b1 = *(const f32x4*)(ap + (size_t)(j + 1) * 4096 + 4);
          r0 = a0 + r0 * gC; r1 = a1 + r1 * gC; r0 = b0 + r0 * gC; r1 = b1 + r1 * gC; }
      *(u32x4*)(R_lds + vst) = (u32x4){cvtpk(r0[0], r0[1]), cvtpk(r0[2], r0[3]), cvtpk(r1[0], r1[1]), cvtpk(r1[2], r1[3])};
      { const f32x4 a0 = *(const f32x4*)(ap + (size_t)nprev * 4096), a1 = *(const f32x4*)(ap + (size_t)nprev * 4096 + 4); r0 = a0 + r0 * gC; r1 = a1 + r1 * gC; }
      *(u32x4*)(R_lds + IMG + vst) = (u32x4){cvtpk(r0[0], r0[1]), cvtpk(r0[2], r0[3]), cvtpk(r1[0], r1[1]), cvtpk(r1[2], r1[3])};
#pragma unroll
      for (int t = 0; t < 4; ++t) { *(bf16x8*)(K_lds + t * IMG + kst) = kk[t]; *(bf16x8*)(V_lds + t * IMG + vst) = vv[t]; }
    }
    __syncthreads();
    const int half = wid >> 2, wq = wid & 3;
    bf16x8 qr[4];
    { const bf16* Qw = RQ + (row0 + 128 * half + 32 * wq + r32) * 256 + h * 64 + hi * 8;
#pragma unroll
      for (int d0 = 0; d0 < 4; ++d0) qr[d0] = *reinterpret_cast<const bf16x8*>(Qw + d0 * 16); }
    f32x16 o[2]; o[0] = f32x16{}; o[1] = f32x16{};
    const int vbase = (int)(uintptr_t)V_lds + v_rd_base(lane);
    const int iq = 32 * wq + r32;
#pragma unroll
    for (int tt = 0; tt < 2; ++tt) {
        if (64 * tt > 32 * wq + 31) continue;
        f32x16 p0, p1; bf16x8 pa0, pa1, pa2, pa3;
        qkt<64, 128>(p0, p1, K_lds + (2 * half + tt) * IMG, r32, hi, qr);
#pragma unroll
        for (int r = 0; r < 16; ++r) { const int d0_ = iq - (64 * tt + crow(r, hi)), d1_ = d0_ - 32;
            p0[r] = d0_ >= 0 ? p0[r] * __builtin_amdgcn_exp2f((float)d0_ * l2g) : 0.f; p1[r] = d1_ >= 0 ? p1[r] * __builtin_amdgcn_exp2f((float)d1_ * l2g) : 0.f; }
        pack_p(p0, p1, pa0, pa1, pa2, pa3);
        pv_all<2>(o, vbase + (2 * half + tt) * IMG, pa0, pa1, pa2, pa3);
    }
    { f32x16 oc[2]; oc[0] = f32x16{}; oc[1] = f32x16{};
      pv_all<2>(oc, (int)(uintptr_t)R_lds + half * IMG + v_rd_base(lane), qr[0], qr[1], qr[2], qr[3]);
#pragma unroll
      for (int r = 0; r < 16; ++r) { const float xi = __builtin_amdgcn_exp2f((float)(32 * wq + crow(r, hi) + 1) * l2g); o[0][r] += oc[0][r] * xi; o[1][r] += oc[1][r] * xi; } }
    __syncthreads();
    float* st = (float*)(S_lds + wid * 8448);
#pragma unroll
    for (int r = 0; r < 16; ++r) { st[crow(r, hi) * 66 + r32] = o[0][r]; st[crow(r, hi) * 66 + 32 + r32] = o[1][r]; }
    asm volatile("s_waitcnt lgkmcnt(0)" ::: "memory");
    { const int rr = lane >> 1, hh = lane & 1; const float* sp = st + rr * 66 + hh * 32; float x[32]; float s = 0.f;
#pragma unroll
      for (int k = 0; k < 32; ++k) { x[k] = sp[k]; s += x[k]; }
      s += __shfl_xor(s, 1); const float mean = s * (1.0f / 64.0f); float q = 0.f;
#pragma unroll
      for (int k = 0; k < 32; ++k) { x[k] -= mean; q += x[k] * x[k]; }
      q += __shfl_xor(q, 1); const float rstd = 1.0f / sqrtf(q * (1.0f / 64.0f) + 1e-6f);
      const size_t grow = row0 + 128 * half + 32 * wq + rr; const int cb = h * 64 + hh * 32;
      const bf16* gp = RG + grow * 256 + cb; bf16* op = MIX + grow * 1024 + 768 + cb;
#pragma unroll
      for (int k8 = 0; k8 < 4; ++k8) { const bf16x8 g8 = *reinterpret_cast<const bf16x8*>(gp + 8 * k8); const f32x4 w0 = *(const f32x4*)(gnw + cb + 8 * k8), w1 = *(const f32x4*)(gnw + cb + 8 * k8 + 4), bb0 = *(const f32x4*)(gnb + cb + 8 * k8), bb1 = *(const f32x4*)(gnb + cb + 8 * k8 + 4);
          float y[8];
#pragma unroll
          for (int k = 0; k < 8; ++k) y[k] = (x[8 * k8 + k] * rstd * (k < 4 ? w0[k & 3] : w1[k & 3]) + (k < 4 ? bb0[k & 3] : bb1[k & 3])) * bf2f(g8[k]);
          *(u32x4*)(op + 8 * k8) = (u32x4){cvtpk(y[0], y[1]), cvtpk(y[2], y[3]), cvtpk(y[4], y[5]), cvtpk(y[6], y[7])}; } }
    __syncthreads();
}

__device__ __forceinline__ void combine_row(const bf16* __restrict__ OD, const float* __restrict__ subln, float lam, float oml, bf16* __restrict__ MIX, size_t row, int lane) {
    const int head = lane >> 4, e0 = (lane & 15) * 8;
    const bf16x8 a = *reinterpret_cast<const bf16x8*>(OD + row * 1024 + head * 256 + e0), b2 = *reinterpret_cast<const bf16x8*>(OD + row * 1024 + head * 256 + 128 + e0);
    float o[8]; float s = 0.f;
#pragma unroll
    for (int k = 0; k < 8; ++k) { o[k] = bf2f(a[k]) - lam * bf2f(b2[k]); s += o[k] * o[k]; }
    s += __shfl_xor(s, 1); s += __shfl_xor(s, 2); s += __shfl_xor(s, 4); s += __shfl_xor(s, 8);
    const float rs = oml / sqrtf(s * (1.0f / 128.0f) + 1e-5f);
    const f32x4 g0 = *(const f32x4*)(subln + e0), g1 = *(const f32x4*)(subln + e0 + 4);
    *(u32x4*)(MIX + row * 1024 + head * 128 + e0) = (u32x4){cvtpk(o[0] * rs * g0[0], o[1] * rs * g0[1]), cvtpk(o[2] * rs * g0[2], o[3] * rs * g0[3]), cvtpk(o[4] * rs * g1[0], o[5] * rs * g1[1]), cvtpk(o[6] * rs * g1[2], o[7] * rs * g1[3])};
}
}
constexpr size_t MiB = 1u << 20;
constexpr size_t WS_CTL = 0, CTL_ZERO_BYTES = 1 * MiB;
constexpr size_t WS_WIN = 1 * MiB, WS_WUQ = 7 * MiB, WS_WUKV = WS_WUQ + 256 * 1024, WS_WOUT = WS_WUKV + 256 * 1024, WS_WGU = WS_WOUT + 2 * MiB, WS_WDN = WS_WGU + 11 * MiB;
constexpr size_t WS_XB = 26 * MiB;
constexpr size_t WS_T64 = 58 * MiB, WS_TM = 62 * MiB;
constexpr size_t WS_AST = 64 * MiB;
constexpr size_t WS_SSQ = 72 * MiB, WS_CQS = WS_SSQ + 256 * 1024, WS_CKVS = WS_CQS + 256 * 1024;
constexpr size_t WS_A = 73 * MiB;
constexpr size_t WS_DQ = WS_A, WS_DK = WS_DQ + 16 * MiB, WS_DV = WS_DK + 16 * MiB, WS_CQ = WS_DV + 16 * MiB, WS_CKV = WS_CQ + 8 * MiB, WS_MQ = WS_CKV + 8 * MiB, WS_MK = WS_MQ + 12 * MiB,
                 WS_MV = WS_MK + 12 * MiB, WS_RQ = WS_MV + 8 * MiB, WS_RK = WS_RQ + 8 * MiB, WS_RV = WS_RK + 8 * MiB, WS_RG = WS_RV + 8 * MiB, WS_MIX = WS_RG + 8 * MiB, WS_END = WS_MIX + 32 * MiB;
constexpr size_t WS_H = WS_A;
static_assert(WS_WDN + (size_t)1024 * FFH * 2 <= WS_XB && WS_H + (size_t)MTOK * FFH * 2 <= WS_MV && WS_END <= 256 * MiB, "d_ws map");
constexpr int CW_TMO = 0, CW_BAR = 4096, CW_Q = 8192;
constexpr int RING_BYTES = 131072, LDSCTL_OFF = RING_BYTES, MISC_OFF = LDSCTL_OFF + 320, LDS_BYTES = 147456;
constexpr int NWAVES = 8;

#ifndef MK_N_LAUNCHES
#define MK_N_LAUNCHES 16
#endif
constexpr int N_PHASES = 16;

struct Args { const void* in[21]; float* out; unsigned char* ws; int ph_lo, ph_hi; };
static_assert(sizeof(Args) == 23 * 8 + 8, "no padding");

__device__ __forceinline__ float wave_sum(float v) {
#pragma unroll
    for (int o = 1; o < 64; o <<= 1) v += __shfl_xor(v, o);
    return v;
}
__device__ const float INVF[32] = { 1.000000000e+00f, 7.498942018e-01f, 5.623413324e-01f, 4.216965139e-01f, 3.162277639e-01f, 2.371373922e-01f, 1.778279394e-01f, 1.333521456e-01f, 1.000000015e-01f, 7.498941571e-02f, 5.623412877e-02f,
    4.216964915e-02f, 3.162277862e-02f, 2.371373586e-02f, 1.778279431e-02f, 1.333521493e-02f, 9.999999776e-03f, 7.498942316e-03f, 5.623413250e-03f, 4.216964822e-03f, 3.162277862e-03f, 2.371373819e-03f, 1.778279431e-03f,
    1.333521446e-03f, 1.000000047e-03f, 7.498941850e-04f, 5.623413017e-04f, 4.216965463e-04f, 3.162277862e-04f, 2.371373848e-04f, 1.778279402e-04f, 1.333521504e-04f };

struct WSrc { const float *w_in, *attn_norm, *w_uq, *q_norm, *w_ukv, *kv_norm, *w_out, *w_gate, *w_up, *ffn_norm, *w_down; };
__device__ __forceinline__ int ckv_slot(int p) { const int x = p & 127; if (x < 16) return -1; const int s = ((p >> 7) ? 112 : 0) + x - 16; return s < 128 ? s : -1; }
__device__ __forceinline__ float src_in(const WSrc& w, int n, int k) {
    const int pn = n >> 8, q = n & 255, bj = q >> 7, x = q & 127, wc = x >> 5, y = x & 31, rp = 64 * wc + 32 * bj + y; int c;
    switch (pn) {
        case 0: case 1: c = 256 * pn + rp; break;
        case 2: case 3: c = 512 + 256 * (pn - 2) + rp; break;
        case 4: case 5: c = 1024 + 256 * (pn - 4) + q; break;
        case 6: c = 1536 + q; break;
        case 7: if (x < 16) c = 1920 + 16 * bj + x; else { const int s = ckv_slot(q); if (s < 0) return 0.f; c = 1792 + s; } break;
        case 8: c = 1952 + rp; break;
        case 9: c = 2208 + rp; break;
        case 10: c = 2464 + q; break;
        default: c = 2720 + q; break;
    }
    return w.w_in[(size_t)k * IN_COLS + c] * w.attn_norm[k];
}
__device__ __forceinline__ float src_uq(const WSrc& w, int n, int k) {
    const int pn = n >> 8, q = n & 255, bj = q >> 7, x = q & 127, wc = x >> 5, y = x & 31, head = 2 * pn + (wc >> 1); int c;
    if ((wc & 1) == 0) c = head * 96 + 32 * bj + y; else { if (y >= 16) return 0.f; c = head * 96 + 64 + 16 * bj + y; }
    return w.w_uq[(size_t)k * 384 + c] * w.q_norm[k];
}
__device__ __forceinline__ float src_ukv(const WSrc& w, int n, int k) {
    const int pn = n >> 8, q = n & 255, bj = q >> 7, x = q & 127, wc = x >> 5, y = x & 31, head = 2 * pn + (wc >> 1), c = head * 128 + 64 * (wc & 1) + 32 * bj + y;
    const int s = ckv_slot(k); if (s < 0) return 0.f;
    return w.w_ukv[(size_t)s * 512 + c] * w.kv_norm[s];
}
__device__ __forceinline__ float src_out(const WSrc& w, int n, int k) { return w.w_out[(size_t)k * 1024 + n]; }
__device__ __forceinline__ float src_gu(const WSrc& w, int n, int k) { const int c = 128 * (n >> 8) + (n & 127); return ((n >> 7) & 1 ? w.w_up : w.w_gate)[(size_t)k * FFH + c] * w.ffn_norm[k]; }
__device__ __forceinline__ float src_dn(const WSrc& w, int n, int k) { return w.w_down[(size_t)k * 1024 + n]; }

template <int WHICH> __device__ __forceinline__ void wconv_item(const WSrc& w, bf16* WT, int K, int N, LAS float* scr, int item, int lane) {
    const int nblk = N / 32, kb = item / nblk, nb = item % nblk, k0 = 64 * kb, n0 = 32 * nb;
#pragma unroll 4
    for (int i = 0; i < 32; ++i) { const int kk = 2 * i + (lane >> 5), n = n0 + (lane & 31), k = k0 + kk; float v;
        if (WHICH == 0) v = src_in(w, n, k); else if (WHICH == 1) v = src_uq(w, n, k); else if (WHICH == 2) v = src_ukv(w, n, k); else if (WHICH == 3) v = src_out(w, n, k); else if (WHICH == 4) v = src_gu(w, n, k); else v = src_dn(w, n, k);
        scr[kk * 33 + (lane & 31)] = v; }
    LDS_WAIT(); asm volatile("" ::: "memory");
    const int c = lane & 7;
#pragma unroll
    for (int j = 0; j < 4; ++j) { const int n = (lane >> 3) + 8 * j; const LAS float* s = scr + (8 * c) * 33 + n;
        v4u o; o.x = pk2(s[0 * 33], s[1 * 33]); o.y = pk2(s[2 * 33], s[3 * 33]); o.z = pk2(s[4 * 33], s[5 * 33]); o.w = pk2(s[6 * 33], s[7 * 33]);
        *(GAS v4u*)(WT + (size_t)(n0 + n) * K + k0 + 8 * c) = o; }
    LDS_WAIT(); asm volatile("" ::: "memory");
}
__device__ __forceinline__ void convert_group(const Args& a, unsigned char* ws, int layer, int grp, LAS unsigned char* lds, int gw, int NGW, int wave, int lane) {
    WSrc w;
    w.w_in = (const float*)a.in[3] + (size_t)layer * 1024 * IN_COLS; w.attn_norm = (const float*)a.in[2] + layer * 1024;
    w.w_uq = (const float*)a.in[10] + (size_t)layer * 256 * 384; w.q_norm = (const float*)a.in[9] + layer * 256;
    w.w_ukv = (const float*)a.in[12] + (size_t)layer * 128 * 512; w.kv_norm = (const float*)a.in[11] + layer * 128;
    w.w_out = (const float*)a.in[15] + (size_t)layer * 1024 * 1024; w.ffn_norm = (const float*)a.in[16] + layer * 1024;
    w.w_gate = (const float*)a.in[17] + (size_t)layer * 1024 * FFH; w.w_up = (const float*)a.in[18] + (size_t)layer * 1024 * FFH; w.w_down = (const float*)a.in[19] + (size_t)layer * FFH * 1024;
    LAS float* scr = (LAS float*)(lds + wave * 16384);
    if (grp == 0) {
        constexpr int I0 = (1024 / 64) * (NIN / 32), I1 = (256 / 64) * (512 / 32), I2 = I1;
        for (int it = gw; it < I0 + I1 + I2; it += NGW) {
            if (it < I0) wconv_item<0>(w, (bf16*)(ws + WS_WIN), 1024, NIN, scr, it, lane);
            else if (it < I0 + I1) wconv_item<1>(w, (bf16*)(ws + WS_WUQ), 256, 512, scr, it - I0, lane);
            else wconv_item<2>(w, (bf16*)(ws + WS_WUKV), 256, 512, scr, it - I0 - I1, lane);
        }
    } else {
        constexpr int I0 = (1024 / 64) * (1024 / 32), I1 = (1024 / 64) * (NGU / 32), I2 = (FFH / 64) * (1024 / 32);
        for (int it = gw; it < I0 + I1 + I2; it += NGW) {
            if (it < I0) wconv_item<3>(w, (bf16*)(ws + WS_WOUT), 1024, 1024, scr, it, lane);
            else if (it < I0 + I1) wconv_item<4>(w, (bf16*)(ws + WS_WGU), 1024, NGU, scr, it - I0, lane);
            else wconv_item<5>(w, (bf16*)(ws + WS_WDN), FFH, 1024, scr, it - I0 - I1, lane);
        }
    }
}

__global__ void __launch_bounds__(NWAVES * 64, 2) hyb_fwd(Args args) {
    extern __shared__ __attribute__((aligned(16))) unsigned char lds[];
    LAS unsigned char* L = (LAS unsigned char*)lds;
    volatile LAS unsigned* MISC = (volatile LAS unsigned*)(L + MISC_OFF);
    const int tid = threadIdx.x, lane = tid & 63, wave = __builtin_amdgcn_readfirstlane(tid >> 6);
    const int G = gridDim.x, bx = blockIdx.x, vcu = (G % 8 == 0) ? (bx % 8) * (G / 8) + bx / 8 : bx;
    const int gw = vcu * NWAVES + wave, NGW = G * NWAVES;
    unsigned char* ws = args.ws;
    gu32* ctl = (gu32*)(ws + WS_CTL);
    for (int u = tid; u < (LDS_BYTES - LDSCTL_OFF) / 4; u += NWAVES * 64) ((LAS unsigned*)(L + LDSCTL_OFF))[u] = 0u;
    __syncthreads();
    XcdBarrier bar; bar.bar = (unsigned*)(ctl + CW_BAR); bar.x = 0; bar.st = nullptr;
    if (MK_N_LAUNCHES == 1) bar = xcd_barrier_post((unsigned*)(ctl + CW_BAR), MISC + 8);
#define GRID_BAR() do { if (MK_N_LAUNCHES == 1) xcd_barrier(bar); } while (0)
    const int lo = args.ph_lo, hi = args.ph_hi;
#ifndef PH_MASK
#define PH_MASK 0xff
#endif
#define PHON(j) ((PH_MASK >> (j)) & 1)
#define IN(k) (lo <= (k) && (k) < hi)
#define BOTH(k) (IN(k) && IN((k) + 1))
    const float* x_in = (const float*)args.in[0];
    float* out = args.out;
    bf16* XB = (bf16*)(ws + WS_XB); bf16* OD = XB;
    float* T64 = (float*)(ws + WS_T64); float* TM = (float*)(ws + WS_TM); float* AST = (float*)(ws + WS_AST);
    float* SSQ = (float*)(ws + WS_SSQ); float* CQS = (float*)(ws + WS_CQS); float* CKVS = (float*)(ws + WS_CKVS);
    bf16 *DQ = (bf16*)(ws + WS_DQ), *DK = (bf16*)(ws + WS_DK), *DV = (bf16*)(ws + WS_DV), *CQ = (bf16*)(ws + WS_CQ), *CKV = (bf16*)(ws + WS_CKV), *MQ = (bf16*)(ws + WS_MQ), *MK = (bf16*)(ws + WS_MK), *MV = (bf16*)(ws + WS_MV),
         *RQ = (bf16*)(ws + WS_RQ), *RK = (bf16*)(ws + WS_RK), *RV = (bf16*)(ws + WS_RV), *RG = (bf16*)(ws + WS_RG), *MIX = (bf16*)(ws + WS_MIX), *HB = (bf16*)(ws + WS_H);

    if (PHON(7) && IN(0)) {
        int tid_o = tid; asm volatile("" : "+v"(tid_o)); const int lane_o = tid_o & 63;
        convert_group(args, ws, 0, 0, L, gw, NGW, wave, lane_o);
        convert_group(args, ws, 0, 1, L, gw, NGW, wave, lane_o);
        for (int m = gw; m < MTOK; m += NGW) {
            const GAS f32x4* xr = (const GAS f32x4*)(x_in + (size_t)m * DMODEL) + lane_o; GAS unsigned long long* o8 = (GAS unsigned long long*)(XB + (size_t)m * DMODEL) + lane_o; float s = 0.f;
#pragma unroll
            for (int j = 0; j < 4; ++j) { const f32x4 v = xr[64 * j]; s += (v.x * v.x + v.y * v.y) + (v.z * v.z + v.w * v.w); o8[64 * j] = (unsigned long long)pk2(v.x, v.y) | ((unsigned long long)pk2(v.z, v.w) << 32); }
            s = wave_sum(s);
            if (lane_o == 0) *(GAS f32x4*)(SSQ + (size_t)m * 4) = (f32x4){s, 0.f, 0.f, 0.f};
        }
        const int* pos = (const int*)args.in[1];
        for (int i = bx * (NWAVES * 64) + tid_o; i < MTOK * 32; i += G * NWAVES * 64) {
            const int row = i >> 5, f = i & 31; const float ang = (float)pos[row] * INVF[f];
            const double ad = (double)ang, kd = __builtin_rint(ad * 0.15915494309189535), rd = __builtin_fma(-kd, 6.283185307179586, ad);
            const float rev = (float)(rd * 0.15915494309189535), sn = __builtin_amdgcn_sinf(rev), cs = __builtin_amdgcn_cosf(rev);
            T64[(size_t)row * 64 + f] = cs; T64[(size_t)row * 64 + 32 + f] = sn;
            if ((f & 1) == 0) { TM[(size_t)row * 32 + (f >> 1)] = cs; TM[(size_t)row * 32 + 16 + (f >> 1)] = sn; }
        }
        if (BOTH(0)) GRID_BAR();
    }

#pragma unroll 1
    for (int layer = 0; layer < DEPTH; ++layer) {
        const int P = 1 + 7 * layer;
        if (PHON(0) && IN(P)) {
            pg8::Gemm g{XB, (const bf16*)(ws + WS_WIN), MTOK, NIN, DMODEL}; pg8::StaticOrder S; S.init(MTOK, NIN, G, bx);
            pg8::EpiG1 E{SSQ, T64, TM, DQ, DK, DV, CQ, CKV, MK, RQ, RK, RV, RG, CQS, CKVS};
            pg8::gemm_phase<pg8::EpiG1, pg8::StaticOrder, true, true>(L, g, S, E);
            if (BOTH(P)) GRID_BAR();
        }
        if (PHON(1) && IN(P + 1)) {
#ifndef M1_MASK
#define M1_MASK 7
#endif
            if (M1_MASK & 1) { pg8::Gemm g{CQ, (const bf16*)(ws + WS_WUQ), MTOK, 512, 256}; pg8::StaticOrder S; S.init(MTOK, 512, G, bx);
              pg8::EpiMQ E{CQS, TM, MQ}; pg8::gemm_phase<pg8::EpiMQ, pg8::StaticOrder, true, true>(L, g, S, E); }
            if (M1_MASK & 2) { pg8::Gemm g{CKV, (const bf16*)(ws + WS_WUKV), MTOK, 512, 256}; pg8::StaticOrder S; S.init(MTOK, 512, G, (bx + G / 2) % G);
              pg8::EpiMKV E{CKVS, MK, MV}; pg8::gemm_phase<pg8::EpiMKV, pg8::StaticOrder, true, true>(L, g, S, E); }
            if (M1_MASK & 4) for (int u = bx; u < 256; u += G) ret::state_item(RK, RV, AST, u >> 7, (u >> 5) & 3, u & 31, (char*)lds);
            if (BOTH(P + 1)) GRID_BAR();
        }
        if (PHON(2) && IN(P + 2)) {
            gu32* qh = ctl + CW_Q + layer * 1024; const unsigned myx = xb_xcc_id() & 7u;
            for (unsigned s = 0; s < 8; ++s) { const unsigned xq = (myx + s) & 7u;
                for (;;) {
                    if (tid == 0) MISC[0] = __hip_atomic_fetch_add(qh + 64 * xq, 1u, __ATOMIC_RELAXED, __HIP_MEMORY_SCOPE_AGENT);
                    __syncthreads(); const unsigned idx = MISC[0]; __syncthreads();
                    if (idx >= 96u) break;
                    const int qb = 31 - (int)(idx / 3u), kind = (int)(idx % 3u), b = (int)(xq >> 2), head = (int)(xq & 3u);
                    const size_t r0 = (size_t)b * SEQ, rq = r0 + 256 * qb;
                    if (kind < 2) at::attn_unit<64, 128, 512, 512, 512, 1024>(DQ + rq * 512 + head * 128 + kind * 64, DK + r0 * 512 + head * 128 + kind * 64, DV + r0 * 512 + head * 128, OD + rq * 1024 + head * 256 + kind * 128, qb, (char*)lds);
                    else at::attn_unit<96, 64, 384, 384, 256, 1024>(MQ + rq * 384 + head * 96, MK + r0 * 384 + head * 96, MV + r0 * 256 + head * 64, MIX + rq * 1024 + 512 + head * 64, qb, (char*)lds);
                } }
            if (BOTH(P + 2)) GRID_BAR();
        }
        if (PHON(3) && IN(P + 3)) {
            int tid_o = tid; asm volatile("" : "+v"(tid_o)); const int lane_o = tid_o & 63;
            for (int u = bx; u < 256; u += G) ret::ret_unit(RQ, RK, RV, RG, AST, (const float*)args.in[13] + layer * 256, (const float*)args.in[14] + layer * 256, MIX, u >> 7, (u >> 5) & 3, u & 31, (char*)lds);
            { const float s1 = wave_sum(((const float*)args.in[4])[layer * 64 + lane_o] * ((const float*)args.in[5])[layer * 64 + lane_o]), s2 = wave_sum(((const float*)args.in[6])[layer * 64 + lane_o] * ((const float*)args.in[7])[layer * 64 + lane_o]);
              const float lam_init = layer == 0 ? 0.2f : 0.35550906759096934f, lam = __builtin_amdgcn_exp2f(s1 * LOG2E) - __builtin_amdgcn_exp2f(s2 * LOG2E) + lam_init;
              const float* subln = (const float*)args.in[8] + layer * 128;
              for (int m = gw; m < MTOK; m += NGW) ret::combine_row(OD, subln, lam, 1.0f - lam_init, MIX, (size_t)m, lane_o); }
            if (layer == 0) convert_group(args, ws, 1, 0, L, gw, NGW, wave, lane_o); else convert_group(args, ws, 1, 1, L, gw, NGW, wave, lane_o);
            if (BOTH(P + 3)) GRID_BAR();
        }
        if (PHON(4) && IN(P + 4)) {
            pg8::Gemm g{MIX, (const bf16*)(ws + WS_WOUT), MTOK, DMODEL, DMODEL}; pg8::StaticOrder S; S.init(MTOK, DMODEL, G, bx);
            pg8::EpiRes E{layer == 0 ? x_in : out, out, XB, SSQ};
            if (G == 256) pg8::gemm_phase<pg8::EpiRes, pg8::StaticOrder, false, true>(L, g, S, E);
            if (BOTH(P + 4)) GRID_BAR();
        }
        if (PHON(5) && IN(P + 5)) {
            pg8::Gemm g{XB, (const bf16*)(ws + WS_WGU), MTOK, NGU, DMODEL}; pg8::StaticOrder S; S.init(MTOK, NGU, G, bx);
            pg8::EpiGU E{SSQ, HB};
            pg8::gemm_phase<pg8::EpiGU, pg8::StaticOrder, true, true>(L, g, S, E);
            if (BOTH(P + 5)) GRID_BAR();
        }
        if (PHON(6) && IN(P + 6)) {
            pg8::Gemm g{HB, (const bf16*)(ws + WS_WDN), MTOK, DMODEL, FFH}; pg8::StaticOrder S; S.init(MTOK, DMODEL, G, bx);
            pg8::EpiRes E{out, out, XB, SSQ};
            if (G == 256) pg8::gemm_phase<pg8::EpiRes, pg8::StaticOrder, false, true>(L, g, S, E);
            if (BOTH(P + 6)) GRID_BAR();
        }
    }
    if (PHON(7) && IN(15)) {
        int tid_o = tid; asm volatile("" : "+v"(tid_o)); const int lane_o = tid_o & 63;
        const float* fn = (const float*)args.in[20];
        for (int m = gw; m < MTOK; m += NGW) {
            const float rs = pg8::rstd4(SSQ + (size_t)m * 4, 1.0f / 1024.0f, NORM_EPS);
            GAS f32x4* xr = (GAS f32x4*)(out + (size_t)m * DMODEL) + lane_o; const GAS f32x4* gr = (const GAS f32x4*)fn + lane_o;
#pragma unroll
            for (int j = 0; j < 4; ++j) { const f32x4 v = xr[64 * j], g4 = gr[64 * j]; xr[64 * j] = v * rs * g4; }
        }
    }
#undef IN
#undef BOTH
#undef GRID_BAR
}

extern "C" void kernel_launch(void* const* d_in, const int* in_sizes, int n_in, void* d_out, int out_size, void* d_ws, size_t ws_size, hipStream_t stream) {
    static int grid = 0;
    if (grid == 0) {
        if (n_in != 21 || in_sizes[0] != MTOK * DMODEL || out_size != MTOK * DMODEL || ws_size < WS_END) { fprintf(stderr, "kernel_launch: unexpected shapes (n_in %d, in0 %d, out %d, ws %zu)\n", n_in, n_in > 0 ? in_sizes[0] : -1, out_size, ws_size); grid = -1; return; }
        int dev = 0, cus = 0, per_cu = 0;
        if (hipGetDevice(&dev) != hipSuccess || hipDeviceGetAttribute(&cus, hipDeviceAttributeMultiprocessorCount, dev) != hipSuccess) { grid = -1; return; }
        if (hipFuncSetAttribute((const void*)hyb_fwd, hipFuncAttributeMaxDynamicSharedMemorySize, LDS_BYTES) != hipSuccess) { fprintf(stderr, "kernel_launch: hipFuncSetAttribute failed\n"); grid = -1; return; }
        if (hipOccupancyMaxActiveBlocksPerMultiprocessor(&per_cu, (const void*)hyb_fwd, NWAVES * 64, LDS_BYTES) != hipSuccess) per_cu = 0;
        (void)hipGetLastError();
        if (per_cu < 1 || cus * per_cu < 256) { fprintf(stderr, "kernel_launch: %d CUs x %d resident workgroups cannot hold the 256-workgroup grid\n", cus, per_cu); grid = -1; return; }
        grid = 256;
    }
    if (grid < 0) return;
    (void)hipMemsetAsync((char*)d_ws + WS_CTL, 0, CTL_ZERO_BYTES, stream);
    Args a{};
    for (int i = 0; i < 21; ++i) a.in[i] = d_in[i];
    a.out = (float*)d_out; a.ws = (unsigned char*)d_ws;
    if (MK_N_LAUNCHES == 1) { a.ph_lo = 0; a.ph_hi = N_PHASES; hipLaunchKernelGGL(hyb_fwd, dim3(grid), dim3(NWAVES * 64), LDS_BYTES, stream, a); }
    else for (int p = 0; p < N_PHASES; ++p) { a.ph_lo = p; a.ph_hi = p + 1; hipLaunchKernelGGL(hyb_fwd, dim3(grid), dim3(NWAVES * 64), LDS_BYTES, stream, a); }
}
```

```cpp
#include <hip/hip_runtime.h>
#include <hip/hip_bf16.h>
#include <cstdio>
#include <cstdint>
#include <cmath>
namespace pg8 {
#define PG8_LAS __attribute__((address_space(3)))
typedef unsigned short bf16_t;
typedef short bf16x8 __attribute__((ext_vector_type(8)));
typedef float f32x4 __attribute__((ext_vector_type(4)));
typedef unsigned u32x4 __attribute__((ext_vector_type(4)));
constexpr int BM = 256, BK = 64, HALF = 128, HTB = HALF * BK * 2  , STAGE_BYTES = 8 * HTB, NXCD = 8, WGM = 8;

__host__ __device__ __forceinline__ int lds_byte(int r, int c) { const int st = (r >> 4) * 2 + (c >> 5), rr = r & 15, cc = c & 31, ob = rr * 64 + cc * 2; return st * 1024 + (ob ^ (((ob >> 9) & 1) << 5)); }
__host__ __device__ __forceinline__ void stage_rc(int b, int& R, int& C) { const int st = b / 1024, sb = b % 1024, swz = sb ^ (((sb >> 9) & 1) << 5); R = (st >> 1) * 16 + swz / 64; C = (st & 1) * 32 + (swz % 64) / 2; }
__host__ __device__ __forceinline__ int perm32(int rho) { const int n = rho >> 4, i = rho & 15; return 8 * (i >> 2) + 4 * n + (i & 3); }

struct Unit { int pm, pn, half, ord; };
struct Gemm { const bf16_t* A; const bf16_t* Bt; int M, N, K; };

struct StaticOrder {
    int nM, nN, nwg, G, c;
    __host__ __device__ void init(int M, int N, int G_, int c_) { nM = M / BM; nN = N / BM; nwg = nM * nN; G = G_; c = c_; }
    __host__ __device__ __attribute__((always_inline)) bool next(int i, Unit& u) const {
        const long L = (long)i * G + c; if (L >= nwg) return false;
        int wgid = (int)L; { const int q = nwg / NXCD, r = nwg % NXCD, xcd = wgid % NXCD, off = wgid / NXCD; wgid = (xcd < r ? xcd * (q + 1) : r * (q + 1) + (xcd - r) * q) + off; }
        const int nig = WGM * nN, gid = wgid / nig, fm = gid * WGM, gsz = (nM - fm) < WGM ? (nM - fm) : WGM;
        u.pm = fm + ((wgid % nig) % gsz); u.pn = (wgid % nig) / gsz; u.half = 0; u.ord = i; return true;
    }
    __device__ __forceinline__ void a_ready(const Unit&) const {}
    __device__ __forceinline__ void done(const Unit&) const {}
};
struct StaticOrderSplit {
    StaticOrder so; int nfull, rem, mode;
    __host__ __device__ void init(int M, int N, int G_, int c_, int mode_ = 0) { so.init(M, N, G_, c_); nfull = so.nwg / G_; rem = so.nwg % G_; mode = mode_; }
    __host__ __device__ __attribute__((always_inline)) bool next(int i, Unit& u) const {
        if (mode == 1 && i >= nfull) return false;
        if (mode == 2) { if (i > 0) return false; i = nfull; }
        if (i < nfull || 2 * rem != so.G) return so.next(i, u);
        if (i > nfull) return false;
        StaticOrder t = so; t.c = so.c >> 1; t.G = so.G; const long L = (long)nfull * so.G + (so.c >> 1); if (L >= so.nwg) return false;
        StaticOrder t2 = so; t2.c = (int)(L - (long)nfull * so.G);
        if (!t2.next(nfull, u)) return false; u.half = 1 + (so.c & 1); return true;
    }
    __device__ __forceinline__ void a_ready(const Unit&) const {}
    __device__ __forceinline__ void done(const Unit&) const {}
};

__device__ __forceinline__ unsigned cvt_pk_bf16(float lo, float hi) { unsigned r; asm volatile("v_cvt_pk_bf16_f32 %0, %1, %2" : "=v"(r) : "v"(lo), "v"(hi)); return r; }
typedef float f32x2 __attribute__((ext_vector_type(2)));
template <class Epi, class Sched, bool ALIGN_EPI = false, bool SP2 = false, bool HALF_OK = false>
__device__ __forceinline__ void gemm_phase(PG8_LAS unsigned char* lds, const Gemm g, const Sched& S, const Epi& E) {
    int tid_ = threadIdx.x; asm volatile("" : "+v"(tid_));
    const int tid = tid_, wid = __builtin_amdgcn_readfirstlane(tid >> 6), lane = tid & 63, wr = wid >> 2, wc = wid & 3, fr = lane & 15, fq = lane >> 4;
    const int K = g.K, nt = K / BK;
    unsigned voffA[2], voffB[2];
#pragma unroll
    for (int i = 0; i < 2; ++i) { int R, C; stage_rc(tid * 16 + i * 8192, R, C); const int Rb = Epi::PERM ? ((R & ~31) + perm32(R & 31)) : R;
        voffA[i] = (unsigned)(R * K + C) * 2u; voffB[i] = (unsigned)(Rb * K + C) * 2u; }
    const size_t kstep = (size_t)(BK * 2);
    const size_t hstep = (size_t)HALF * K * 2;
    const size_t tstep = 2 * hstep;
    const unsigned ldsw = (unsigned)wid * 1024u;
    const int aoff = lds_byte(wr * 64 + fr, fq * 8), boff = lds_byte(wc * 32 + fr, fq * 8);
#define PG8_SA(b, h) (((b) * 2 + (h)) * HTB)
#define PG8_SB(b, h) ((4 + (b) * 2 + (h)) * HTB)
#define PG8_STAGE(bufoff, gbase, voff) do { _Pragma("unroll") for (int _i = 0; _i < 2; ++_i) \
        __builtin_amdgcn_global_load_lds((const unsigned*)((const char*)(gbase) + (voff)[_i]), (PG8_LAS unsigned*)(lds + (bufoff) + ldsw + _i * 8192), 16, 0, 0); } while (0)
#define PG8_LDA(dst, b, h) do { _Pragma("unroll") for (int m = 0; m < 4; ++m) _Pragma("unroll") for (int k = 0; k < 2; ++k) dst[m][k] = *(const PG8_LAS bf16x8*)(lds + PG8_SA(b, h) + aoff + m * 2048 + k * 1024); } while (0)
#define PG8_LDB(dst, b, h) do { _Pragma("unroll") for (int n = 0; n < 2; ++n) _Pragma("unroll") for (int k = 0; k < 2; ++k) dst[n][k] = *(const PG8_LAS bf16x8*)(lds + PG8_SB(b, h) + boff + n * 2048 + k * 1024); } while (0)
#define PG8_MMA(ai, bj, At, Bt) do { if (HALF_OK && cur.half != 0 && cur.half != (ai) + 1) break; __builtin_amdgcn_s_setprio(1); _Pragma("unroll") for (int m = 0; m < 4; ++m) _Pragma("unroll") for (int n = 0; n < 2; ++n) _Pragma("unroll") for (int k = 0; k < 2; ++k) \
        acc[ai][bj][m][n] = __builtin_amdgcn_mfma_f32_16x16x32_bf16(Bt[n][k], At[m][k], acc[ai][bj][m][n], 0, 0, 0); __builtin_amdgcn_s_setprio(0); } while (0)
#define PG8_WAIT_V(n) asm volatile("s_waitcnt vmcnt(" #n ")" ::: "memory")
#define PG8_WAIT_L(n) asm volatile("s_waitcnt lgkmcnt(" #n ")" ::: "memory")
#define PG8_BAR __builtin_amdgcn_s_barrier()
#define PG8_SCHED __builtin_amdgcn_sched_barrier(0)
    Unit cur, nxt; int ui = 0;
    if (!S.next(0, cur)) return;
    f32x4 acc[2][2][4][2];
#pragma unroll
    for (int a = 0; a < 2; ++a)
#pragma unroll
        for (int b = 0; b < 2; ++b)
#pragma unroll
            for (int m = 0; m < 4; ++m)
#pragma unroll
                for (int n = 0; n < 2; ++n) acc[a][b][m][n] = (f32x4){0.f, 0.f, 0.f, 0.f};
    bf16x8 At[4][2], B0[2][2], B1[2][2];
    const char* cA = (const char*)g.A + (size_t)cur.pm * tstep; const char* cB = (const char*)g.Bt + (size_t)cur.pn * tstep;
    S.a_ready(cur);
    if constexpr (SP2) {
        PG8_STAGE(PG8_SB(0, 0), cB, voffB); PG8_STAGE(PG8_SB(0, 1), cB + hstep, voffB); PG8_STAGE(PG8_SA(0, 0), cA, voffA); PG8_STAGE(PG8_SA(0, 1), cA + hstep, voffA);
        if (wr == 1) PG8_BAR;
        PG8_WAIT_V(2); PG8_BAR;
        PG8_STAGE(PG8_SB(1, 0), cB + kstep, voffB); PG8_STAGE(PG8_SA(1, 0), cA + kstep, voffA); PG8_STAGE(PG8_SB(1, 1), cB + hstep + kstep, voffB);
        PG8_WAIT_V(6); PG8_BAR;
    } else {
        PG8_STAGE(PG8_SB(0, 0), cB, voffB); PG8_STAGE(PG8_SA(0, 0), cA, voffA); PG8_STAGE(PG8_SB(0, 1), cB + hstep, voffB); PG8_STAGE(PG8_SA(0, 1), cA + hstep, voffA);
        if (wr == 1) PG8_BAR;
        PG8_WAIT_V(4); PG8_BAR;
        PG8_STAGE(PG8_SB(1, 0), cB + kstep, voffB); PG8_STAGE(PG8_SA(1, 0), cA + kstep, voffA); PG8_STAGE(PG8_SB(1, 1), cB + hstep + kstep, voffB);
        PG8_WAIT_V(6); PG8_BAR;
    }
    for (;;) {
        const bool has_next = S.next(ui + 1, nxt);
        const char* nA = has_next ? (const char*)g.A + (size_t)nxt.pm * tstep : cA; const char* nB = has_next ? (const char*)g.Bt + (size_t)nxt.pn * tstep : cB;
        for (int t = 0; t < nt; t += 2) {
            const bool last = (t == nt - 2);
            const char* a1 = cA + (size_t)(t + 1) * kstep;
            const char* a2 = last ? nA : cA + (size_t)(t + 2) * kstep; const char* b2 = last ? nB : cB + (size_t)(t + 2) * kstep;
            const char* a3 = a2 + kstep; const char* b3 = b2 + kstep;
            if (last && has_next) S.a_ready(nxt);
            if constexpr (SP2) {
            PG8_LDB(B0, 0, 0); PG8_LDB(B1, 0, 1); PG8_SCHED; PG8_LDA(At, 0, 0); PG8_STAGE(PG8_SA(1, 1), a1 + hstep, voffA);
            PG8_WAIT_V(8); PG8_WAIT_L(0); PG8_BAR; PG8_MMA(0, 0, At, B0); PG8_MMA(0, 1, At, B1); PG8_BAR; PG8_SCHED;
            PG8_LDA(At, 0, 1); PG8_STAGE(PG8_SB(0, 0), b2, voffB); PG8_STAGE(PG8_SB(0, 1), b2 + hstep, voffB); PG8_STAGE(PG8_SA(0, 0), a2, voffA);
            PG8_WAIT_V(8); PG8_WAIT_L(0); PG8_BAR; PG8_MMA(1, 0, At, B0); PG8_MMA(1, 1, At, B1); PG8_BAR; PG8_SCHED;
            PG8_LDB(B0, 1, 0); PG8_LDB(B1, 1, 1); PG8_SCHED; PG8_LDA(At, 1, 0); PG8_STAGE(PG8_SA(0, 1), a2 + hstep, voffA);
            PG8_WAIT_V(8); PG8_WAIT_L(0); PG8_BAR; PG8_MMA(0, 0, At, B0); PG8_MMA(0, 1, At, B1); PG8_BAR; PG8_SCHED;
            PG8_LDA(At, 1, 1); PG8_STAGE(PG8_SB(1, 0), b3, voffB); PG8_STAGE(PG8_SB(1, 1), b3 + hstep, voffB); PG8_STAGE(PG8_SA(1, 0), a3, voffA);
            PG8_WAIT_V(8); PG8_WAIT_L(0); PG8_BAR; PG8_MMA(1, 0, At, B0); PG8_MMA(1, 1, At, B1); PG8_BAR; PG8_SCHED;
            } else {
            PG8_LDB(B0, 0, 0); PG8_SCHED; PG8_LDA(At, 0, 0); PG8_STAGE(PG8_SA(1, 1), a1 + hstep, voffA);
            PG8_WAIT_L(8); PG8_BAR; PG8_WAIT_L(0); PG8_MMA(0, 0, At, B0); PG8_BAR; PG8_SCHED;
            PG8_LDB(B1, 0, 1); PG8_STAGE(PG8_SB(0, 0), b2, voffB);
            PG8_BAR; PG8_WAIT_L(0); PG8_MMA(0, 1, At, B1); PG8_BAR;
            PG8_LDA(At, 0, 1); PG8_STAGE(PG8_SA(0, 0), a2, voffA);
            PG8_BAR; PG8_WAIT_L(0); PG8_MMA(1, 0, At, B0); PG8_BAR; PG8_SCHED;
            PG8_STAGE(PG8_SB(0, 1), b2 + hstep, voffB);
            PG8_WAIT_V(6); PG8_BAR; PG8_MMA(1, 1, At, B1); PG8_BAR;
            PG8_LDB(B0, 1, 0); PG8_SCHED; PG8_LDA(At, 1, 0); PG8_STAGE(PG8_SA(0, 1), a2 + hstep, voffA);
            PG8_WAIT_L(8); PG8_BAR; PG8_WAIT_L(0); PG8_MMA(0, 0, At, B0); PG8_BAR; PG8_SCHED;
            PG8_LDB(B1, 1, 1); PG8_STAGE(PG8_SB(1, 0), b3, voffB);
            PG8_BAR; PG8_WAIT_L(0); PG8_MMA(0, 1, At, B1); PG8_BAR;
            PG8_LDA(At, 1, 1); PG8_STAGE(PG8_SA(1, 0), a3, voffA);
            PG8_BAR; PG8_WAIT_L(0); PG8_MMA(1, 0, At, B0); PG8_BAR; PG8_SCHED;
            PG8_STAGE(PG8_SB(1, 1), b3 + hstep, voffB);
            PG8_WAIT_V(6); PG8_BAR; PG8_MMA(1, 1, At, B1); PG8_BAR;
            }
        }
        if constexpr (ALIGN_EPI) { if (wr == 0) PG8_BAR; }
        if constexpr (!Epi::AFTER_DRAIN) { E(acc, cur, wr, wc, fr, fq); S.done(cur); }
        if (!has_next) break;
#pragma unroll
        for (int a = 0; a < 2; ++a)
#pragma unroll
            for (int b = 0; b < 2; ++b)
#pragma unroll
                for (int m = 0; m < 4; ++m)
#pragma unroll
                    for (int n = 0; n < 2; ++n) acc[a][b][m][n] = (f32x4){0.f, 0.f, 0.f, 0.f};
        cur = nxt; cA = nA; cB = nB; ++ui;
        if constexpr (ALIGN_EPI) { if (wr == 1) PG8_BAR; }
    }
    PG8_WAIT_V(0);
    if constexpr (!ALIGN_EPI) { if (wr == 0) PG8_BAR; }
    PG8_BAR;
    if constexpr (Epi::AFTER_DRAIN) { E.fused(acc, cur, wr, wc, fr, fq, lds, wid, lane); S.done(cur); }
#undef PG8_SA
#undef PG8_SB
#undef PG8_STAGE
#undef PG8_LDA
#undef PG8_LDB
#undef PG8_MMA
#undef PG8_WAIT_V
#undef PG8_WAIT_L
#undef PG8_BAR
#undef PG8_SCHED
}
}

#ifndef PG8_SP2
#define PG8_SP2 true
#endif
#ifndef PG8_ALIGN
#define PG8_ALIGN true
#endif
#define GAS __attribute__((address_space(1)))
#define LAS __attribute__((address_space(3)))
typedef unsigned short bf16;
typedef unsigned v4u __attribute__((ext_vector_type(4)));
typedef float f32x4 __attribute__((ext_vector_type(4)));
typedef short bf16x8 __attribute__((ext_vector_type(8)));
typedef GAS unsigned gu32;
typedef GAS unsigned long long gu64;
#define RLX_AGENT __ATOMIC_RELAXED, __HIP_MEMORY_SCOPE_AGENT
#define LDS_WAIT() asm volatile("s_waitcnt lgkmcnt(0)" ::: "memory")
#define VM_WAIT() asm volatile("s_waitcnt vmcnt(0)" ::: "memory")
__device__ __forceinline__ unsigned long long rt() { return __builtin_amdgcn_s_memrealtime(); }
__device__ __forceinline__ unsigned f2bf(float f) { unsigned u = __builtin_bit_cast(unsigned, f); return (u + 0x7fffu + ((u >> 16) & 1u)) >> 16; }
__device__ __forceinline__ unsigned pk2(float lo, float hi) { return f2bf(lo) | (f2bf(hi) << 16); }

#define XB_TMO      128
#define XB_XCNT(j)  (256  + 64 * (j))
#define XB_XSUB(j)  (1280 + 64 * (j))
#define XB_XGEN(j)  (2304 + 64 * (j))
#define XB_TOP      3328
#define XB_TOPGEN   3392
#define XCD_BAR_WORDS 3456
#define XB_SPIN_CAP (1u << 18)

__device__ __forceinline__ unsigned xb_ld(unsigned* p)              { return __hip_atomic_load(p, __ATOMIC_RELAXED, __HIP_MEMORY_SCOPE_AGENT); }
__device__ __forceinline__ unsigned xb_add(unsigned* p, unsigned v) { return __hip_atomic_fetch_add(p, v, __ATOMIC_RELAXED, __HIP_MEMORY_SCOPE_AGENT); }
__device__ __forceinline__ unsigned xb_xcc_id() { return (unsigned)__builtin_amdgcn_s_getreg((3 << 11) | 20) & 0xFu; }
#define XB_SPIN(cond, bar) do { unsigned _sp = 0; while (cond) { __builtin_amdgcn_s_sleep(1); \
    if ((++_sp & 255u) == 0u) { if (xb_ld(&(bar)[XB_TMO])) break; if (_sp > XB_SPIN_CAP) { atomicAdd(&(bar)[XB_TMO], 1u); break; } } } } while (0)

struct XcdBarrier {
    unsigned* bar; unsigned x;
    volatile LAS unsigned* st;
};

__device__ __forceinline__ XcdBarrier xcd_barrier_post(unsigned* bar, volatile LAS unsigned* st) {
    XcdBarrier b; b.bar = bar; b.x = xb_xcc_id(); b.st = st;
    if (threadIdx.x == 0) (void)xb_add(&bar[XB_XCNT(b.x)], 1u);
    return b;
}
__device__ __forceinline__ void xcd_barrier_complete(unsigned* bar, unsigned x, unsigned& nloc, unsigned& nx, unsigned& xmask) {
    const unsigned G = gridDim.x * gridDim.y * gridDim.z;
    unsigned sum, cnt, mine, msk, sp = 0u;
    for (;;) {
        sum = 0u; cnt = 0u; mine = 0u; msk = 0u;
#pragma unroll
        for (unsigned j = 0; j < 16; ++j) { const unsigned c = xb_ld(&bar[XB_XCNT(j)]); sum += c; cnt += (c > 0u) ? 1u : 0u; msk |= (c > 0u) ? (1u << j) : 0u; mine = (j == x) ? c : mine; }
        if (sum == G) break;
        __builtin_amdgcn_s_sleep(1);
        if ((++sp & 255u) == 0u) { if (xb_ld(&bar[XB_TMO])) break; if (sp > XB_SPIN_CAP) { atomicAdd(&bar[XB_TMO], 1u); break; } }
    }
    nloc = mine > 0u ? mine : 1u; nx = cnt > 0u ? cnt : 1u; xmask = msk | (1u << x);
}

__device__ __forceinline__ void xcd_barrier(const XcdBarrier& b) {
    asm volatile("s_waitcnt vmcnt(0)" ::: "memory");
    __syncthreads();
    if (threadIdx.x == 0) {
        unsigned* bar = b.bar;
        __builtin_amdgcn_s_waitcnt(0);
        unsigned nloc = b.st[0], nx = b.st[1];
        if (nloc == 0u) { unsigned xm; xcd_barrier_complete(bar, b.x, nloc, nx, xm); b.st[0] = nloc; b.st[1] = nx; b.st[2] = xm; }
        const unsigned old = xb_add(&bar[XB_XSUB(b.x)], 1u);
        const unsigned gen = old / nloc;
        __builtin_amdgcn_fence(__ATOMIC_ACQUIRE, "agent");
        if (old + 1u == (gen + 1u) * nloc) {
            __builtin_amdgcn_fence(__ATOMIC_RELEASE, "agent");
            asm volatile("s_waitcnt vmcnt(0)" ::: "memory");
            const unsigned og = xb_add(&bar[XB_TOP], 1u);
            const unsigned tg = og / nx;
            if (og + 1u == (tg + 1u) * nx) {
                const unsigned xm = b.st[2];
#pragma unroll
                for (unsigned j = 0; j < 16; ++j) if ((xm >> j) & 1u) (void)xb_add(&bar[XB_XGEN(j)], 1u);
            } else XB_SPIN(xb_ld(&bar[XB_XGEN(b.x)]) == gen, bar);
            asm volatile("s_waitcnt vmcnt(0)" ::: "memory");
        } else {
            XB_SPIN(xb_ld(&bar[XB_XGEN(b.x)]) == gen, bar);
            asm volatile("s_waitcnt vmcnt(0)" ::: "memory");
        }
    }
    __syncthreads();
}
constexpr int BATCH = 2, SEQ = 8192, DMODEL = 1024, MTOK = BATCH * SEQ, DEPTH = 2;
constexpr int IN_COLS = 2976, NIN = 3072, FFH = 2816, NGU = 2 * FFH;
constexpr float NORM_EPS = 1e-6f;
constexpr float LOG2E = 1.4426950408889634f;
constexpr float C2_DIFF = 0.125f * LOG2E;
constexpr float C2_MLA = 0.10206207261596575f * LOG2E;


template <int K> __device__ __forceinline__ float shx(float v) {
    static_assert(K == 1 || K == 2 || K == 4 || K == 8 || K == 16, "xor distance");
    if constexpr (K == 1) return __builtin_bit_cast(float, __builtin_amdgcn_mov_dpp(__builtin_bit_cast(int, v), 0xB1, 0xF, 0xF, true));
    else if constexpr (K == 2) return __builtin_bit_cast(float, __builtin_amdgcn_mov_dpp(__builtin_bit_cast(int, v), 0x4E, 0xF, 0xF, true));
    else return __builtin_bit_cast(float, __builtin_amdgcn_ds_swizzle(__builtin_bit_cast(int, v), (K << 10) | 0x1F));
}
__device__ __forceinline__ float add_x32(float v) { auto rr = __builtin_amdgcn_permlane32_swap(__float_as_uint(v), __float_as_uint(v), false, false); return __uint_as_float(rr[0]) + __uint_as_float(rr[1]); }
constexpr size_t MiB = 1u << 20;
constexpr size_t WS_CTL = 0, CTL_ZERO_BYTES = 1 * MiB;
constexpr size_t WS_WIN = 1 * MiB, WS_WUQ = 7 * MiB, WS_WUKV = WS_WUQ + 256 * 1024, WS_WOUT = WS_WUKV + 256 * 1024, WS_WGU = WS_WOUT + 2 * MiB, WS_WDN = WS_WGU + 11 * MiB;
constexpr size_t WS_XB = 26 * MiB;
constexpr size_t WS_T64 = 58 * MiB, WS_TM = 62 * MiB;
constexpr size_t WS_QN = 68 * MiB;
constexpr size_t WS_AST = 64 * MiB;
constexpr size_t WS_SSQ = 72 * MiB, WS_CQS = WS_SSQ + 256 * 1024, WS_CKVS = WS_CQS + 256 * 1024;
constexpr size_t WS_A = 73 * MiB;
constexpr size_t WS_DQ = WS_A, WS_DK = WS_DQ + 16 * MiB, WS_DV = WS_DK + 16 * MiB, WS_CQ = WS_DV + 16 * MiB, WS_CKV = WS_CQ + 8 * MiB, WS_MQ = WS_CKV + 8 * MiB, WS_MK = WS_MQ + 12 * MiB,
                 WS_MV = WS_MK + 12 * MiB, WS_RQ = WS_MV + 8 * MiB, WS_RK = WS_RQ + 8 * MiB, WS_RV = WS_RK + 8 * MiB, WS_RG = WS_RV + 8 * MiB, WS_MIX = WS_RG + 8 * MiB, WS_END = WS_MIX + 32 * MiB;
constexpr size_t WS_H = WS_A;
static_assert(WS_WDN + (size_t)1024 * FFH * 2 <= WS_XB && WS_H + (size_t)MTOK * FFH * 2 <= WS_MV && WS_END <= 256 * MiB, "d_ws map");
constexpr int CW_TMO = 0, CW_BAR = 4096, CW_Q = 8192, CW_P = 16384, CW_KM = 49152  ;
constexpr int RING_BYTES = 131072, LDSCTL_OFF = RING_BYTES, MISC_OFF = LDSCTL_OFF + 320, RS_OFF = LDSCTL_OFF + 1024  , LDS_BYTES = 147456;
constexpr int NWAVES = 8;

template <bool RELEASE = true> __device__ __forceinline__ void panel_barrier(gu32* cnt, unsigned expected, gu32* tmo);
namespace pg8 {
typedef float f32x2v __attribute__((ext_vector_type(2)));
__device__ __forceinline__ u32x4 pack8(const f32x4 a, const f32x4 b) { u32x4 w; w.x = cvt_pk_bf16(a[0], a[1]); w.y = cvt_pk_bf16(a[2], a[3]); w.z = cvt_pk_bf16(b[0], b[1]); w.w = cvt_pk_bf16(b[2], b[3]); return w; }
#ifdef WT_STORES
__device__ __forceinline__ void st16(void* p, const u32x4 v) { asm volatile("global_store_dwordx4 %0, %1, off sc1\n\ts_nop 1" :: "v"(p), "v"(v) : "memory"); }
#else
__device__ __forceinline__ void st16(void* p, const u32x4 v) { *(u32x4*)p = v; }
#endif
__device__ __forceinline__ float rstd4(const float* p, float inv_n, float eps) { const f32x4 s = *(const f32x4*)p; return 1.0f / sqrtf(((s[0] + s[1]) + (s[2] + s[3])) * inv_n + eps); }
__device__ __forceinline__ float sumsq4(const f32x4 v) { return (v[0] * v[0] + v[1] * v[1]) + (v[2] * v[2] + v[3] * v[3]); }
__device__ __forceinline__ f32x4 silu4(const f32x4 v) { f32x4 r;
#pragma unroll
    for (int i = 0; i < 4; ++i) r[i] = v[i] * __builtin_amdgcn_rcpf(1.0f + __builtin_amdgcn_exp2f(-v[i] * 1.4426950408889634f)); return r; }

__device__ __forceinline__ void rstd8(float (&rs)[2][4], const float* p, int row0, float inv_n, float eps) {
    f32x4 s[2][4];
#pragma unroll
    for (int ai = 0; ai < 2; ++ai)
#pragma unroll
        for (int m = 0; m < 4; ++m) s[ai][m] = *(const f32x4*)(p + (size_t)(row0 + ai * HALF + m * 16) * 4);
#pragma unroll
    for (int ai = 0; ai < 2; ++ai)
#pragma unroll
        for (int m = 0; m < 4; ++m) rs[ai][m] = 1.0f / sqrtf(((s[ai][m][0] + s[ai][m][1]) + (s[ai][m][2] + s[ai][m][3])) * inv_n + eps);
}
struct EpiG1 {
    static constexpr bool PERM = true, AFTER_DRAIN = false;
    unsigned char* ws;
    int layer;
    const PG8_LAS float* rs_tab;
    __device__ __forceinline__ void scales(float (&rsv)[4], const PG8_LAS float* tab, int lrow0) const {
#pragma unroll
        for (int m = 0; m < 4; ++m) rsv[m] = tab[lrow0 + m * 16];
    }
    __device__ __forceinline__ void operator()(const f32x4 (&acc)[2][2][4][2], const Unit& u, int wr, int wc, int fr, int fq) const {
        { int t_ = threadIdx.x; asm volatile("" : "+v"(t_)); fr = t_ & 15; fq = (t_ >> 4) & 3; }
        const int pn = u.pn; const PG8_LAS float* tab = rs_tab + u.ord * 256;
        if (pn < 4 || pn == 8 || pn == 9) {
            const float* t64 = (const float*)(ws + WS_T64);
            const float sc = pn < 2 ? C2_DIFF : (pn == 9 ? 0.125f : 1.0f);
            bf16_t* dbase; int ld; if (pn < 2) { dbase = (bf16_t*)(ws + WS_DQ) + 256 * pn; ld = 512; } else if (pn < 4) { dbase = (bf16_t*)(ws + WS_DK) + 256 * (pn - 2); ld = 512; } else { dbase = (bf16_t*)(ws + (pn == 8 ? WS_RQ : WS_RK)); ld = 256; }
            dbase += 64 * wc + 8 * fq;
            float kmx = 0.f;
#pragma unroll
            for (int ai = 0; ai < 2; ++ai) {
                const int row0 = u.pm * BM + ai * HALF + wr * 64 + fr; float rsv[4]; scales(rsv, tab, ai * HALF + wr * 64 + fr);
#pragma unroll
                for (int mp = 0; mp < 2; ++mp) {
                    f32x4 tc[2][4];
#pragma unroll
                    for (int k = 0; k < 2; ++k) { const float* tr = t64 + (size_t)(row0 + (2 * mp + k) * 16) * 64 + 8 * fq;
                        tc[k][0] = *(const f32x4*)tr; tc[k][1] = *(const f32x4*)(tr + 4); tc[k][2] = *(const f32x4*)(tr + 32); tc[k][3] = *(const f32x4*)(tr + 36); }
                    asm volatile("" ::: "memory");
#pragma unroll
                    for (int k = 0; k < 2; ++k) { const int m = 2 * mp + k; const float rs = rsv[m];
                        const f32x4 l0 = acc[ai][0][m][0] * rs, l1 = acc[ai][0][m][1] * rs, h0 = acc[ai][1][m][0] * rs, h1 = acc[ai][1][m][1] * rs;
                        const f32x4 c0 = tc[k][0], c1 = tc[k][1], s0 = tc[k][2], s1 = tc[k][3];
                        const f32x4 ol0 = (l0 * c0 - h0 * s0) * sc, ol1 = (l1 * c1 - h1 * s1) * sc, oh0 = (h0 * c0 + l0 * s0) * sc, oh1 = (h1 * c1 + l1 * s1) * sc;
                        bf16_t* dst = dbase + (size_t)(row0 + m * 16) * ld;
                        st16(dst, pack8(ol0, ol1)); st16(dst + 32, pack8(oh0, oh1));
                        if (pn < 4) {
                            float s = (sumsq4(ol0) + sumsq4(ol1)) + (sumsq4(oh0) + sumsq4(oh1)); s += shx<16>(s); s = add_x32(s);
                            if (pn < 2) { if (fq == 0) ((float*)(ws + WS_QN))[(size_t)(row0 + m * 16) * 8 + 4 * pn + wc] = sqrtf(s); } else kmx = fmaxf(kmx, s); } }
                }
            }
            if (pn == 2 || pn == 3) { kmx = fmaxf(kmx, shx<1>(kmx)); kmx = fmaxf(kmx, shx<2>(kmx)); kmx = fmaxf(kmx, shx<4>(kmx)); kmx = fmaxf(kmx, shx<8>(kmx));
                if (fr == 0 && fq == 0) (void)__hip_atomic_fetch_max((int*)(ws + WS_CTL) + CW_KM + layer * 64 + (u.pm >> 5) * 8 + 4 * (pn - 2) + wc, __float_as_int(sqrtf(kmx)), __ATOMIC_RELAXED, __HIP_MEMORY_SCOPE_AGENT); }
        } else if (pn == 4 || pn == 5 || pn == 10 || pn == 11) {
            bf16_t* dbase; int ld; if (pn < 6) { dbase = (bf16_t*)(ws + WS_DV) + 256 * (pn - 4); ld = 512; } else { dbase = (bf16_t*)(ws + (pn == 10 ? WS_RV : WS_RG)); ld = 256; }
            dbase += 32 * wc + 8 * fq;
#pragma unroll
            for (int ai = 0; ai < 2; ++ai) {
                const int row0 = u.pm * BM + ai * HALF + wr * 64 + fr; float rsv[4]; scales(rsv, tab, ai * HALF + wr * 64 + fr);
#pragma unroll
                for (int m = 0; m < 4; ++m) { const float rs = rsv[m];
                    f32x4 l0 = acc[ai][0][m][0] * rs, l1 = acc[ai][0][m][1] * rs, h0 = acc[ai][1][m][0] * rs, h1 = acc[ai][1][m][1] * rs;
                    if (pn == 11) { l0 = silu4(l0); l1 = silu4(l1); h0 = silu4(h0); h1 = silu4(h1); }
                    bf16_t* dst = dbase + (size_t)(row0 + m * 16) * ld;
                    st16(dst, pack8(l0, l1)); st16(dst + HALF, pack8(h0, h1)); }
            }
        } else if (pn == 6) {
            bf16_t* dbase = (bf16_t*)(ws + WS_CQ) + 32 * wc + 8 * fq; float* CQS = (float*)(ws + WS_CQS);
#pragma unroll
            for (int ai = 0; ai < 2; ++ai) {
                const int row0 = u.pm * BM + ai * HALF + wr * 64 + fr; float rsv[4]; scales(rsv, tab, ai * HALF + wr * 64 + fr);
#pragma unroll
                for (int m = 0; m < 4; ++m) { const float rs = rsv[m]; const int row = row0 + m * 16;
                    const f32x4 l0 = acc[ai][0][m][0] * rs, l1 = acc[ai][0][m][1] * rs, h0 = acc[ai][1][m][0] * rs, h1 = acc[ai][1][m][1] * rs;
                    bf16_t* dst = dbase + (size_t)row * 256;
                    st16(dst, pack8(l0, l1)); st16(dst + HALF, pack8(h0, h1));
                    float s = (sumsq4(l0) + sumsq4(l1)) + (sumsq4(h0) + sumsq4(h1));
                    s += shx<16>(s); s = add_x32(s);
                    if (fq == 0) CQS[(size_t)row * 4 + wc] = s; }
            }
        } else {
            bf16_t* dbase = (bf16_t*)(ws + WS_CKV) + 32 * wc + 8 * fq; float* CKVS = (float*)(ws + WS_CKVS); const float* tm = (const float*)(ws + WS_TM); bf16_t* MK = (bf16_t*)(ws + WS_MK);
            const bool kr = (wc == 0) && (fq < 2);
#pragma unroll
            for (int ai = 0; ai < 2; ++ai) {
                const int row0 = u.pm * BM + ai * HALF + wr * 64 + fr; float rsv[4]; scales(rsv, tab, ai * HALF + wr * 64 + fr);
#pragma unroll
                for (int m = 0; m < 4; ++m) { const float rs = rsv[m]; const int row = row0 + m * 16;
                    const f32x4 l0 = acc[ai][0][m][0] * rs, l1 = acc[ai][0][m][1] * rs, h0 = acc[ai][1][m][0] * rs, h1 = acc[ai][1][m][1] * rs;
                    bf16_t* dst = dbase + (size_t)row * 256;
                    st16(dst, pack8(l0, l1)); st16(dst + HALF, pack8(h0, h1));
                    float s = kr ? 0.f : (sumsq4(l0) + sumsq4(l1)) + (sumsq4(h0) + sumsq4(h1));
                    s += shx<16>(s); s = add_x32(s);
                    if (fq == 0) CKVS[(size_t)row * 4 + wc] = s;
                    if (kr) {
                        const float* tr = tm + (size_t)row * 32 + 8 * fq;
                        const f32x4 c0 = *(const f32x4*)tr, c1 = *(const f32x4*)(tr + 4), s0 = *(const f32x4*)(tr + 16), s1 = *(const f32x4*)(tr + 20);
                        const u32x4 olo = pack8(l0 * c0 - h0 * s0, l1 * c1 - h1 * s1), ohi = pack8(h0 * c0 + l0 * s0, h1 * c1 + l1 * s1);
                        bf16_t* kd = MK + (size_t)row * 384 + 64 + 8 * fq;
#pragma unroll
                        for (int hh = 0; hh < 4; ++hh) { st16(kd + hh * 96, olo); st16(kd + hh * 96 + 16, ohi); }
                    } }
            }
        }
    }
};

struct EpiMQ {
    static constexpr bool PERM = true, AFTER_DRAIN = false;
    unsigned char* ws;
    __device__ __forceinline__ void operator()(const f32x4 (&acc)[2][2][4][2], const Unit& u, int wr, int wc, int fr, int fq) const {
        { int t_ = threadIdx.x; asm volatile("" : "+v"(t_)); fr = t_ & 15; fq = (t_ >> 4) & 3; }
        const int head = 2 * u.pn + (wc >> 1);
        const float* cqs = (const float*)(ws + WS_CQS); const float* tm = (const float*)(ws + WS_TM); bf16_t* MQ = (bf16_t*)(ws + WS_MQ);
        float rsv[2][4]; rstd8(rsv, cqs, u.pm * BM + wr * 64 + fr, 1.0f / 256.0f, NORM_EPS);
#pragma unroll
        for (int ai = 0; ai < 2; ++ai)
#pragma unroll
            for (int m = 0; m < 4; ++m) {
                const int row = u.pm * BM + ai * HALF + wr * 64 + m * 16 + fr;
                const float rs = rsv[ai][m] * C2_MLA;
                const f32x4 l0 = acc[ai][0][m][0] * rs, l1 = acc[ai][0][m][1] * rs, h0 = acc[ai][1][m][0] * rs, h1 = acc[ai][1][m][1] * rs;
                bf16_t* dst = MQ + (size_t)row * 384 + head * 96;
                if ((wc & 1) == 0) { st16(dst + 8 * fq, pack8(l0, l1)); st16(dst + 32 + 8 * fq, pack8(h0, h1)); }
                else if (fq < 2) {
                    const float* tr = tm + (size_t)row * 32 + 8 * fq;
                    const f32x4 c0 = *(const f32x4*)tr, c1 = *(const f32x4*)(tr + 4), s0 = *(const f32x4*)(tr + 16), s1 = *(const f32x4*)(tr + 20);
                    st16(dst + 64 + 8 * fq, pack8(l0 * c0 - h0 * s0, l1 * c1 - h1 * s1)); st16(dst + 80 + 8 * fq, pack8(h0 * c0 + l0 * s0, h1 * c1 + l1 * s1));
                }
            }
    }
};
struct EpiMKV {
    static constexpr bool PERM = true, AFTER_DRAIN = false;
    unsigned char* ws;
    __device__ __forceinline__ void operator()(const f32x4 (&acc)[2][2][4][2], const Unit& u, int wr, int wc, int fr, int fq) const {
        { int t_ = threadIdx.x; asm volatile("" : "+v"(t_)); fr = t_ & 15; fq = (t_ >> 4) & 3; }
        const int head = 2 * u.pn + (wc >> 1);
        const float* ckvs = (const float*)(ws + WS_CKVS); bf16_t* MK = (bf16_t*)(ws + WS_MK); bf16_t* MV = (bf16_t*)(ws + WS_MV);
        float rsv[2][4]; rstd8(rsv, ckvs, u.pm * BM + wr * 64 + fr, 1.0f / 128.0f, NORM_EPS);
#pragma unroll
        for (int ai = 0; ai < 2; ++ai)
#pragma unroll
            for (int m = 0; m < 4; ++m) {
                const int row = u.pm * BM + ai * HALF + wr * 64 + m * 16 + fr;
                const float rs = rsv[ai][m];
                const f32x4 l0 = acc[ai][0][m][0] * rs, l1 = acc[ai][0][m][1] * rs, h0 = acc[ai][1][m][0] * rs, h1 = acc[ai][1][m][1] * rs;
                bf16_t* dst = (wc & 1) ? MV + (size_t)row * 256 + head * 64 : MK + (size_t)row * 384 + head * 96;
                st16(dst + 8 * fq, pack8(l0, l1)); st16(dst + 32 + 8 * fq, pack8(h0, h1));
            }
    }
};

struct EpiGU {
    static constexpr bool PERM = true, AFTER_DRAIN = false;
    unsigned char* ws; const PG8_LAS float* rs_tab;
    __device__ __forceinline__ void operator()(const f32x4 (&acc)[2][2][4][2], const Unit& u, int wr, int wc, int fr, int fq) const {
        { int t_ = threadIdx.x; asm volatile("" : "+v"(t_)); fr = t_ & 15; fq = (t_ >> 4) & 3; }
        bf16_t* H = (bf16_t*)(ws + WS_H);
        float rsv[2][4];
#pragma unroll
        for (int ai = 0; ai < 2; ++ai)
#pragma unroll
            for (int m = 0; m < 4; ++m) rsv[ai][m] = rs_tab[u.ord * 256 + ai * HALF + wr * 64 + m * 16 + fr];
#pragma unroll
        for (int ai = 0; ai < 2; ++ai)
#pragma unroll
            for (int m = 0; m < 4; ++m) {
                if (u.half != 0 && u.half != ai + 1) continue;
                const int row = u.pm * BM + ai * HALF + wr * 64 + m * 16 + fr;
                const float rs = rsv[ai][m];
                const f32x4 g0 = acc[ai][0][m][0] * rs, g1 = acc[ai][0][m][1] * rs, u0 = acc[ai][1][m][0] * rs, u1 = acc[ai][1][m][1] * rs;
                st16(H + (size_t)row * FFH + u.pn * HALF + 32 * wc + 8 * fq, pack8(silu4(g0) * u0, silu4(g1) * u1));
            }
    }
};

struct EpiRes {
    static constexpr bool PERM = true, AFTER_DRAIN = true;
    unsigned char* ws; int dry;
    int fin; const float* fnw; float* outp;
    __device__ __forceinline__ void fused(f32x4 (&acc)[2][2][4][2], const Unit& u, int wr, int wc, int fr, int fq, PG8_LAS unsigned char* lds, int wid, int lane) const {
        { int t_ = threadIdx.x; asm volatile("" : "+v"(t_)); fr = t_ & 15; fq = (t_ >> 4) & 3; }
        PG8_LAS float* P = (PG8_LAS float*)lds;
        bf16_t* xb = (bf16_t*)(ws + WS_XB); float* ssq = (float*)(ws + WS_SSQ);
        const int col0 = u.pn * BM + wc * 32 + 8 * fq;
        u32x4 xi[2][2];
#define ER_LOAD(k) do { const size_t off_ = (size_t)(u.pm * BM + ((k) >> 2) * HALF + wr * 64 + ((k) & 3) * 16 + fr) * DMODEL + col0; \
        _Pragma("unroll") for (int q_ = 0; q_ < 2; ++q_) xi[(k) & 1][q_] = *(const u32x4*)(xb + off_ + q_ * HALF); } while (0)
        ER_LOAD(0);
#pragma unroll
        for (int k = 0; k < 8; ++k) { const int ai = k >> 2, m = k & 3, r = ai * HALF + wr * 64 + m * 16 + fr; const size_t off = (size_t)(u.pm * BM + r) * DMODEL + col0; float s = 0.f;
            if (k < 7) ER_LOAD(k + 1);
            asm volatile("" ::: "memory");
#pragma unroll
            for (int bj = 0; bj < 2; ++bj) { const u32x4 x4 = xi[k & 1][bj];
                const f32x4 xv0 = {__uint_as_float(x4.x << 16), __uint_as_float(x4.x & 0xffff0000u), __uint_as_float(x4.y << 16), __uint_as_float(x4.y & 0xffff0000u)};
                const f32x4 xv1 = {__uint_as_float(x4.z << 16), __uint_as_float(x4.z & 0xffff0000u), __uint_as_float(x4.w << 16), __uint_as_float(x4.w & 0xffff0000u)};
                const f32x4 v0 = xv0 + acc[ai][bj][m][0], v1 = xv1 + acc[ai][bj][m][1];
                if (fin) { acc[ai][bj][m][0] = v0; acc[ai][bj][m][1] = v1; }
                else { u32x4 w; w.x = cvt_pk_bf16(v0[0], v0[1]); w.y = cvt_pk_bf16(v0[2], v0[3]); w.z = cvt_pk_bf16(v1[0], v1[1]); w.w = cvt_pk_bf16(v1[2], v1[3]); if (!dry) *(u32x4*)(xb + off + bj * HALF) = w; }
                s += sumsq4(v0) + sumsq4(v1); }
            s += shx<16>(s); s = add_x32(s);
            if (fq == 0) P[r * 4 + wc] = s;
            asm volatile("" ::: "memory"); }
#undef ER_LOAD
        asm volatile("s_waitcnt lgkmcnt(0)" ::: "memory"); __builtin_amdgcn_s_barrier(); asm volatile("" ::: "memory");
        const int t = wid * 64 + lane;
        if (t < 256 && !dry) { const PG8_LAS f32x4* P4 = (const PG8_LAS f32x4*)lds; const f32x4 p = P4[t]; const float tot = (p[0] + p[1]) + (p[2] + p[3]);
            if (fin) __hip_atomic_store(ssq + (size_t)(u.pm * BM + t) * 4 + u.pn, tot, __ATOMIC_RELAXED, __HIP_MEMORY_SCOPE_AGENT);
            else ssq[(size_t)(u.pm * BM + t) * 4 + u.pn] = tot; }
        asm volatile("s_waitcnt lgkmcnt(0)" ::: "memory"); __builtin_amdgcn_s_barrier(); asm volatile("" ::: "memory");
        if (fin) {
            panel_barrier<false>((gu32*)(ws + WS_CTL) + CW_P + (2 * 64 + u.pm) * 64, 4u, (gu32*)(ws + WS_CTL) + CW_TMO);
            f32x4 ps[8];
#pragma unroll
            for (int k = 0; k < 8; ++k) { const int r = (k >> 2) * HALF + wr * 64 + (k & 3) * 16 + fr; ps[k] = *(const f32x4*)(ssq + (size_t)(u.pm * BM + r) * 4); }
            f32x4 gv[2][2];
#pragma unroll
            for (int bj = 0; bj < 2; ++bj)
#pragma unroll
                for (int n = 0; n < 2; ++n) gv[bj][n] = *(const f32x4*)(fnw + col0 + bj * HALF + n * 4);
#pragma unroll
            for (int k = 0; k < 8; ++k) { const int ai = k >> 2, m = k & 3, r = ai * HALF + wr * 64 + m * 16 + fr; const size_t off = (size_t)(u.pm * BM + r) * DMODEL + col0;
                const float rs = 1.0f / sqrtf(((ps[k][0] + ps[k][1]) + (ps[k][2] + ps[k][3])) * (1.0f / 1024.0f) + NORM_EPS);
#pragma unroll
                for (int bj = 0; bj < 2; ++bj)
#pragma unroll
                    for (int n = 0; n < 2; ++n) { const f32x4 o4 = acc[ai][bj][m][n] * rs * gv[bj][n]; if (!dry) *(f32x4*)(outp + off + bj * HALF + n * 4) = o4; } }
        }
    }
};
}
namespace at {
using bf16 = unsigned short;
using bf16x8 = __attribute__((ext_vector_type(8))) short;
using s16x4 = __attribute__((ext_vector_type(4))) short;
using f32x16 = __attribute__((ext_vector_type(16))) float;
using f32x4 = __attribute__((ext_vector_type(4))) float;
using u32x4 = __attribute__((ext_vector_type(4))) unsigned;
#define SBAR() __builtin_amdgcn_sched_barrier(0)
constexpr float THR2 = 8.f;
__device__ __forceinline__ int crow(int r, int hi) { return (r & 3) + 8 * (r >> 2) + 4 * hi; }
__device__ __forceinline__ unsigned cvtpk(float lo, float hi) { unsigned r; asm volatile("v_cvt_pk_bf16_f32 %0, %1, %2" : "=v"(r) : "v"(lo), "v"(hi)); return r; }
__device__ __forceinline__ float bf2f(short b) { return __uint_as_float(((unsigned)(unsigned short)b) << 16); }
template <int NB> __device__ __forceinline__ int v_st(int k, int c) { const int kk = (k & ~0xC) | ((k & 4) << 1) | ((k & 8) >> 1); return ((kk >> 3) * NB + (c >> 5)) * 512 + ((kk & 7) * 32 + (c & 31)) * 2; }
__device__ __forceinline__ int v_rd_base(int lane) { return ((lane & 3) << 3) | (((lane >> 2) & 3) << 6) | (((lane >> 4) & 1) << 5) | (((lane >> 5) & 1) << 8); }
template <int NB> constexpr int v_rd_off(int d0, int ks, int half) { return d0 * 512 + ks * (2 * NB * 512) + half * (NB * 512); }
template <int KRS> __device__ __forceinline__ int k_swz(int row) { return KRS == 128 ? (((row >> 1) & 7) << 4) : ((row & 7) << 4); }
template <int KRS> __device__ __forceinline__ int k_addr(int row, int chunk) { return row * KRS + ((chunk * 16) ^ k_swz<KRS>(row)); }

__device__ __forceinline__ void mask_tile(f32x16& p0, f32x16& p1, int dq) {
    const float NEG = -__builtin_inff();
#pragma unroll
    for (int r = 0; r < 16; ++r) { const int c = (r & 3) + 8 * (r >> 2); if (dq - c < 0) p0[r] = NEG; if (dq - c - 32 < 0) p1[r] = NEG; }
}
__device__ __forceinline__ void partialSM(f32x16& p0, f32x16& p1, float& m_reg, float& alpha) {
    float pmax = p0[0];
#pragma unroll
    for (int r = 1; r < 16; ++r) pmax = fmaxf(pmax, p0[r]);
#pragma unroll
    for (int r = 0; r < 16; ++r) pmax = fmaxf(pmax, p1[r]);
    { auto rr = __builtin_amdgcn_permlane32_swap(__float_as_uint(pmax), __float_as_uint(pmax), false, false); pmax = fmaxf(__uint_as_float(rr[0]), __uint_as_float(rr[1])); }
    float mn;
    if (__builtin_expect(__all(pmax - m_reg <= THR2), 1)) { mn = m_reg; alpha = 1.f; }
    else { mn = fmaxf(m_reg, pmax); alpha = __builtin_amdgcn_exp2f(m_reg - mn); m_reg = mn; }
#pragma unroll
    for (int r = 0; r < 16; ++r) { p0[r] -= mn; p1[r] -= mn; }
#pragma unroll
    for (int r = 0; r < 16; ++r) p0[r] = __builtin_amdgcn_exp2f(p0[r]);
}
#define AT_PK4(P, B_, OUT) do { unsigned a0 = cvtpk(P[B_ + 0], P[B_ + 1]), a1 = cvtpk(P[B_ + 2], P[B_ + 3]); unsigned b0 = cvtpk(P[B_ + 4], P[B_ + 5]), b1 = cvtpk(P[B_ + 6], P[B_ + 7]); \
        auto r0 = __builtin_amdgcn_permlane32_swap(a0, b0, false, false); auto r1 = __builtin_amdgcn_permlane32_swap(a1, b1, false, false); \
        u32x4 w = {r0[0], r1[0], r0[1], r1[1]}; OUT = *reinterpret_cast<bf16x8*>(&w); } while (0)
__device__ __forceinline__ void pack_p(const f32x16& p0, const f32x16& p1, bf16x8& pa0, bf16x8& pa1, bf16x8& pa2, bf16x8& pa3) { AT_PK4(p0, 0, pa0); AT_PK4(p0, 8, pa1); AT_PK4(p1, 0, pa2); AT_PK4(p1, 8, pa3); }
__device__ __forceinline__ void finishSM(f32x16& p0, f32x16& p1, float alpha, float& l_reg, bf16x8& pa0, bf16x8& pa1, bf16x8& pa2, bf16x8& pa3) {
#pragma unroll
    for (int r = 0; r < 16; ++r) p1[r] = __builtin_amdgcn_exp2f(p1[r]);
    float ps = 0;
#pragma unroll
    for (int r = 0; r < 16; ++r) ps += p0[r];
#pragma unroll
    for (int r = 0; r < 16; ++r) ps += p1[r];
    { auto rr = __builtin_amdgcn_permlane32_swap(__float_as_uint(ps), __float_as_uint(ps), false, false); ps = __uint_as_float(rr[0]) + __uint_as_float(rr[1]); }
    l_reg = l_reg * alpha + ps;
    pack_p(p0, p1, pa0, pa1, pa2, pa3);
}
template <int DQK, int KRS> __device__ __forceinline__ void qkt(f32x16& p0, f32x16& p1, const char* Kimg, int r32, int hi, const bf16x8* qr) {
    p0 = f32x16{}; p1 = f32x16{};
    const char* kb[4];
#pragma unroll
    for (int dd = 0; dd < 4; ++dd) kb[dd] = Kimg + k_addr<KRS>(r32, 2 * dd + hi);
#pragma unroll
    for (int d0 = 0; d0 < DQK / 16; ++d0) { const char* a = kb[d0 & 3] + (d0 >> 2) * 128;
        const bf16x8 b0 = *reinterpret_cast<const bf16x8*>(a), b1 = *reinterpret_cast<const bf16x8*>(a + 32 * KRS);
        p0 = __builtin_amdgcn_mfma_f32_32x32x16_bf16(b0, qr[d0], p0, 0, 0, 0);
        p1 = __builtin_amdgcn_mfma_f32_32x32x16_bf16(b1, qr[d0], p1, 0, 0, 0); }
}
struct VFr { s16x4 l0, l1, l2, l3, h0, h1, h2, h3; };
#define AT_TRRD(dst, off) asm volatile("ds_read_b64_tr_b16 %0, %1 offset:%2" : "=&v"(dst) : "v"(vb), "i"(off) : "memory")
template <int NB, int D0> __device__ __forceinline__ void v_reads(VFr& f, int vb) {
    AT_TRRD(f.l0, (v_rd_off<NB>(D0, 0, 0))); AT_TRRD(f.h0, (v_rd_off<NB>(D0, 0, 1))); AT_TRRD(f.l1, (v_rd_off<NB>(D0, 1, 0))); AT_TRRD(f.h1, (v_rd_off<NB>(D0, 1, 1)));
    AT_TRRD(f.l2, (v_rd_off<NB>(D0, 2, 0))); AT_TRRD(f.h2, (v_rd_off<NB>(D0, 2, 1))); AT_TRRD(f.l3, (v_rd_off<NB>(D0, 3, 0))); AT_TRRD(f.h3, (v_rd_off<NB>(D0, 3, 1)));
}
#undef AT_TRRD
#define AT_PK(L, H) (bf16x8){L[0], L[1], L[2], L[3], H[0], H[1], H[2], H[3]}
__device__ __forceinline__ void pv_mma(f32x16& od, const VFr& f, bf16x8 pa0, bf16x8 pa1, bf16x8 pa2, bf16x8 pa3) {
    od = __builtin_amdgcn_mfma_f32_32x32x16_bf16(pa0, AT_PK(f.l0, f.h0), od, 0, 0, 0);
    od = __builtin_amdgcn_mfma_f32_32x32x16_bf16(pa1, AT_PK(f.l1, f.h1), od, 0, 0, 0);
    od = __builtin_amdgcn_mfma_f32_32x32x16_bf16(pa2, AT_PK(f.l2, f.h2), od, 0, 0, 0);
    od = __builtin_amdgcn_mfma_f32_32x32x16_bf16(pa3, AT_PK(f.l3, f.h3), od, 0, 0, 0);
}
#undef AT_PK
#define AT_LW(n) asm volatile("s_waitcnt lgkmcnt(" #n ")" ::: "memory")
template <int NB> __device__ __forceinline__ void pv_all(f32x16* o, int vb, bf16x8 pa0, bf16x8 pa1, bf16x8 pa2, bf16x8 pa3) {
    VFr fa, fb;
    v_reads<NB, 0>(fa, vb); v_reads<NB, 1>(fb, vb);
    AT_LW(8); SBAR(); pv_mma(o[0], fa, pa0, pa1, pa2, pa3); SBAR();
    if constexpr (NB == 4) {
        v_reads<NB, 2>(fa, vb); AT_LW(8); SBAR(); pv_mma(o[1], fb, pa0, pa1, pa2, pa3); SBAR();
        v_reads<NB, 3>(fb, vb); AT_LW(8); SBAR(); pv_mma(o[2], fa, pa0, pa1, pa2, pa3); SBAR();
        AT_LW(0); SBAR(); pv_mma(o[3], fb, pa0, pa1, pa2, pa3);
    } else { AT_LW(0); SBAR(); pv_mma(o[1], fb, pa0, pa1, pa2, pa3); }
}
#undef AT_LW

template <int DQK, int DV, int LDQ, int LDK, int LDV, int LDO>
__device__ __forceinline__ void attn_unit(const bf16* __restrict__ Qb, const bf16* __restrict__ Kh, const bf16* __restrict__ Vh, bf16* __restrict__ Ob, int qb, char* lds, int kvmul = 1) {
    constexpr int KRS = DQK == 64 ? 128 : 256, KB = 64 * KRS, NB = DV / 32, VB = 64 * DV * 2, KCH = DQK / 8, NKP = (64 * KCH + 511) / 512, VCH = DV / 8, NVP = 64 * VCH / 512;
    static_assert(NKP <= 2 && (NVP == 1 || NVP == 2), "staging piece counts");
    int tid_ = threadIdx.x; asm volatile("" : "+v"(tid_));
    const int tid = tid_, wid = __builtin_amdgcn_readfirstlane(tid >> 6), lane = tid & 63, r32 = lane & 31, hi = lane >> 5;
    char* V_lds = lds; char* K_lds = lds + 2 * VB;
    float* ws = (float*)(lds + 2 * VB + 2 * KB) + wid * 64; float* li_l = ws; float* al_l = ws + 32;
    float m_reg = -1e30f, l_reg = 0; f32x16 o[NB];
#pragma unroll
    for (int d = 0; d < NB; ++d) o[d] = f32x16{};
    bf16x8 qr[DQK / 16];
    const bf16* Qw = Qb + (size_t)(wid * 32 + r32) * LDQ + hi * 8;
#pragma unroll
    for (int d0 = 0; d0 < DQK / 16; ++d0) qr[d0] = *reinterpret_cast<const bf16x8*>(Qw + d0 * 16);
    const int kr0 = tid / KCH, kc0 = tid % KCH, kr1 = (tid + 512) / KCH, kc1 = (tid + 512) % KCH; const bool k2 = (NKP == 2) && (tid + 512 < 64 * KCH);
    const int kw0 = k_addr<KRS>(kr0, kc0), kw1 = k_addr<KRS>(kr1 & 63, kc1);
    const int vr = tid / VCH, vc = (tid % VCH) * 8, vst0 = v_st<NB>(vr, vc), vst1 = v_st<NB>((32 + vr) & 63, vc);
    const int vb0 = (int)(uintptr_t)V_lds + v_rd_base(lane);
    bf16x8 sk0, sk1, sv0, sv1;
#define AT_SLOAD(k0_) do { const int k0 = (k0_) * kvmul; sv0 = *reinterpret_cast<const bf16x8*>(Vh + (size_t)((k0) + vr) * LDV + vc); if (NVP == 2) sv1 = *reinterpret_cast<const bf16x8*>(Vh + (size_t)((k0) + 32 + vr) * LDV + vc); \
        sk0 = *reinterpret_cast<const bf16x8*>(Kh + (size_t)((k0) + kr0) * LDK + kc0 * 8); if (k2) sk1 = *reinterpret_cast<const bf16x8*>(Kh + (size_t)((k0) + kr1) * LDK + kc1 * 8); } while (0)
#define AT_SWRITE(b) do { *(bf16x8*)(V_lds + (b) * VB + vst0) = sv0; if (NVP == 2) *(bf16x8*)(V_lds + (b) * VB + vst1) = sv1; \
        *(bf16x8*)(K_lds + (b) * KB + kw0) = sk0; if (k2) *(bf16x8*)(K_lds + (b) * KB + kw1) = sk1; } while (0)
#define AT_VMW() asm volatile("s_waitcnt vmcnt(0)" ::: "memory")
#define AT_RESC(a) do { if (__any((a) < 1.f)) { if (hi == 0) al_l[r32] = (a); asm volatile("s_waitcnt lgkmcnt(0)" ::: "memory"); \
        _Pragma("unroll") for (int d_ = 0; d_ < NB; ++d_) _Pragma("unroll") for (int r = 0; r < 16; ++r) o[d_][r] *= al_l[crow(r, hi)]; } } while (0)
    const int NT = 4 * (qb + 1);
    const int qlo = 256 * qb + wid * 32, qm = qlo + r32 - 4 * hi;
#define AT_MASK(P0_, P1_, t) do { const int kb_ = (t) * 64; if (kb_ + 63 > qlo) mask_tile(P0_, P1_, qm - kb_); } while (0)
    f32x16 pA0, pA1, pB0, pB1; float alA, alB; bf16x8 pa0, pa1, pa2, pa3;
    AT_SLOAD(0); AT_VMW(); AT_SWRITE(0); __syncthreads();
    qkt<DQK, KRS>(pA0, pA1, K_lds, r32, hi, qr); AT_MASK(pA0, pA1, 0); partialSM(pA0, pA1, m_reg, alA);
    AT_SLOAD(64); AT_VMW(); AT_SWRITE(1); __syncthreads();
    for (int j = 1; j + 1 < NT; j += 2) {
        SBAR(); qkt<DQK, KRS>(pB0, pB1, K_lds + KB, r32, hi, qr);
        finishSM(pA0, pA1, alA, l_reg, pa0, pa1, pa2, pa3); SBAR();
        AT_SLOAD((j + 1) * 64); SBAR();
        pv_all<NB>(o, vb0, pa0, pa1, pa2, pa3); AT_MASK(pB0, pB1, j); partialSM(pB0, pB1, m_reg, alB);
        __syncthreads(); AT_VMW(); AT_SWRITE(0);
        AT_RESC(alB); __syncthreads();
        SBAR(); qkt<DQK, KRS>(pA0, pA1, K_lds, r32, hi, qr);
        finishSM(pB0, pB1, alB, l_reg, pa0, pa1, pa2, pa3); SBAR();
        AT_SLOAD((j + 2) * 64); SBAR();
        pv_all<NB>(o, vb0 + VB, pa0, pa1, pa2, pa3); AT_MASK(pA0, pA1, j + 1); partialSM(pA0, pA1, m_reg, alA);
        __syncthreads(); AT_VMW(); AT_SWRITE(1);
        AT_RESC(alA); __syncthreads();
    }
    SBAR(); qkt<DQK, KRS>(pB0, pB1, K_lds + KB, r32, hi, qr);
    finishSM(pA0, pA1, alA, l_reg, pa0, pa1, pa2, pa3); SBAR();
    pv_all<NB>(o, vb0, pa0, pa1, pa2, pa3); AT_MASK(pB0, pB1, NT - 1); partialSM(pB0, pB1, m_reg, alB);
    AT_RESC(alB);
    finishSM(pB0, pB1, alB, l_reg, pa0, pa1, pa2, pa3); SBAR();
    pv_all<NB>(o, vb0 + VB, pa0, pa1, pa2, pa3);
    if (hi == 0) li_l[r32] = l_reg; asm volatile("s_waitcnt lgkmcnt(0)" ::: "memory");
    float rli[16];
#pragma unroll
    for (int r = 0; r < 16; ++r) rli[r] = __builtin_amdgcn_rcpf(li_l[crow(r, hi)]);
    bf16* Ow = Ob + (size_t)(wid * 32) * LDO;
#pragma unroll
    for (int r = 0; r < 16; ++r) { const int orow = crow(r, hi);
#pragma unroll
        for (int d0 = 0; d0 < NB; ++d0) { const float v = o[d0][r] * rli[r]; const float vn = shx<1>(v);
            if ((r32 & 1) == 0 && kvmul) *(unsigned*)(Ow + (size_t)orow * LDO + d0 * 32 + r32) = cvtpk(v, vn); } }
    __syncthreads();
#undef AT_SLOAD
#undef AT_SWRITE
#undef AT_VMW
#undef AT_RESC
#undef AT_MASK
}
}
namespace at2 {
using namespace at;
typedef __attribute__((address_space(3))) const char* lds_cptr;
typedef short v4i16_t __attribute__((ext_vector_type(4)));
__device__ __forceinline__ void glds16(const void* gsrc, unsigned lds_dst) { unsigned keep;
    asm volatile("s_mov_b32 %0, m0\n\ts_mov_b32 m0, %2\n\ts_nop 0\n\tglobal_load_lds_dwordx4 %1, off\n\ts_mov_b32 m0, %0" : "=&s"(keep) : "v"(gsrc), "s"(lds_dst) : "memory"); }
__device__ __forceinline__ s16x4 vtr(lds_cptr p) { return __builtin_bit_cast(s16x4, __builtin_amdgcn_ds_read_tr16_b64_v4i16((__attribute__((address_space(3))) v4i16_t*)p)); }
__device__ __forceinline__ bf16x8 kld(lds_cptr p) { return *(const __attribute__((address_space(3))) bf16x8*)p; }
typedef float f32x2_t __attribute__((ext_vector_type(2))); typedef __bf16 bf16x2_t __attribute__((ext_vector_type(2)));
__device__ __forceinline__ unsigned cvtpk_s(float lo, float hi) { f32x2_t v = {lo, hi}; bf16x2_t b = __builtin_convertvector(v, bf16x2_t); return __builtin_bit_cast(unsigned, b); }
constexpr float THRL = 8.f;

template <int DQK, int DV, int LDQ, int LDK, int LDV, int LDO>
__device__ __forceinline__ void attn_unit(const bf16* __restrict__ Qb, const bf16* __restrict__ Kh, const bf16* __restrict__ Vh, bf16* __restrict__ Ob, int qb, char* shm, int kvmul = 1) {
    constexpr int NKS = DQK / 16, NB = DV / 32, KSL = 64 * DQK * 2, VSL = 64 * DV * 2, NKC = DQK / 8, NVP = DV / 8, LDS_K = 0, LDS_V = 3 * KSL, LDS_WS = 3 * KSL + 3 * VSL;
    static_assert(NKC <= 16 && (NVP == 8 || NVP == 16), "piece counts");
    int tid_ = threadIdx.x; asm volatile("" : "+v"(tid_));
    const int tid = tid_, lane = tid & 63, r32 = lane & 31, hi = lane >> 5, wid = __builtin_amdgcn_readfirstlane(tid >> 6);
    const unsigned lds0 = (unsigned)(uintptr_t)shm;
    float* wsf = (float*)(shm + LDS_WS) + wid * 64;
    const bool k2 = (NKC > 8) && (wid < NKC - 8);
    const bf16* ksrc = Kh + (size_t)lane * LDK + wid * 8;
    const bf16* vsrc = Vh + (size_t)(16 * (wid & 3) + (lane >> 2)) * LDV + (wid >> 2) * 32 + (lane & 3) * 8;
#define A2_DMA_K(t, s) do { glds16(ksrc + (size_t)(t) * 64 * LDK, (unsigned)__builtin_amdgcn_readfirstlane(lds0 + LDS_K + (s) * KSL + wid * 1024)); \
        if (k2) glds16(ksrc + (size_t)(t) * 64 * LDK + 64, (unsigned)__builtin_amdgcn_readfirstlane(lds0 + LDS_K + (s) * KSL + (wid + 8) * 1024)); } while (0)
#define A2_DMA_V(t, s) do { glds16(vsrc + (size_t)(t) * 64 * LDV, (unsigned)__builtin_amdgcn_readfirstlane(lds0 + LDS_V + (s) * VSL + wid * 1024)); \
        if (NVP == 16) glds16(vsrc + (size_t)(t) * 64 * LDV + 64, (unsigned)__builtin_amdgcn_readfirstlane(lds0 + LDS_V + (s) * VSL + (wid + 8) * 1024)); } while (0)
#define A2_WAIT_BAR_K() do { if ((k2 ? 2 : 1) + (NVP == 16 ? 2 : 1) == 3) asm volatile("s_waitcnt vmcnt(3) lgkmcnt(0)\n\ts_barrier" ::: "memory"); else asm volatile("s_waitcnt vmcnt(2) lgkmcnt(0)\n\ts_barrier" ::: "memory"); } while (0)
#define A2_WAIT_BAR_0() asm volatile("s_waitcnt vmcnt(0) lgkmcnt(0)\n\ts_barrier" ::: "memory")
    const lds_cptr shm3 = (lds_cptr)shm;
    const lds_cptr kp0 = shm3 + LDS_K + hi * 1024 + r32 * 16;
    const lds_cptr vp0 = shm3 + LDS_V + ((lane >> 4) & 1) * 32 + (lane & 3) * 8 + (4 * hi + ((lane & 15) >> 2)) * 64;
    const int NT = 4 * (qb + 1);
    A2_DMA_K(0, 0); A2_DMA_V(0, 0); A2_DMA_K(1, 1); A2_DMA_V(1, 1);
    bf16x8 qr[NKS];
    { const bf16* Qw = Qb + (size_t)(wid * 32 + r32) * LDQ + hi * 8;
#pragma unroll
      for (int d0 = 0; d0 < NKS; ++d0) qr[d0] = *reinterpret_cast<const bf16x8*>(Qw + d0 * 16); }
    float mhat = 0.f, l_reg = 0.f; f32x16 o[NB];
#pragma unroll
    for (int d = 0; d < NB; ++d) o[d] = f32x16{};
    f32x16 negm = f32x16{};
    const int qlo = 256 * qb + wid * 32, qm = qlo + r32 - 4 * hi;
    A2_WAIT_BAR_0();
    int sl = 0;
#pragma unroll 1
    for (int t = 0; t < NT; ++t) {
        const int sl2 = sl == 0 ? 2 : sl - 1;
        if (t + 2 < NT) { A2_DMA_K(t + 2, sl2); A2_DMA_V(t + 2, sl2); }
        f32x16 c0, c1;
        { const lds_cptr kp = kp0 + sl * KSL;
#pragma unroll
          for (int d0 = 0; d0 < NKS; ++d0) { const bf16x8 b0 = kld(kp + d0 * 2048), b1 = kld(kp + d0 * 2048 + 512);
              c0 = __builtin_amdgcn_mfma_f32_32x32x16_bf16(b0, qr[d0], d0 == 0 ? negm : c0, 0, 0, 0);
              c1 = __builtin_amdgcn_mfma_f32_32x32x16_bf16(b1, qr[d0], d0 == 0 ? negm : c1, 0, 0, 0); } }
        if (t * 64 + 63 > qlo) mask_tile(c0, c1, qm - t * 64);
        float rm = c0[0];
#pragma unroll
        for (int r = 1; r < 16; ++r) rm = fmaxf(rm, c0[r]);
#pragma unroll
        for (int r = 0; r < 16; ++r) rm = fmaxf(rm, c1[r]);
        { auto rr = __builtin_amdgcn_permlane32_swap(__float_as_uint(rm), __float_as_uint(rm), false, false); rm = fmaxf(__uint_as_float(rr[0]), __uint_as_float(rr[1])); }
        if (t == 0 || __builtin_expect(__any(rm > THRL), 0)) {
            const float dl = t == 0 ? rm : fmaxf(rm, 0.f); mhat += dl;
#pragma unroll
            for (int r = 0; r < 16; ++r) { c0[r] -= dl; c1[r] -= dl; }
#pragma unroll
            for (int r = 0; r < 16; ++r) negm[r] = -mhat;
            if (t != 0) { const float f = __builtin_amdgcn_exp2f(-dl); l_reg *= f; if (hi == 0) wsf[r32] = f; asm volatile("s_waitcnt lgkmcnt(0)" ::: "memory");
#pragma unroll
                for (int d_ = 0; d_ < NB; ++d_)
#pragma unroll
                    for (int r = 0; r < 16; ++r) o[d_][r] *= wsf[crow(r, hi)]; }
        }
        float sacc = 0.f;
#pragma unroll
        for (int r = 0; r < 16; ++r) { c0[r] = __builtin_amdgcn_exp2f(c0[r]); sacc += c0[r]; }
#pragma unroll
        for (int r = 0; r < 16; ++r) { c1[r] = __builtin_amdgcn_exp2f(c1[r]); sacc += c1[r]; }
        l_reg += sacc;
        u32x4 pw[4];
#pragma unroll
        for (int k = 0; k < 2; ++k) { pw[k] = (u32x4){cvtpk_s(c0[8 * k], c0[8 * k + 1]), cvtpk_s(c0[8 * k + 2], c0[8 * k + 3]), cvtpk_s(c0[8 * k + 4], c0[8 * k + 5]), cvtpk_s(c0[8 * k + 6], c0[8 * k + 7])};
                                      pw[2 + k] = (u32x4){cvtpk_s(c1[8 * k], c1[8 * k + 1]), cvtpk_s(c1[8 * k + 2], c1[8 * k + 3]), cvtpk_s(c1[8 * k + 4], c1[8 * k + 5]), cvtpk_s(c1[8 * k + 6], c1[8 * k + 7])}; }
        { const lds_cptr vp = vp0 + sl * VSL;
#pragma unroll
          for (int d0 = 0; d0 < NB; ++d0)
#pragma unroll
              for (int ks = 0; ks < 4; ++ks) { const s16x4 lo = vtr(vp + d0 * 4096 + ks * 1024), hh = vtr(vp + d0 * 4096 + ks * 1024 + 512);
                  o[d0] = __builtin_amdgcn_mfma_f32_32x32x16_bf16(__builtin_bit_cast(bf16x8, pw[ks]), (bf16x8){lo[0], lo[1], lo[2], lo[3], hh[0], hh[1], hh[2], hh[3]}, o[d0], 0, 0, 0); } }
        if (t + 2 < NT) A2_WAIT_BAR_K(); else A2_WAIT_BAR_0();
        sl = sl == 2 ? 0 : sl + 1;
    }
    { auto rr = __builtin_amdgcn_permlane32_swap(__float_as_uint(l_reg), __float_as_uint(l_reg), false, false); l_reg = __uint_as_float(rr[0]) + __uint_as_float(rr[1]); }
    if (hi == 0) wsf[32 + r32] = l_reg; asm volatile("s_waitcnt lgkmcnt(0)" ::: "memory");
    float rli[16];
#pragma unroll
    for (int r = 0; r < 16; ++r) rli[r] = __builtin_amdgcn_rcpf(wsf[32 + crow(r, hi)]);
    bf16* Ow = Ob + (size_t)(wid * 32) * LDO;
#pragma unroll
    for (int r = 0; r < 16; ++r) { const int orow = crow(r, hi);
#pragma unroll
        for (int d0 = 0; d0 < NB; ++d0) { const float v = o[d0][r] * rli[r]; const float vn = shx<1>(v);
            if ((r32 & 1) == 0) *(unsigned*)(Ow + (size_t)orow * LDO + d0 * 32 + r32) = cvtpk(v, vn); } }
    asm volatile("s_waitcnt vmcnt(0) lgkmcnt(0)\n\ts_barrier" ::: "memory");
#undef A2_DMA_K
#undef A2_DMA_V
#undef A2_WAIT_BAR_K
#undef A2_WAIT_BAR_0
}
}
namespace at3 {
using namespace at2;
__device__ __forceinline__ void glds16s(const void* sbase, unsigned voff, unsigned lds_dst) { unsigned keep;
    asm volatile("s_mov_b32 %0, m0\n\ts_mov_b32 m0, %3\n\ts_nop 0\n\tglobal_load_lds_dwordx4 %1, %2\n\ts_mov_b32 m0, %0" : "=&s"(keep) : "v"(voff), "s"(sbase), "s"(lds_dst) : "memory"); }
#ifdef A3_HALFPRIO
#define A3_PRIO(p) do { if (wid >= 4) __builtin_amdgcn_s_setprio((p) + 1); else __builtin_amdgcn_s_setprio(p); } while (0)
#else
#define A3_PRIO(p) __builtin_amdgcn_s_setprio(p)
#endif
#define A3_PIN(x) asm volatile("" : "+v"(x))
#define A3_PEL(P0, P1, e) ((e) < 16 ? P0[(e) & 15] : P1[(e) & 15])
template <int DQK, int DV, int LDQ, int LDK, int LDV, int LDO>
__device__ __forceinline__ unsigned attn_unit(const bf16* __restrict__ Qb, const bf16* __restrict__ Kh, const bf16* __restrict__ Vh, bf16* __restrict__ Ob, int qb, char* shm, gu32* qp, volatile LAS unsigned* misc, const float* qn = nullptr, float kmax = 0.f, int kvmul = 1) {
    constexpr int NKS = DQK / 16, NQK = DQK / 8, NB = DV / 32, NPV = 4 * NB, KSL = 64 * DQK * 2, VSL = 64 * DV * 2, NKC = DQK / 8, NVP = DV / 8, LDS_K = 0, LDS_V = 3 * KSL, LDS_WS = 3 * KSL + 3 * VSL;
    static_assert(NKC <= 16 && (NVP == 8 || NVP == 16) && 32 % NQK != 1 && 32 % NPV == 0, "shape");
    int tid_ = threadIdx.x; asm volatile("" : "+v"(tid_));
    const int tid = tid_, lane = tid & 63, r32 = lane & 31, hi = lane >> 5, wid = __builtin_amdgcn_readfirstlane(tid >> 6);
    const int rb = wid < 4 ? wid : 11 - wid;
    const unsigned lds0 = (unsigned)(uintptr_t)shm;
    float* wsf = (float*)(shm + LDS_WS) + wid * 64;
    const bool k2 = (NKC > 8) && (wid < NKC - 8);
    const unsigned kvo = (unsigned)(lane * LDK) * 2u, vvo = (unsigned)((lane >> 2) * LDV + (lane & 3) * 8) * 2u;
    const char* kbs = (const char*)(Kh + wid * 8); const char* vbs = (const char*)(Vh + (size_t)(16 * (wid & 3)) * LDV + (wid >> 2) * 32);
#define A3_DMA_K(t, s) do { const char* b_ = kbs + (size_t)((t) * kvmul) * (64 * LDK * 2); glds16s(b_, kvo, (unsigned)__builtin_amdgcn_readfirstlane(lds0 + LDS_K + (s) * KSL + wid * 1024)); \
        if (k2) glds16s(b_ + 128, kvo, (unsigned)__builtin_amdgcn_readfirstlane(lds0 + LDS_K + (s) * KSL + (wid + 8) * 1024)); } while (0)
#define A3_DMA_V(t, s) do { const char* b_ = vbs + (size_t)((t) * kvmul) * (64 * LDV * 2); glds16s(b_, vvo, (unsigned)__builtin_amdgcn_readfirstlane(lds0 + LDS_V + (s) * VSL + wid * 1024)); \
        if (NVP == 16) glds16s(b_ + 128, vvo, (unsigned)__builtin_amdgcn_readfirstlane(lds0 + LDS_V + (s) * VSL + (wid + 8) * 1024)); } while (0)
#define A3_WB(n) asm volatile("s_waitcnt vmcnt(" #n ") lgkmcnt(0)\n\ts_barrier" ::: "memory")
#define A3_WAIT_BAR(gk, gv) do { const int n_ = ((gk) ? (k2 ? 2 : 1) : 0) + ((gv) ? NVP / 8 : 0); \
        if (n_ == 0) A3_WB(0); else if (n_ == 1) A3_WB(1); else if (n_ == 2) A3_WB(2); else if (n_ == 3) A3_WB(3); else A3_WB(4); } while (0)
    const lds_cptr shm3 = (lds_cptr)shm;
    const lds_cptr kp0 = shm3 + LDS_K + hi * 1024 + r32 * 16;
    const lds_cptr vp0 = shm3 + LDS_V + ((lane >> 4) & 1) * 32 + (lane & 3) * 8 + (4 * hi + ((lane & 15) >> 2)) * 64;
    const int NT = 4 * (qb + 1);
    A3_DMA_K(0, 0); A3_DMA_V(0, 0); A3_DMA_K(1, 1);
    bf16x8 qr[NKS];
    { const bf16* Qw = Qb + (size_t)(rb * 32 + r32) * LDQ + hi * 8;
#pragma unroll
      for (int d0 = 0; d0 < NKS; ++d0) qr[d0] = *reinterpret_cast<const bf16x8*>(Qw + d0 * 16); }
    float mhat = 0.f, l_reg = 0.f; f32x16 o[NB];
#pragma unroll
    for (int d = 0; d < NB; ++d) o[d] = f32x16{};
    f32x16 negm = f32x16{}; asm volatile("" : "+v"(negm));
    const int qlo = 256 * qb + rb * 32, qm = qlo + r32 - 4 * hi, lastw = 4 * qb + (rb >> 1);
    bool fix = false;
    if (qn != nullptr) { const float bnd = qn[(size_t)(rb * 32 + r32) * 8] * kmax * 1.01f; fix = !__any(!(bnd < 100.f)); }
    u32x4 pw[4]; asm volatile("" : "=v"(pw[0]), "=v"(pw[1]), "=v"(pw[2]), "=v"(pw[3])); bool resc = false;
    int slk = 0, slv = 0;
#define A3_KFRAG(kp_, i) kld((kp_) + ((i) >> 1) * 2048 + ((i) & 1) * 512)
#define A3_VFRAG(vp_, j) ((vp_) + ((j) % NB) * 4096 + ((j) / NB) * 1024)
#define A3_MASK(C0_, C1_, t) do { if ((t) * 64 + 63 > qlo) mask_tile(C0_, C1_, qm - (t) * 64); } while (0)
#define A3_ROWMAX(C0_, C1_, rm_) do { float a_ = fmaxf(fmaxf(C0_[0], C0_[1]), C1_[0]), b_ = fmaxf(fmaxf(C0_[2], C0_[3]), C1_[1]); a_ = fmaxf(fmaxf(a_, C1_[2]), C1_[3]); \
        _Pragma("unroll") for (int r = 4; r < 16; r += 4) { a_ = fmaxf(fmaxf(a_, C0_[r]), C0_[r + 1]); b_ = fmaxf(fmaxf(b_, C0_[r + 2]), C0_[r + 3]); a_ = fmaxf(fmaxf(a_, C1_[r]), C1_[r + 1]); b_ = fmaxf(fmaxf(b_, C1_[r + 2]), C1_[r + 3]); } \
        rm_ = fmaxf(a_, b_); { auto rr_ = __builtin_amdgcn_permlane32_swap(__float_as_uint(rm_), __float_as_uint(rm_), false, false); rm_ = fmaxf(__uint_as_float(rr_[0]), __uint_as_float(rr_[1])); } } while (0)
#define A3_STEP(C0, C1, P0, P1, t, BAND) do { \
        const bool gk_ = !(BAND) || ((t) + 2 < NT), gv_ = !(BAND) || ((t) + 1 < NT); \
        const lds_cptr kp_ = kp0 + slk * KSL; const lds_cptr vp_ = vp0 + slv * VSL; \
        bf16x8 kf_[3]; s16x4 vl_[3], vh_[3]; float sacc_ = 0.f; \
        kf_[0] = A3_KFRAG(kp_, 0); kf_[1] = A3_KFRAG(kp_, 1); SBAR(); A3_PRIO(1); \
        _Pragma("unroll") for (int i = 0; i < NQK; ++i) { \
            if (i + 2 < NQK) kf_[(i + 2) % 3] = A3_KFRAG(kp_, i + 2); \
            if (i == NQK - 2) { vl_[0] = vtr(A3_VFRAG(vp_, 0)); vh_[0] = vtr(A3_VFRAG(vp_, 0) + 512); } \
            if (i == NQK - 1) { vl_[1] = vtr(A3_VFRAG(vp_, 1)); vh_[1] = vtr(A3_VFRAG(vp_, 1) + 512); } \
            SBAR(); \
            if ((i & 1) == 0) C0 = __builtin_amdgcn_mfma_f32_32x32x16_bf16(kf_[i % 3], qr[i >> 1], i < 2 ? negm : C0, 0, 0, 0); \
            else C1 = __builtin_amdgcn_mfma_f32_32x32x16_bf16(kf_[i % 3], qr[i >> 1], i < 2 ? negm : C1, 0, 0, 0); \
            _Pragma("unroll") for (int e = (i * 32) / NQK; e < ((i + 1) * 32) / NQK; ++e) sacc_ += A3_PEL(P0, P1, e); \
            A3_PIN(sacc_); \
            _Pragma("unroll") for (int c = (i * 16) / NQK; c < ((i + 1) * 16) / NQK; ++c) { const int e = 2 * c; pw[c >> 2][c & 3] = cvtpk_s(A3_PEL(P0, P1, e), A3_PEL(P0, P1, e + 1)); } \
            A3_PIN(pw[((i * 16) / NQK) >> 2]); \
            SBAR(); } \
        A3_PRIO(0); l_reg += sacc_; \
        if (gk_) A3_DMA_K((t) + 2, slk == 0 ? 2 : slk - 1); if (gv_) A3_DMA_V((t) + 1, slv == 0 ? 2 : slv - 1); \
        if (BAND) A3_MASK(C0, C1, t); \
        if (!fix) { float rm_; A3_ROWMAX(C0, C1, rm_); resc = false; \
          if (__builtin_expect(__any(rm_ > THRL), 0)) { const float dl = fmaxf(rm_, 0.f); mhat += dl; \
              _Pragma("unroll") for (int r = 0; r < 16; ++r) { C0[r] -= dl; C1[r] -= dl; } \
              _Pragma("unroll") for (int r = 0; r < 16; ++r) negm[r] = -mhat; asm volatile("" : "+v"(negm)); \
              const float f = __builtin_amdgcn_exp2f(-dl); l_reg *= f; if (hi == 0) wsf[r32] = f; resc = true; } } \
        SBAR(); A3_PRIO(1); \
        _Pragma("unroll") for (int j = 0; j < NPV; ++j) { \
            if (j + 2 < NPV) { vl_[(j + 2) % 3] = vtr(A3_VFRAG(vp_, j + 2)); vh_[(j + 2) % 3] = vtr(A3_VFRAG(vp_, j + 2) + 512); } \
            SBAR(); \
            o[j % NB] = __builtin_amdgcn_mfma_f32_32x32x16_bf16(__builtin_bit_cast(bf16x8, pw[j / NB]), \
                (bf16x8){vl_[j % 3][0], vl_[j % 3][1], vl_[j % 3][2], vl_[j % 3][3], vh_[j % 3][0], vh_[j % 3][1], vh_[j % 3][2], vh_[j % 3][3]}, o[j % NB], 0, 0, 0); \
            _Pragma("unroll") for (int e = (j * 32) / NPV; e < ((j + 1) * 32) / NPV; ++e) { if (e < 16) C0[e & 15] = __builtin_amdgcn_exp2f(C0[e & 15]); else C1[e & 15] = __builtin_amdgcn_exp2f(C1[e & 15]); } \
            if (((j * 32) / NPV) < 16) A3_PIN(C0); else A3_PIN(C1); \
            SBAR(); } \
        A3_PRIO(0); A3_WAIT_BAR(gk_, gv_); \
        if (resc) { asm volatile("s_waitcnt lgkmcnt(0)" ::: "memory"); \
            _Pragma("unroll") for (int d_ = 0; d_ < NB; ++d_) _Pragma("unroll") for (int r = 0; r < 16; ++r) o[d_][r] *= wsf[crow(r, hi)]; } \
        slk = slk == 2 ? 0 : slk + 1; slv = (t) == 0 ? 0 : (slv == 2 ? 0 : slv + 1); \
    } while (0)
    f32x16 pA0, pA1, pB0, pB1;
    A3_WB(0);
    { const lds_cptr kp_ = kp0;
#pragma unroll
      for (int i = 0; i < NQK; ++i) { const bf16x8 kf = A3_KFRAG(kp_, i);
          if ((i & 1) == 0) pA0 = __builtin_amdgcn_mfma_f32_32x32x16_bf16(kf, qr[i >> 1], i < 2 ? negm : pA0, 0, 0, 0); else pA1 = __builtin_amdgcn_mfma_f32_32x32x16_bf16(kf, qr[i >> 1], i < 2 ? negm : pA1, 0, 0, 0); }
      A3_DMA_K(2, 2); A3_DMA_V(1, 1);
      A3_MASK(pA0, pA1, 0);
      if (!fix) { float rm; A3_ROWMAX(pA0, pA1, rm); mhat = rm;
#pragma unroll
          for (int r = 0; r < 16; ++r) { pA0[r] -= rm; pA1[r] -= rm; }
#pragma unroll
          for (int r = 0; r < 16; ++r) negm[r] = -mhat;
          asm volatile("" : "+v"(negm)); }
#pragma unroll
      for (int r = 0; r < 16; ++r) { pA0[r] = __builtin_amdgcn_exp2f(pA0[r]); pA1[r] = __builtin_amdgcn_exp2f(pA1[r]); }
      A3_WAIT_BAR(true, true);
      slk = 1; slv = 0; }
    int t = 1;
#pragma unroll 1
    for (; t + 5 < NT; t += 2) { A3_STEP(pB0, pB1, pA0, pA1, t, false); A3_STEP(pA0, pA1, pB0, pB1, t + 1, false); }
#define A3_DRAINP(P0, P1) do { float sacc = 0.f; \
        _Pragma("unroll") for (int r = 0; r < 16; ++r) sacc += P0[r]; \
        _Pragma("unroll") for (int r = 0; r < 16; ++r) sacc += P1[r]; \
        l_reg += sacc; \
        _Pragma("unroll") for (int c = 0; c < 16; ++c) { const int e = 2 * c; pw[c >> 2][c & 3] = cvtpk_s(A3_PEL(P0, P1, e), A3_PEL(P0, P1, e + 1)); } \
        const lds_cptr vq_ = vp0 + slv * VSL; \
        s16x4 vl_[3], vh_[3]; vl_[0] = vtr(A3_VFRAG(vq_, 0)); vh_[0] = vtr(A3_VFRAG(vq_, 0) + 512); vl_[1] = vtr(A3_VFRAG(vq_, 1)); vh_[1] = vtr(A3_VFRAG(vq_, 1) + 512); SBAR(); \
        _Pragma("unroll") for (int j = 0; j < NPV; ++j) { \
            if (j + 2 < NPV) { vl_[(j + 2) % 3] = vtr(A3_VFRAG(vq_, j + 2)); vh_[(j + 2) % 3] = vtr(A3_VFRAG(vq_, j + 2) + 512); } \
            SBAR(); \
            o[j % NB] = __builtin_amdgcn_mfma_f32_32x32x16_bf16(__builtin_bit_cast(bf16x8, pw[j / NB]), \
                (bf16x8){vl_[j % 3][0], vl_[j % 3][1], vl_[j % 3][2], vl_[j % 3][3], vh_[j % 3][0], vh_[j % 3][1], vh_[j % 3][2], vh_[j % 3][3]}, o[j % NB], 0, 0, 0); \
            SBAR(); } } while (0)
#define A3_TAIL(t) do { const bool gk_ = (t) + 2 < NT, gv_ = (t) + 1 < NT; \
        if (gk_) A3_DMA_K((t) + 2, slk == 0 ? 2 : slk - 1); if (gv_) A3_DMA_V((t) + 1, slv == 0 ? 2 : slv - 1); \
        A3_WAIT_BAR(gk_, gv_); slk = slk == 2 ? 0 : slk + 1; slv = slv == 2 ? 0 : slv + 1; } while (0)
#pragma unroll 1
    for (; t + 1 < NT; t += 2) { A3_STEP(pB0, pB1, pA0, pA1, t, true); A3_STEP(pA0, pA1, pB0, pB1, t + 1, true); }
    if ((rb >> 1) == 3) { A3_STEP(pB0, pB1, pA0, pA1, NT - 1, true); }
    else { pB0 = pA0; pB1 = pA1; A3_WAIT_BAR(false, false); }
    A3_DRAINP(pB0, pB1);
#undef A3_TAIL
#undef A3_DRAINP
    { auto rr = __builtin_amdgcn_permlane32_swap(__float_as_uint(l_reg), __float_as_uint(l_reg), false, false); l_reg = __uint_as_float(rr[0]) + __uint_as_float(rr[1]); }
    if (hi == 0) wsf[32 + r32] = l_reg; asm volatile("s_waitcnt lgkmcnt(0)" ::: "memory");
    float rli[16];
#pragma unroll
    for (int r = 0; r < 16; ++r) rli[r] = __builtin_amdgcn_rcpf(wsf[32 + crow(r, hi)]);
    constexpr int PC = 64, NPASS = DV / PC, BPP = PC / 32;
    unsigned nxt = 0u; if (tid == 0) nxt = __hip_atomic_fetch_add(qp, 1u, __ATOMIC_RELAXED, __HIP_MEMORY_SCOPE_AGENT);
    LAS char* stg = (LAS char*)shm + LDS_WS + 2048 + wid * 4096;
    LAS char* stw = stg + hi * 512 + r32 * 2;
    bf16* Ow = Ob + (size_t)(rb * 32 + (lane >> 3)) * LDO + (lane & 7) * 8;
#pragma unroll
    for (int ps = 0; ps < NPASS; ++ps) {
#pragma unroll
        for (int r = 0; r < 16; r += 2)
#pragma unroll
            for (int b = 0; b < BPP; ++b) { const unsigned pk = cvtpk(o[ps * BPP + b][r] * rli[r], o[ps * BPP + b][r + 1] * rli[r + 1]);
                *(LAS unsigned short*)(stw + crow(r, 0) * 128 + b * 64) = (unsigned short)pk; *(LAS unsigned short*)(stw + crow(r + 1, 0) * 128 + b * 64) = (unsigned short)(pk >> 16); }
        asm volatile("s_waitcnt lgkmcnt(0)" ::: "memory");
        u32x4 ov[4];
#pragma unroll
        for (int i = 0; i < 4; ++i) ov[i] = *(const LAS u32x4*)(stg + i * 1024 + lane * 16);
        asm volatile("s_waitcnt lgkmcnt(0)" ::: "memory");
        if (kvmul) {
#pragma unroll
            for (int i = 0; i < 4; ++i) *(u32x4*)(Ow + (size_t)(i * 8) * LDO + ps * PC) = ov[i]; }
    }
    if (tid == 0) misc[0] = nxt;
    asm volatile("s_waitcnt lgkmcnt(0)\n\ts_barrier" ::: "memory");
    const unsigned nidx = (unsigned)__builtin_amdgcn_readfirstlane((int)misc[0]);
#undef A3_DMA_K
#undef A3_DMA_V
#undef A3_WB
#undef A3_WAIT_BAR
#undef A3_KFRAG
#undef A3_VFRAG
#undef A3_MASK
#undef A3_ROWMAX
#undef A3_STEP
    return nidx;
}
#undef A3_PIN
#undef A3_PEL
}
namespace ret {
using namespace at;
__device__ __forceinline__ float log2_gamma(int h) { return h == 0 ? -0.04580368961312479f : h == 1 ? -0.02272007650008353f : h == 2 ? -0.011315313227834146f : -0.005646563141142063f; }
constexpr int IMG = 8192;
template <int OFF> __device__ __forceinline__ s16x4 trr(int vb) { s16x4 r; asm volatile("ds_read_b64_tr_b16 %0, %1 offset:%2" : "=&v"(r) : "v"(vb), "i"(OFF) : "memory"); return r; }

__device__ __forceinline__ void state_item(const bf16* __restrict__ RK, const bf16* __restrict__ RV, float* __restrict__ AST, int b, int h, int cp, char* lds) {
    int tid_ = threadIdx.x; asm volatile("" : "+v"(tid_));
    const int tid = tid_, wid = __builtin_amdgcn_readfirstlane(tid >> 6), lane = tid & 63, r32 = lane & 31, hi = lane >> 5;
    const float l2g = log2_gamma(h);
    const size_t row0 = (size_t)b * SEQ + 256 * cp;
    const int key = tid >> 3, c = (tid & 7) * 8, vst = v_st<2>(key, c);
    bf16x8 kk[4], vv[4];
#pragma unroll
    for (int t = 0; t < 4; ++t) { kk[t] = *reinterpret_cast<const bf16x8*>(RK + (row0 + 64 * t + key) * 256 + h * 64 + c); vv[t] = *reinterpret_cast<const bf16x8*>(RV + (row0 + 64 * t + key) * 256 + h * 64 + c); }
#pragma unroll
    for (int t = 0; t < 4; ++t) { const int j = (64 * t + key) & 127; const float z = __builtin_amdgcn_exp2f((float)(127 - j) * l2g);
        u32x4 w; w.x = cvtpk(bf2f(kk[t][0]) * z, bf2f(kk[t][1]) * z); w.y = cvtpk(bf2f(kk[t][2]) * z, bf2f(kk[t][3]) * z); w.z = cvtpk(bf2f(kk[t][4]) * z, bf2f(kk[t][5]) * z); w.w = cvtpk(bf2f(kk[t][6]) * z, bf2f(kk[t][7]) * z);
        *(u32x4*)(lds + t * IMG + vst) = w; *(bf16x8*)(lds + (4 + t) * IMG + vst) = vv[t]; }
    __syncthreads();
    const int half = wid >> 2, db = (wid >> 1) & 1, eb = wid & 1;
    const int va = (int)(uintptr_t)lds + v_rd_base(lane) + db * 512, vb = (int)(uintptr_t)lds + 4 * IMG + v_rd_base(lane) + eb * 512;
    f32x16 acc = f32x16{};
#define RT_STEP(T, KS) do { const s16x4 al = trr<(T) * IMG + v_rd_off<2>(0, KS, 0)>(va2), ah = trr<(T) * IMG + v_rd_off<2>(0, KS, 1)>(va2), bl = trr<(T) * IMG + v_rd_off<2>(0, KS, 0)>(vb2), bh = trr<(T) * IMG + v_rd_off<2>(0, KS, 1)>(vb2); \
        asm volatile("s_waitcnt lgkmcnt(0)" ::: "memory"); SBAR(); \
        acc = __builtin_amdgcn_mfma_f32_32x32x16_bf16((bf16x8){al[0], al[1], al[2], al[3], ah[0], ah[1], ah[2], ah[3]}, (bf16x8){bl[0], bl[1], bl[2], bl[3], bh[0], bh[1], bh[2], bh[3]}, acc, 0, 0, 0); } while (0)
    { const int va2 = va + half * 2 * IMG, vb2 = vb + half * 2 * IMG;
      RT_STEP(0, 0); RT_STEP(0, 1); RT_STEP(0, 2); RT_STEP(0, 3); RT_STEP(1, 0); RT_STEP(1, 1); RT_STEP(1, 2); RT_STEP(1, 3); }
#undef RT_STEP
    asm volatile("s_nop 7\n\ts_nop 7\n\ts_nop 7" : "+v"(acc));
    bf16* dst = (bf16*)AST + ((size_t)((b * 4 + h) * 64 + 2 * cp + half)) * 4096 + (size_t)(32 * db) * 64 + 32 * eb + r32;
#pragma unroll
    for (int r = 0; r < 16; r += 2) { const unsigned pk = cvtpk(acc[r], acc[r + 1]); *(unsigned short*)(dst + crow(r, hi) * 64) = (unsigned short)pk; *(unsigned short*)(dst + crow(r + 1, hi) * 64) = (unsigned short)(pk >> 16); }
    __syncthreads();
}

__device__ __forceinline__ void ret_unit(const bf16* __restrict__ RQ, const bf16* __restrict__ RK, const bf16* __restrict__ RV, const bf16* __restrict__ RG, const float* __restrict__ AST,
                                         const float* __restrict__ gnw, const float* __restrict__ gnb, bf16* __restrict__ MIX, int b, int h, int cp, char* lds) {
    int tid_ = threadIdx.x; asm volatile("" : "+v"(tid_));
    const int tid = tid_, wid = __builtin_amdgcn_readfirstlane(tid >> 6), lane = tid & 63, r32 = lane & 31, hi = lane >> 5;
    const float l2g = log2_gamma(h);
    const size_t row0 = (size_t)b * SEQ + 256 * cp;
    char* K_lds = lds; char* V_lds = lds + 4 * IMG; char* R_lds = lds + 8 * IMG; char* S_lds = lds;
    { const int key = tid >> 3, ch = tid & 7, c = ch * 8, vst = v_st<2>(key, c), kst = k_addr<128>(key, ch);
      bf16x8 kk[4], vv[4];
#pragma unroll
      for (int t = 0; t < 4; ++t) { kk[t] = *reinterpret_cast<const bf16x8*>(RK + (row0 + 64 * t + key) * 256 + h * 64 + c); vv[t] = *reinterpret_cast<const bf16x8*>(RV + (row0 + 64 * t + key) * 256 + h * 64 + c); }
      const float gC = __builtin_amdgcn_exp2f(128.f * l2g);
      const bf16* ap = (const bf16*)AST + (size_t)((b * 4 + h) * 64) * 4096 + (size_t)key * 64 + c;
#define RT_LO4(x) ((f32x4){bf2f((x)[0]), bf2f((x)[1]), bf2f((x)[2]), bf2f((x)[3])})
#define RT_HI4(x) ((f32x4){bf2f((x)[4]), bf2f((x)[5]), bf2f((x)[6]), bf2f((x)[7])})
      f32x4 r0 = {0.f, 0.f, 0.f, 0.f}, r1 = {0.f, 0.f, 0.f, 0.f};
      const int nprev = 2 * cp;
      { float w = 1.0f;
        int j = nprev - 1;
        for (; j >= 7; j -= 8) { bf16x8 xs[8];
#pragma unroll
            for (int q = 0; q < 8; ++q) xs[q] = *reinterpret_cast<const bf16x8*>(ap + (size_t)(j - q) * 4096);
#pragma unroll
            for (int q = 0; q < 8; ++q) { r0 += RT_LO4(xs[q]) * w; r1 += RT_HI4(xs[q]) * w; w *= gC; } }
        if (j >= 1) { bf16x8 xs[6];
#pragma unroll
            for (int q = 0; q < 6; ++q) { if (j - q >= 0) xs[q] = *reinterpret_cast<const bf16x8*>(ap + (size_t)(j - q) * 4096); else xs[q] = bf16x8{}; }
#pragma unroll
            for (int q = 0; q < 6; ++q) { r0 += RT_LO4(xs[q]) * w; r1 += RT_HI4(xs[q]) * w; w *= gC; } } }
      *(u32x4*)(R_lds + vst) = (u32x4){cvtpk(r0[0], r0[1]), cvtpk(r0[2], r0[3]), cvtpk(r1[0], r1[1]), cvtpk(r1[2], r1[3])};
      { const bf16x8 an = *reinterpret_cast<const bf16x8*>(ap + (size_t)nprev * 4096); r0 = RT_LO4(an) + r0 * gC; r1 = RT_HI4(an) + r1 * gC; }
#undef RT_LO4
#undef RT_HI4
      *(u32x4*)(R_lds + IMG + vst) = (u32x4){cvtpk(r0[0], r0[1]), cvtpk(r0[2], r0[3]), cvtpk(r1[0], r1[1]), cvtpk(r1[2], r1[3])};
#pragma unroll
      for (int t = 0; t < 4; ++t) { *(bf16x8*)(K_lds + t * IMG + kst) = kk[t]; *(bf16x8*)(V_lds + t * IMG + vst) = vv[t]; }
    }
    __syncthreads();
    const int half = wid >> 2, wq = wid & 3;
    bf16x8 qr[4];
    { const bf16* Qw = RQ + (row0 + 128 * half + 32 * wq + r32) * 256 + h * 64 + hi * 8;
#pragma unroll
      for (int d0 = 0; d0 < 4; ++d0) qr[d0] = *reinterpret_cast<const bf16x8*>(Qw + d0 * 16); }
    f32x16 o[2]; o[0] = f32x16{}; o[1] = f32x16{};
    const int vbase = (int)(uintptr_t)V_lds + v_rd_base(lane);
    const int iq = 32 * wq + r32;
#pragma unroll
    for (int tt = 0; tt < 2; ++tt) {
        if (64 * tt > 32 * wq + 31) continue;
        f32x16 p0, p1; bf16x8 pa0, pa1, pa2, pa3;
        qkt<64, 128>(p0, p1, K_lds + (2 * half + tt) * IMG, r32, hi, qr);
#pragma unroll
        for (int r = 0; r < 16; ++r) { const int d0_ = iq - (64 * tt + crow(r, hi)), d1_ = d0_ - 32;
            p0[r] = d0_ >= 0 ? p0[r] * __builtin_amdgcn_exp2f((float)d0_ * l2g) : 0.f; p1[r] = d1_ >= 0 ? p1[r] * __builtin_amdgcn_exp2f((float)d1_ * l2g) : 0.f; }
        pack_p(p0, p1, pa0, pa1, pa2, pa3);
        pv_all<2>(o, vbase + (2 * half + tt) * IMG, pa0, pa1, pa2, pa3);
    }
    { f32x16 oc[2]; oc[0] = f32x16{}; oc[1] = f32x16{};
      pv_all<2>(oc, (int)(uintptr_t)R_lds + half * IMG + v_rd_base(lane), qr[0], qr[1], qr[2], qr[3]);
#pragma unroll
      for (int r = 0; r < 16; ++r) { const float xi = __builtin_amdgcn_exp2f((float)(32 * wq + crow(r, hi) + 1) * l2g); o[0][r] += oc[0][r] * xi; o[1][r] += oc[1][r] * xi; } }
    __syncthreads();
    float* st = (float*)(S_lds + wid * 8448);
#pragma unroll
    for (int r = 0; r < 16; ++r) { st[crow(r, hi) * 66 + r32] = o[0][r]; st[crow(r, hi) * 66 + 32 + r32] = o[1][r]; }
    asm volatile("s_waitcnt lgkmcnt(0)" ::: "memory");
    { const int rr = lane >> 1, hh = lane & 1; const float* sp = st + rr * 66 + hh * 32; float x[32]; float s = 0.f;
#pragma unroll
      for (int k = 0; k < 32; ++k) { x[k] = sp[k]; s += x[k]; }
      s += shx<1>(s); const float mean = s * (1.0f / 64.0f); float q = 0.f;
#pragma unroll
      for (int k = 0; k < 32; ++k) { x[k] -= mean; q += x[k] * x[k]; }
      q += shx<1>(q); const float rstd = 1.0f / sqrtf(q * (1.0f / 64.0f) + 1e-6f);
      const size_t grow = row0 + 128 * half + 32 * wq + rr; const int cb = h * 64 + hh * 32;
      const bf16* gp = RG + grow * 256 + cb; bf16* op = MIX + grow * 1024 + 768 + cb;
#pragma unroll
      for (int k8 = 0; k8 < 4; ++k8) { const bf16x8 g8 = *reinterpret_cast<const bf16x8*>(gp + 8 * k8); const f32x4 w0 = *(const f32x4*)(gnw + cb + 8 * k8), w1 = *(const f32x4*)(gnw + cb + 8 * k8 + 4), bb0 = *(const f32x4*)(gnb + cb + 8 * k8), bb1 = *(const f32x4*)(gnb + cb + 8 * k8 + 4);
          float y[8];
#pragma unroll
          for (int k = 0; k < 8; ++k) y[k] = (x[8 * k8 + k] * rstd * (k < 4 ? w0[k & 3] : w1[k & 3]) + (k < 4 ? bb0[k & 3] : bb1[k & 3])) * bf2f(g8[k]);
          *(u32x4*)(op + 8 * k8) = (u32x4){cvtpk(y[0], y[1]), cvtpk(y[2], y[3]), cvtpk(y[4], y[5]), cvtpk(y[6], y[7])}; } }
    __syncthreads();
}

__device__ __forceinline__ void combine_row(const bf16* __restrict__ OD, const float* __restrict__ subln, float lam, float oml, bf16* __restrict__ MIX, size_t row, int lane) {
    const int head = lane >> 4, e0 = (lane & 15) * 8;
    const bf16x8 a = *reinterpret_cast<const bf16x8*>(OD + row * 1024 + head * 256 + e0), b2 = *reinterpret_cast<const bf16x8*>(OD + row * 1024 + head * 256 + 128 + e0);
    float o[8]; float s = 0.f;
#pragma unroll
    for (int k = 0; k < 8; ++k) { o[k] = bf2f(a[k]) - lam * bf2f(b2[k]); s += o[k] * o[k]; }
    s += shx<1>(s); s += shx<2>(s); s += shx<4>(s); s += shx<8>(s);
    const float rs = oml / sqrtf(s * (1.0f / 128.0f) + 1e-5f);
    const f32x4 g0 = *(const f32x4*)(subln + e0), g1 = *(const f32x4*)(subln + e0 + 4);
    *(u32x4*)(MIX + row * 1024 + head * 128 + e0) = (u32x4){cvtpk(o[0] * rs * g0[0], o[1] * rs * g0[1]), cvtpk(o[2] * rs * g0[2], o[3] * rs * g0[3]), cvtpk(o[4] * rs * g1[0], o[5] * rs * g1[1]), cvtpk(o[6] * rs * g1[2], o[7] * rs * g1[3])};
}
__device__ __forceinline__ void combine_rows4(const bf16* __restrict__ OD, const float* __restrict__ subln, float lam, float oml, bf16* __restrict__ MIX, size_t row, size_t stride, int lane) {
    const int head = lane >> 4, e0 = (lane & 15) * 8;
    bf16x8 a[4], b2[4];
#pragma unroll
    for (int k = 0; k < 4; ++k) { a[k] = *reinterpret_cast<const bf16x8*>(OD + (row + k * stride) * 1024 + head * 256 + e0); b2[k] = *reinterpret_cast<const bf16x8*>(OD + (row + k * stride) * 1024 + head * 256 + 128 + e0); }
    const f32x4 g0 = *(const f32x4*)(subln + e0), g1 = *(const f32x4*)(subln + e0 + 4);
#pragma unroll
    for (int k = 0; k < 4; ++k) { float o[8]; float s = 0.f;
#pragma unroll
        for (int j = 0; j < 8; ++j) { o[j] = bf2f(a[k][j]) - lam * bf2f(b2[k][j]); s += o[j] * o[j]; }
        s += shx<1>(s); s += shx<2>(s); s += shx<4>(s); s += shx<8>(s);
        const float rs = oml / sqrtf(s * (1.0f / 128.0f) + 1e-5f);
        const u32x4 w = (u32x4){cvtpk(o[0] * rs * g0[0], o[1] * rs * g0[1]), cvtpk(o[2] * rs * g0[2], o[3] * rs * g0[3]), cvtpk(o[4] * rs * g1[0], o[5] * rs * g1[1]), cvtpk(o[6] * rs * g1[2], o[7] * rs * g1[3])};
        asm volatile("global_store_dwordx4 %0, %1, off sc1\n\ts_nop 1" :: "v"(MIX + (row + k * stride) * 1024 + head * 128 + e0), "v"(w) : "memory"); }
}
}
#ifndef MK_N_LAUNCHES
#define MK_N_LAUNCHES 1
#endif
constexpr int N_PHASES = 16;

struct Args { const void* in[21]; float* out; unsigned char* ws; int ph_lo, ph_hi; };
static_assert(sizeof(Args) == 23 * 8 + 8, "no padding");

__device__ __forceinline__ float wave_sum(float v) { v += shx<1>(v); v += shx<2>(v); v += shx<4>(v); v += shx<8>(v); v += shx<16>(v); return add_x32(v); }
__device__ const float INVF[32] = { 1.000000000e+00f, 7.498942018e-01f, 5.623413324e-01f, 4.216965139e-01f, 3.162277639e-01f, 2.371373922e-01f, 1.778279394e-01f, 1.333521456e-01f, 1.000000015e-01f, 7.498941571e-02f, 5.623412877e-02f,
    4.216964915e-02f, 3.162277862e-02f, 2.371373586e-02f, 1.778279431e-02f, 1.333521493e-02f, 9.999999776e-03f, 7.498942316e-03f, 5.623413250e-03f, 4.216964822e-03f, 3.162277862e-03f, 2.371373819e-03f, 1.778279431e-03f,
    1.333521446e-03f, 1.000000047e-03f, 7.498941850e-04f, 5.623413017e-04f, 4.216965463e-04f, 3.162277862e-04f, 2.371373848e-04f, 1.778279402e-04f, 1.333521504e-04f };

struct WSrc { const float *w_in, *attn_norm, *w_uq, *q_norm, *w_ukv, *kv_norm, *w_out, *w_gate, *w_up, *ffn_norm, *w_down; };
__device__ __forceinline__ int ckv_slot(int p) { const int x = p & 127; if (x < 16) return -1; const int s = ((p >> 7) ? 112 : 0) + x - 16; return s < 128 ? s : -1; }
__device__ __forceinline__ bool src_in(const WSrc& w, int n, int k, const float*& p, float& g) {
    const int pn = n >> 8, q = n & 255, bj = q >> 7, x = q & 127, wc = x >> 5, y = x & 31, rp = 64 * wc + 32 * bj + y; int c;
    switch (pn) {
        case 0: case 1: c = 256 * pn + rp; break;
        case 2: case 3: c = 512 + 256 * (pn - 2) + rp; break;
        case 4: case 5: c = 1024 + 256 * (pn - 4) + q; break;
        case 6: c = 1536 + q; break;
        case 7: if (x < 16) c = 1920 + 16 * bj + x; else { const int s = ckv_slot(q); if (s < 0) return false; c = 1792 + s; } break;
        case 8: c = 1952 + rp; break;
        case 9: c = 2208 + rp; break;
        case 10: c = 2464 + q; break;
        default: c = 2720 + q; break;
    }
    p = w.w_in + (size_t)k * IN_COLS + c; g = w.attn_norm[k]; return true;
}
__device__ __forceinline__ bool src_uq(const WSrc& w, int n, int k, const float*& p, float& g) {
    const int pn = n >> 8, q = n & 255, bj = q >> 7, x = q & 127, wc = x >> 5, y = x & 31, head = 2 * pn + (wc >> 1); int c;
    if ((wc & 1) == 0) c = head * 96 + 32 * bj + y; else { if (y >= 16) return false; c = head * 96 + 64 + 16 * bj + y; }
    p = w.w_uq + (size_t)k * 384 + c; g = w.q_norm[k]; return true;
}
__device__ __forceinline__ bool src_ukv(const WSrc& w, int n, int k, const float*& p, float& g) {
    const int pn = n >> 8, q = n & 255, bj = q >> 7, x = q & 127, wc = x >> 5, y = x & 31, head = 2 * pn + (wc >> 1), c = head * 128 + 64 * (wc & 1) + 32 * bj + y;
    const int s = ckv_slot(k); if (s < 0) return false;
    p = w.w_ukv + (size_t)s * 512 + c; g = w.kv_norm[s]; return true;
}
__device__ __forceinline__ bool src_out(const WSrc& w, int n, int k, const float*& p, float& g) { p = w.w_out + (size_t)k * 1024 + n; g = 1.0f; return true; }
__device__ __forceinline__ bool src_gu(const WSrc& w, int n, int k, const float*& p, float& g) { const int c = 128 * (n >> 8) + (n & 127); p = ((n >> 7) & 1 ? w.w_up : w.w_gate) + (size_t)k * FFH + c; g = w.ffn_norm[k]; return true; }
__device__ __forceinline__ bool src_dn(const WSrc& w, int n, int k, const float*& p, float& g) { p = w.w_down + (size_t)k * 1024 + n; g = 1.0f; return true; }

template <int WHICH> __device__ __forceinline__ void wconv_item(const WSrc& w, bf16* WT, int K, int N, LAS float* scr, int item, int lane) {
    const int nblk = N / 32, kb = item / nblk, nb = item % nblk, k0 = 64 * kb, n0 = 32 * nb;
    const int n4 = n0 + 4 * (lane & 7);
    f32x4 vv[8];
#pragma unroll
    for (int i = 0; i < 8; ++i) { const int k = k0 + 8 * i + (lane >> 3); const float* p = nullptr; float g = 0.f; bool ok;
        if (WHICH == 0) ok = src_in(w, n4, k, p, g); else if (WHICH == 1) ok = src_uq(w, n4, k, p, g); else if (WHICH == 2) ok = src_ukv(w, n4, k, p, g); else if (WHICH == 3) ok = src_out(w, n4, k, p, g); else if (WHICH == 4) ok = src_gu(w, n4, k, p, g); else ok = src_dn(w, n4, k, p, g);
        vv[i] = ok ? *(const GAS f32x4*)p * g : (f32x4){0.f, 0.f, 0.f, 0.f}; }
#pragma unroll
    for (int i = 0; i < 8; ++i) { LAS float* d = scr + (8 * i + (lane >> 3)) * 33 + 4 * (lane & 7); d[0] = vv[i].x; d[1] = vv[i].y; d[2] = vv[i].z; d[3] = vv[i].w; }
    LDS_WAIT(); asm volatile("" ::: "memory");
    const int c = lane & 7;
#pragma unroll
    for (int j = 0; j < 4; ++j) { const int n = (lane >> 3) + 8 * j; const LAS float* s = scr + (8 * c) * 33 + n;
        v4u o; o.x = pk2(s[0 * 33], s[1 * 33]); o.y = pk2(s[2 * 33], s[3 * 33]); o.z = pk2(s[4 * 33], s[5 * 33]); o.w = pk2(s[6 * 33], s[7 * 33]);
        *(GAS v4u*)(WT + (size_t)(n0 + n) * K + k0 + 8 * c) = o; }
    LDS_WAIT(); asm volatile("" ::: "memory");
}
struct Args;
__device__ __forceinline__ int cv_next(gu32* ctr, int gw, int prev, int NGW, int lane) {
    if (!ctr) return prev < 0 ? gw : prev + NGW;
    if (prev >= 0 && (prev & 1) == 0) return prev + 1;
    unsigned v = 0; if (lane == 0) v = __hip_atomic_fetch_add(ctr, 2u, __ATOMIC_RELAXED, __HIP_MEMORY_SCOPE_AGENT);
    return (int)__builtin_amdgcn_readfirstlane((int)v);
}
__device__ __forceinline__ void convert_group(const __attribute__((address_space(4))) Args* a, unsigned char* ws, int layer, int grp, LAS unsigned char* lds, int gw, int NGW, int wave, int lane, gu32* ctr = nullptr) {
    WSrc w;
    w.w_in = (const float*)a->in[3] + (size_t)layer * 1024 * IN_COLS; w.attn_norm = (const float*)a->in[2] + layer * 1024;
    w.w_uq = (const float*)a->in[10] + (size_t)layer * 256 * 384; w.q_norm = (const float*)a->in[9] + layer * 256;
    w.w_ukv = (const float*)a->in[12] + (size_t)layer * 128 * 512; w.kv_norm = (const float*)a->in[11] + layer * 128;
    w.w_out = (const float*)a->in[15] + (size_t)layer * 1024 * 1024; w.ffn_norm = (const float*)a->in[16] + layer * 1024;
    w.w_gate = (const float*)a->in[17] + (size_t)layer * 1024 * FFH; w.w_up = (const float*)a->in[18] + (size_t)layer * 1024 * FFH; w.w_down = (const float*)a->in[19] + (size_t)layer * FFH * 1024;
    LAS float* scr = (LAS float*)(lds + wave * 16384);
    if (grp == 0) {
        constexpr int I0 = (1024 / 64) * (NIN / 32), I1 = (256 / 64) * (512 / 32), I2 = I1;
        for (int it = cv_next(ctr, gw, -1, NGW, lane); it < I0 + I1 + I2; it = cv_next(ctr, gw, it, NGW, lane)) {
            if (it < I0) wconv_item<0>(w, (bf16*)(ws + WS_WIN), 1024, NIN, scr, it, lane);
            else if (it < I0 + I1) wconv_item<1>(w, (bf16*)(ws + WS_WUQ), 256, 512, scr, it - I0, lane);
            else wconv_item<2>(w, (bf16*)(ws + WS_WUKV), 256, 512, scr, it - I0 - I1, lane);
        }
    } else {
        constexpr int I0 = (1024 / 64) * (1024 / 32), I1 = (1024 / 64) * (NGU / 32), I2 = (FFH / 64) * (1024 / 32);
        for (int it = cv_next(ctr, gw, -1, NGW, lane); it < I0 + I1 + I2; it = cv_next(ctr, gw, it, NGW, lane)) {
            if (it < I0) wconv_item<3>(w, (bf16*)(ws + WS_WOUT), 1024, 1024, scr, it, lane);
            else if (it < I0 + I1) wconv_item<4>(w, (bf16*)(ws + WS_WGU), 1024, NGU, scr, it - I0, lane);
            else wconv_item<5>(w, (bf16*)(ws + WS_WDN), FFH, 1024, scr, it - I0 - I1, lane);
        }
    }
}

typedef const __attribute__((address_space(4))) Args* KArgs;
#define P_(T, OFF) ((T*)(ws + (OFF)))
#define ENV() KArgs ap = (KArgs)__builtin_amdgcn_kernarg_segment_ptr(); asm volatile("" : "+s"(ap)); unsigned char* const ws = ap->ws; float* const out = ap->out; (void)out; \
    int tid_o = threadIdx.x; asm volatile("" : "+v"(tid_o)); const int lane_o = tid_o & 63, wave = __builtin_amdgcn_readfirstlane(tid_o >> 6); (void)lane_o; \
    const int G = gridDim.x, bx = blockIdx.x, vcu = (G % 8 == 0) ? (bx % 8) * (G / 8) + bx / 8 : bx, gw = vcu * NWAVES + wave, NGW = G * NWAVES; (void)gw; (void)NGW
#ifndef PROBE_DUP
#define PROBE_DUP 0
#endif
#ifdef PROBE_KV0
#define PROBE_KVARG , (rep == 0 ? 1 : 0)
#else
#define PROBE_KVARG
#endif
#ifndef ATT
#define ATT at3
#endif
#ifndef PROBE_M1S
#define PROBE_M1S 1
#endif
#define NREP(j) (((PROBE_DUP >> (j)) & 1) ? 2 : 1)
__device__ __forceinline__ bool ph_in(int k) { KArgs ap = (KArgs)__builtin_amdgcn_kernarg_segment_ptr(); return ap->ph_lo <= k && k < ap->ph_hi; }
__device__ __forceinline__ void grid_bar(int k, LAS unsigned char* L) {
    if (MK_N_LAUNCHES != 1) return;
    if (!(ph_in(k) && ph_in(k + 1))) return;
    KArgs ap = (KArgs)__builtin_amdgcn_kernarg_segment_ptr();
    XcdBarrier b; b.bar = (unsigned*)(ap->ws + WS_CTL) + CW_BAR; b.x = xb_xcc_id(); b.st = (volatile LAS unsigned*)(L + MISC_OFF) + 8;
    xcd_barrier(b);
#ifdef PROBE_XBAR
    xcd_barrier(b);
#endif
}
template <bool RELEASE> __device__ __forceinline__ void panel_barrier(gu32* cnt, unsigned expected, gu32* tmo) {
    asm volatile("s_waitcnt vmcnt(0)" ::: "memory");
    __syncthreads();
    if (threadIdx.x == 0) {
        if (RELEASE) { __builtin_amdgcn_fence(__ATOMIC_RELEASE, "agent"); asm volatile("s_waitcnt vmcnt(0)" ::: "memory"); }
        (void)__hip_atomic_fetch_add(cnt, 1u, __ATOMIC_RELAXED, __HIP_MEMORY_SCOPE_AGENT);
        __builtin_amdgcn_fence(__ATOMIC_ACQUIRE, "agent");
        unsigned sp = 0;
        while (__hip_atomic_load(cnt, __ATOMIC_RELAXED, __HIP_MEMORY_SCOPE_AGENT) < expected) { __builtin_amdgcn_s_sleep(2);
            if ((++sp & 255u) == 0u) { if (__hip_atomic_load(tmo, __ATOMIC_RELAXED, __HIP_MEMORY_SCOPE_AGENT)) break; if (sp > (1u << 20)) { atomicAdd((unsigned*)tmo, 1u); break; } } }
        asm volatile("s_waitcnt vmcnt(0)" ::: "memory");
    }
    __syncthreads();
}
template <class Sched> __device__ __forceinline__ void prep_row_scales(const Sched& S_, const float* ssq, float inv_n, LAS unsigned char* L) {
    Sched S = S_; asm volatile("" : "+s"(S.c));
    LAS float* tab = (LAS float*)(L + RS_OFF); int t = threadIdx.x; asm volatile("" : "+v"(t));
    if (t < 256) {
        f32x4 v[8]; bool ok[8];
#pragma unroll
        for (int i = 0; i < 8; ++i) { pg8::Unit u; ok[i] = S.next(i, u); if (ok[i]) v[i] = *(const GAS f32x4*)(ssq + (size_t)(u.pm * 256 + t) * 4); }
#pragma unroll
        for (int i = 0; i < 8; ++i) if (ok[i]) tab[i * 256 + t] = 1.0f / sqrtf(((v[i].x + v[i].y) + (v[i].z + v[i].w)) * inv_n + NORM_EPS);
    }
    __syncthreads();
}
__global__ void __launch_bounds__(NWAVES * 64, 2) hyb_fwd(Args args) {
    extern __shared__ __attribute__((aligned(16))) unsigned char lds[];
    LAS unsigned char* L = (LAS unsigned char*)lds;
    volatile LAS unsigned* MISC = (volatile LAS unsigned*)(L + MISC_OFF);
    for (int u = threadIdx.x; u < (LDS_BYTES - LDSCTL_OFF) / 4; u += NWAVES * 64) ((LAS unsigned*)(L + LDSCTL_OFF))[u] = 0u;
    __syncthreads();
    if (MK_N_LAUNCHES == 1) { (void)xcd_barrier_post((unsigned*)(args.ws + WS_CTL) + CW_BAR, MISC + 8); }

    if (ph_in(0)) for (int rep = 0; rep < NREP(7); ++rep) {
        { ENV(); convert_group(ap, ws, 0, 0, L, gw, NGW, wave, lane_o); }
        { ENV(); convert_group(ap, ws, 0, 1, L, gw, NGW, wave, lane_o); }
        { ENV(); const float* x_in = (const float*)ap->in[0]; bf16* XB = P_(bf16, WS_XB); float* SSQ = P_(float, WS_SSQ);
          for (int m = gw; m < MTOK; m += 2 * NGW) {
            f32x4 v[2][4]; float s[2];
#pragma unroll
            for (int k = 0; k < 2; ++k) { const GAS f32x4* xr = (const GAS f32x4*)(x_in + (size_t)(m + k * NGW) * DMODEL) + lane_o;
#pragma unroll
                for (int j = 0; j < 4; ++j) v[k][j] = xr[64 * j]; }
#pragma unroll
            for (int k = 0; k < 2; ++k) { GAS unsigned long long* o8 = (GAS unsigned long long*)(XB + (size_t)(m + k * NGW) * DMODEL) + lane_o; s[k] = 0.f;
#pragma unroll
                for (int j = 0; j < 4; ++j) { const f32x4 w = v[k][j]; s[k] += (w.x * w.x + w.y * w.y) + (w.z * w.z + w.w * w.w); o8[64 * j] = (unsigned long long)pk2(w.x, w.y) | ((unsigned long long)pk2(w.z, w.w) << 32); }
                s[k] = wave_sum(s[k]);
                if (lane_o == 0) *(GAS f32x4*)(SSQ + (size_t)(m + k * NGW) * 4) = (f32x4){s[k], 0.f, 0.f, 0.f}; }
          } }
        { ENV(); const int* pos = (const int*)ap->in[1]; float* T64 = P_(float, WS_T64); float* TM = P_(float, WS_TM);
          for (int i = bx * (NWAVES * 64) + tid_o; i < MTOK * 32; i += G * NWAVES * 64) {
            const int row = i >> 5, f = i & 31; const float ang = (float)pos[row] * INVF[f];
            const double ad = (double)ang, kd = __builtin_rint(ad * 0.15915494309189535), rd = __builtin_fma(-kd, 6.283185307179586, ad);
            const float rev = (float)(rd * 0.15915494309189535), sn = __builtin_amdgcn_sinf(rev), cs = __builtin_amdgcn_cosf(rev);
            T64[(size_t)row * 64 + f] = cs; T64[(size_t)row * 64 + 32 + f] = sn;
            if ((f & 1) == 0) { TM[(size_t)row * 32 + (f >> 1)] = cs; TM[(size_t)row * 32 + 16 + (f >> 1)] = sn; }
          } }
    }
    grid_bar(0, L);

#pragma unroll 1
    for (int layer = 0; layer < DEPTH; ++layer) {
        const int P = 1 + 7 * layer;
        if (ph_in(P)) {
            ENV();
            pg8::Gemm g{P_(bf16, WS_XB), P_(const bf16, WS_WIN), MTOK, NIN, DMODEL}; pg8::StaticOrder S; S.init(MTOK, NIN, G, bx);
            prep_row_scales(S, P_(const float, WS_SSQ), 1.0f / 1024.0f, L);
            pg8::EpiG1 E{ws, layer, (const LAS float*)(L + RS_OFF)};
            for (int rep = 0; rep < NREP(0); ++rep) pg8::gemm_phase<pg8::EpiG1, pg8::StaticOrder, true, true>(L, g, S, E);
        }
        grid_bar(P, L);
        if (ph_in(P + 1)) {
            for (int rep = 0; rep < NREP(1); ++rep) {
            { ENV(); int K1 = 256; asm volatile("" : "+s"(K1));
              pg8::Gemm g{P_(bf16, WS_CQ), P_(const bf16, WS_WUQ), MTOK, 512, K1}; pg8::StaticOrder S; S.init(MTOK, 512, G, bx);
              pg8::EpiMQ E{ws}; pg8::gemm_phase<pg8::EpiMQ, pg8::StaticOrder, true, true>(L, g, S, E); }
            { ENV(); int K1 = 256; asm volatile("" : "+s"(K1));
              pg8::Gemm g{P_(bf16, WS_CKV), P_(const bf16, WS_WUKV), MTOK, 512, K1}; pg8::StaticOrder S; S.init(MTOK, 512, G, (bx + G / 2) % G);
              pg8::EpiMKV E{ws}; pg8::gemm_phase<pg8::EpiMKV, pg8::StaticOrder, true, true>(L, g, S, E); }
            for (int rs_ = 0; rs_ < PROBE_M1S; ++rs_) { ENV(); for (int u = bx; u < 256; u += G) ret::state_item(P_(bf16, WS_RK), P_(bf16, WS_RV), P_(float, WS_AST), u >> 7, (u >> 5) & 3, u & 31, (char*)lds); }
            }
        }
        grid_bar(P + 1, L);
        if (ph_in(P + 2)) {
            for (int rep = 0; rep < NREP(2); ++rep) {
            const unsigned myx = xb_xcc_id() & 7u;
            for (unsigned s = 0; s < 8; ++s) { const unsigned xq = (myx + s) & 7u;
                gu32* qp; { ENV(); qp = (gu32*)(ws + WS_CTL) + CW_Q + layer * 1024 + rep * 512 + 64 * xq; }
#define POP_SYNC() do { int t0_ = threadIdx.x; asm volatile("" : "+v"(t0_)); __syncthreads(); if (t0_ == 0) MISC[0] = __hip_atomic_fetch_add(qp, 1u, __ATOMIC_RELAXED, __HIP_MEMORY_SCOPE_AGENT); __syncthreads(); idx = (unsigned)__builtin_amdgcn_readfirstlane((int)MISC[0]); } while (0)
                unsigned idx; POP_SYNC();
                while (idx < 128u) {
                    ENV();
                    if (idx >= 96u) { ret::ret_unit(P_(bf16, WS_RQ), P_(bf16, WS_RK), P_(bf16, WS_RV), P_(bf16, WS_RG), P_(float, WS_AST), (const float*)ap->in[13] + layer * 256, (const float*)ap->in[14] + layer * 256,
                                                    P_(bf16, WS_MIX), (int)(xq >> 2), (int)(xq & 3u), 127 - (int)idx, (char*)lds); POP_SYNC(); continue; }
                    const int qb = 31 - (int)(idx / 3u), kind = (int)(idx % 3u), b = (int)(xq >> 2), head = (int)(xq & 3u);
                    const size_t r0 = (size_t)b * SEQ, rq = r0 + 256 * qb;
                    if (kind < 2) idx = ATT::attn_unit<64, 128, 512, 512, 512, 1024>(P_(bf16, WS_DQ) + rq * 512 + head * 128 + kind * 64, P_(bf16, WS_DK) + r0 * 512 + head * 128 + kind * 64, P_(bf16, WS_DV) + r0 * 512 + head * 128,
                                                                                (bf16*)out + rq * 1024 + head * 256 + kind * 128, qb, (char*)lds, qp, MISC, P_(const float, WS_QN) + rq * 8 + head * 2 + kind,
                                                                                __hip_atomic_load((float*)((gu32*)(ws + WS_CTL) + CW_KM + layer * 64 + b * 8 + head * 2 + kind), __ATOMIC_RELAXED, __HIP_MEMORY_SCOPE_AGENT) PROBE_KVARG);
                    else idx = ATT::attn_unit<96, 64, 384, 384, 256, 1024>(P_(bf16, WS_MQ) + rq * 384 + head * 96, P_(bf16, WS_MK) + r0 * 384 + head * 96, P_(bf16, WS_MV) + r0 * 256 + head * 64, P_(bf16, WS_MIX) + rq * 1024 + 512 + head * 64, qb, (char*)lds, qp, MISC PROBE_KVARG);
                } }
            { ENV(); if (layer == 1 || G != 256) convert_group(ap, ws, 1, layer == 0 ? 0 : 1, L, gw, NGW, wave, lane_o); }
            }
        }
        grid_bar(P + 2, L);
        if (ph_in(P + 4)) {
            ENV();
            pg8::Gemm g{P_(bf16, WS_MIX), P_(const bf16, WS_WOUT), MTOK, DMODEL, DMODEL}; pg8::StaticOrder S; S.init(MTOK, DMODEL, G, bx);
            if (G == 256) {
                pg8::Unit u0; (void)S.next(0, u0);
                { const float s1 = wave_sum(((const float*)ap->in[4])[layer * 64 + lane_o] * ((const float*)ap->in[5])[layer * 64 + lane_o]), s2 = wave_sum(((const float*)ap->in[6])[layer * 64 + lane_o] * ((const float*)ap->in[7])[layer * 64 + lane_o]);
                  const float lam_init = layer == 0 ? 0.2f : 0.35550906759096934f, lam = __builtin_amdgcn_exp2f(s1 * LOG2E) - __builtin_amdgcn_exp2f(s2 * LOG2E) + lam_init;
                  const float* subln = (const float*)ap->in[8] + layer * 128;
                  const size_t r0 = (size_t)u0.pm * 256 + (size_t)u0.pn * 64 + (size_t)wave * 8;
                  ret::combine_rows4((const bf16*)out, subln, lam, 1.0f - lam_init, P_(bf16, WS_MIX), r0, (size_t)1, lane_o);
                  ret::combine_rows4((const bf16*)out, subln, lam, 1.0f - lam_init, P_(bf16, WS_MIX), r0 + 4, (size_t)1, lane_o); }
                panel_barrier<false>((gu32*)(ws + WS_CTL) + CW_P + (layer * 64 + u0.pm) * 64, 4u, (gu32*)(ws + WS_CTL) + CW_TMO);
                pg8::EpiRes E{ws, 0, 0, nullptr, nullptr};
                for (int rep = 0; rep < NREP(4); ++rep) { E.dry = rep; pg8::gemm_phase<pg8::EpiRes, pg8::StaticOrder, false, true>(L, g, S, E); }
            }
        }
        grid_bar(P + 4, L);
        if (ph_in(P + 5)) {
            ENV();
            pg8::Gemm g{P_(bf16, WS_XB), P_(const bf16, WS_WGU), MTOK, NGU, DMODEL}; pg8::StaticOrder S; S.init(MTOK, NGU, G, bx);
            prep_row_scales(S, P_(const float, WS_SSQ), 1.0f / 1024.0f, L);
            pg8::EpiGU E{ws, (const LAS float*)(L + RS_OFF)};
            for (int rep = 0; rep < NREP(5); ++rep) pg8::gemm_phase<pg8::EpiGU, pg8::StaticOrder, true, true>(L, g, S, E);
            if (layer == 0 && G == 256 && bx >= 128) convert_group(ap, ws, 1, 0, L, (bx - 128) * NWAVES + wave, 128 * NWAVES, wave, lane_o);
        }
        grid_bar(P + 5, L);
        if (ph_in(P + 6)) {
            ENV();
            pg8::Gemm g{P_(bf16, WS_H), P_(const bf16, WS_WDN), MTOK, DMODEL, FFH}; pg8::StaticOrder S; S.init(MTOK, DMODEL, G, bx);
            const bool ffin = layer == 1 && G == 256 && ph_in(15);
            pg8::EpiRes E{ws, 0, ffin ? 1 : 0, (const float*)ap->in[20], out};
            if (G == 256) for (int rep = 0; rep < NREP(6); ++rep) { E.dry = rep; pg8::gemm_phase<pg8::EpiRes, pg8::StaticOrder, false, true>(L, g, S, E); }
        }
        if (!(layer == 1 && gridDim.x == 256 && ph_in(P + 6))) grid_bar(P + 6, L);
    }
    if (ph_in(15) && !(gridDim.x == 256 && ph_in(14))) {
        for (int rep = NREP(8) - 1; rep >= 0; --rep) {
        ENV(); const float* fn = (const float*)ap->in[20]; const float* SSQ = P_(float, WS_SSQ);
        for (int m = gw; m < MTOK; m += 2 * NGW) {
            bf16x8 v[2][2]; f32x4 s4[2];
#pragma unroll
            for (int k = 0; k < 2; ++k) { const bf16* xr = P_(bf16, WS_XB) + (size_t)(m + k * NGW) * DMODEL + 8 * lane_o; s4[k] = *(const f32x4*)(SSQ + (size_t)(m + k * NGW) * 4);
                v[k][0] = *(const bf16x8*)xr; v[k][1] = *(const bf16x8*)(xr + 512); }
#pragma unroll
            for (int k = 0; k < 2; ++k) { float* orow = out + (size_t)(m + k * NGW) * DMODEL + 8 * lane_o;
                const float rs = 1.0f / sqrtf(((s4[k][0] + s4[k][1]) + (s4[k][2] + s4[k][3])) * (1.0f / 1024.0f) + NORM_EPS);
#pragma unroll
                for (int hh = 0; hh < 2; ++hh) { const f32x4 g0 = *(const f32x4*)(fn + hh * 512 + 8 * lane_o), g1 = *(const f32x4*)(fn + hh * 512 + 8 * lane_o + 4); const bf16x8 b = v[k][hh];
                    const f32x4 w0 = {at::bf2f(b[0]) * rs * g0[0], at::bf2f(b[1]) * rs * g0[1], at::bf2f(b[2]) * rs * g0[2], at::bf2f(b[3]) * rs * g0[3]}, w1 = {at::bf2f(b[4]) * rs * g1[0], at::bf2f(b[5]) * rs * g1[1], at::bf2f(b[6]) * rs * g1[2], at::bf2f(b[7]) * rs * g1[3]};
                    if (rep == 0) { *(f32x4*)(orow + hh * 512) = w0; *(f32x4*)(orow + hh * 512 + 4) = w1; } } }
        }
        }
    }
}

extern "C" void kernel_launch(void* const* d_in, const int* in_sizes, int n_in, void* d_out, int out_size, void* d_ws, size_t ws_size, hipStream_t stream) {
    static int grid = 0;
    if (grid == 0) {
        if (n_in != 21 || in_sizes[0] != MTOK * DMODEL || out_size != MTOK * DMODEL || ws_size < WS_END) { fprintf(stderr, "kernel_launch: unexpected shapes (n_in %d, in0 %d, out %d, ws %zu)\n", n_in, n_in > 0 ? in_sizes[0] : -1, out_size, ws_size); grid = -1; return; }
        int dev = 0, cus = 0, per_cu = 0;
        if (hipGetDevice(&dev) != hipSuccess || hipDeviceGetAttribute(&cus, hipDeviceAttributeMultiprocessorCount, dev) != hipSuccess) { grid = -1; return; }
        if (hipFuncSetAttribute((const void*)hyb_fwd, hipFuncAttributeMaxDynamicSharedMemorySize, LDS_BYTES) != hipSuccess) { fprintf(stderr, "kernel_launch: hipFuncSetAttribute failed\n"); grid = -1; return; }
        if (hipOccupancyMaxActiveBlocksPerMultiprocessor(&per_cu, (const void*)hyb_fwd, NWAVES * 64, LDS_BYTES) != hipSuccess) per_cu = 0;
        (void)hipGetLastError();
        if (per_cu < 1 || cus * per_cu < 256) { fprintf(stderr, "kernel_launch: %d CUs x %d resident workgroups cannot hold the 256-workgroup grid\n", cus, per_cu); grid = -1; return; }
        grid = 256;
    }
    if (grid < 0) return;
    (void)hipMemsetAsync((char*)d_ws + WS_CTL, 0, CTL_ZERO_BYTES, stream);
    Args a{};
    for (int i = 0; i < 21; ++i) a.in[i] = d_in[i];
    a.out = (float*)d_out; a.ws = (unsigned char*)d_ws;
    if (MK_N_LAUNCHES == 1) { a.ph_lo = 0; a.ph_hi = N_PHASES; hipLaunchKernelGGL(hyb_fwd, dim3(grid), dim3(NWAVES * 64), LDS_BYTES, stream, a); }
    else for (int p = 0; p < N_PHASES; ++p) { a.ph_lo = p; a.ph_hi = p + 1; hipLaunchKernelGGL(hyb_fwd, dim3(grid), dim3(NWAVES * 64), LDS_BYTES, stream, a); }
}
```

```cpp
#define A3_TWOLV 0
#include <hip/hip_runtime.h>
#include <hip/hip_bf16.h>
#include <cstdio>
#include <cstdint>
#include <cmath>
namespace pg8 {
#define PG8_LAS __attribute__((address_space(3)))
typedef unsigned short bf16_t;
typedef short bf16x8 __attribute__((ext_vector_type(8)));
typedef float f32x4 __attribute__((ext_vector_type(4)));
typedef unsigned u32x4 __attribute__((ext_vector_type(4)));
constexpr int BM = 256, BK = 64, HALF = 128, HTB = HALF * BK * 2  , STAGE_BYTES = 8 * HTB, NXCD = 8, WGM = 8;

__host__ __device__ __forceinline__ int lds_byte(int r, int c) { const int st = (r >> 4) * 2 + (c >> 5), rr = r & 15, cc = c & 31, ob = rr * 64 + cc * 2; return st * 1024 + (ob ^ (((ob >> 9) & 1) << 5)); }
__host__ __device__ __forceinline__ void stage_rc(int b, int& R, int& C) { const int st = b / 1024, sb = b % 1024, swz = sb ^ (((sb >> 9) & 1) << 5); R = (st >> 1) * 16 + swz / 64; C = (st & 1) * 32 + (swz % 64) / 2; }
__host__ __device__ __forceinline__ int perm32(int rho) { const int n = rho >> 4, i = rho & 15; return 8 * (i >> 2) + 4 * n + (i & 3); }

struct Unit { int pm, pn, half, ord; };
struct Gemm { const bf16_t* A; const bf16_t* Bt; int M, N, K; };

struct StaticOrder {
    int nM, nN, nwg, G, c;
    __host__ __device__ void init(int M, int N, int G_, int c_) { nM = M / BM; nN = N / BM; nwg = nM * nN; G = G_; c = c_; }
    __host__ __device__ __attribute__((always_inline)) bool next(int i, Unit& u) const {
        const long L = (long)i * G + c; if (L >= nwg) return false;
        int wgid = (int)L; { const int q = nwg / NXCD, r = nwg % NXCD, xcd = wgid % NXCD, off = wgid / NXCD; wgid = (xcd < r ? xcd * (q + 1) : r * (q + 1) + (xcd - r) * q) + off; }
        const int nig = WGM * nN, gid = wgid / nig, fm = gid * WGM, gsz = (nM - fm) < WGM ? (nM - fm) : WGM;
        u.pm = fm + ((wgid % nig) % gsz); u.pn = (wgid % nig) / gsz; u.half = 0; u.ord = i; return true;
    }
    __device__ __forceinline__ void a_ready(const Unit&) const {}
    __device__ __forceinline__ void done(const Unit&) const {}
};
struct StaticOrderSplit {
    StaticOrder so; int nfull, rem, mode;
    __host__ __device__ void init(int M, int N, int G_, int c_, int mode_ = 0) { so.init(M, N, G_, c_); nfull = so.nwg / G_; rem = so.nwg % G_; mode = mode_; }
    __host__ __device__ __attribute__((always_inline)) bool next(int i, Unit& u) const {
        if (mode == 1 && i >= nfull) return false;
        if (mode == 2) { if (i > 0) return false; i = nfull; }
        if (i < nfull || 2 * rem != so.G) return so.next(i, u);
        if (i > nfull) return false;
        StaticOrder t = so; t.c = so.c >> 1; t.G = so.G; const long L = (long)nfull * so.G + (so.c >> 1); if (L >= so.nwg) return false;
        StaticOrder t2 = so; t2.c = (int)(L - (long)nfull * so.G);
        if (!t2.next(nfull, u)) return false; u.half = 1 + (so.c & 1); return true;
    }
    __device__ __forceinline__ void a_ready(const Unit&) const {}
    __device__ __forceinline__ void done(const Unit&) const {}
};

__device__ __forceinline__ unsigned cvt_pk_bf16(float lo, float hi) { unsigned r; asm volatile("v_cvt_pk_bf16_f32 %0, %1, %2" : "=v"(r) : "v"(lo), "v"(hi)); return r; }
typedef float f32x2 __attribute__((ext_vector_type(2)));
template <class Epi, class Sched, bool ALIGN_EPI = false, bool SP2 = false, bool HALF_OK = false>
__device__ __forceinline__ void gemm_phase(PG8_LAS unsigned char* lds, const Gemm g, const Sched& S, const Epi& E) {
    int tid_ = threadIdx.x; asm volatile("" : "+v"(tid_));
    const int tid = tid_, wid = __builtin_amdgcn_readfirstlane(tid >> 6), lane = tid & 63, wr = wid >> 2, wc = wid & 3, fr = lane & 15, fq = lane >> 4;
    const int K = g.K, nt = K / BK;
    unsigned voffA[2], voffB[2];
#pragma unroll
    for (int i = 0; i < 2; ++i) { int R, C; stage_rc(tid * 16 + i * 8192, R, C); const int Rb = Epi::PERM ? ((R & ~31) + perm32(R & 31)) : R;
        voffA[i] = (unsigned)(R * K + C) * 2u; voffB[i] = (unsigned)(Rb * K + C) * 2u; }
    const size_t kstep = (size_t)(BK * 2);
    const size_t hstep = (size_t)HALF * K * 2;
    const size_t tstep = 2 * hstep;
    const unsigned ldsw = (unsigned)wid * 1024u;
    const int aoff = lds_byte(wr * 64 + fr, fq * 8), boff = lds_byte(wc * 32 + fr, fq * 8);
#define PG8_SA(b, h) (((b) * 2 + (h)) * HTB)
#define PG8_SB(b, h) ((4 + (b) * 2 + (h)) * HTB)
#define PG8_STAGE(bufoff, gbase, voff) do { _Pragma("unroll") for (int _i = 0; _i < 2; ++_i) \
        __builtin_amdgcn_global_load_lds((const unsigned*)((const char*)(gbase) + (voff)[_i]), (PG8_LAS unsigned*)(lds + (bufoff) + ldsw + _i * 8192), 16, 0, 0); } while (0)
#define PG8_LDA(dst, b, h) do { _Pragma("unroll") for (int m = 0; m < 4; ++m) _Pragma("unroll") for (int k = 0; k < 2; ++k) dst[m][k] = *(const PG8_LAS bf16x8*)(lds + PG8_SA(b, h) + aoff + m * 2048 + k * 1024); } while (0)
#define PG8_LDB(dst, b, h) do { _Pragma("unroll") for (int n = 0; n < 2; ++n) _Pragma("unroll") for (int k = 0; k < 2; ++k) dst[n][k] = *(const PG8_LAS bf16x8*)(lds + PG8_SB(b, h) + boff + n * 2048 + k * 1024); } while (0)
#define PG8_MMA(ai, bj, At, Bt) do { if (HALF_OK && cur.half != 0 && cur.half != (ai) + 1) break; __builtin_amdgcn_s_setprio(1); _Pragma("unroll") for (int m = 0; m < 4; ++m) _Pragma("unroll") for (int n = 0; n < 2; ++n) _Pragma("unroll") for (int k = 0; k < 2; ++k) \
        acc[ai][bj][m][n] = __builtin_amdgcn_mfma_f32_16x16x32_bf16(Bt[n][k], At[m][k], acc[ai][bj][m][n], 0, 0, 0); __builtin_amdgcn_s_setprio(0); } while (0)
#define PG8_WAIT_V(n) asm volatile("s_waitcnt vmcnt(" #n ")" ::: "memory")
#define PG8_WAIT_L(n) asm volatile("s_waitcnt lgkmcnt(" #n ")" ::: "memory")
#define PG8_BAR __builtin_amdgcn_s_barrier()
#define PG8_SCHED __builtin_amdgcn_sched_barrier(0)
    Unit cur, nxt; int ui = 0;
    if (!S.next(0, cur)) return;
    f32x4 acc[2][2][4][2];
#pragma unroll
    for (int a = 0; a < 2; ++a)
#pragma unroll
        for (int b = 0; b < 2; ++b)
#pragma unroll
            for (int m = 0; m < 4; ++m)
#pragma unroll
                for (int n = 0; n < 2; ++n) acc[a][b][m][n] = (f32x4){0.f, 0.f, 0.f, 0.f};
    bf16x8 At[4][2], B0[2][2], B1[2][2];
    const char* cA = (const char*)g.A + (size_t)cur.pm * tstep; const char* cB = (const char*)g.Bt + (size_t)cur.pn * tstep;
    S.a_ready(cur);
    if constexpr (SP2) {
        PG8_STAGE(PG8_SB(0, 0), cB, voffB); PG8_STAGE(PG8_SB(0, 1), cB + hstep, voffB); PG8_STAGE(PG8_SA(0, 0), cA, voffA); PG8_STAGE(PG8_SA(0, 1), cA + hstep, voffA);
        if (wr == 1) PG8_BAR;
        PG8_WAIT_V(2); PG8_BAR;
        PG8_STAGE(PG8_SB(1, 0), cB + kstep, voffB); PG8_STAGE(PG8_SA(1, 0), cA + kstep, voffA); PG8_STAGE(PG8_SB(1, 1), cB + hstep + kstep, voffB);
        PG8_WAIT_V(6); PG8_BAR;
    } else {
        PG8_STAGE(PG8_SB(0, 0), cB, voffB); PG8_STAGE(PG8_SA(0, 0), cA, voffA); PG8_STAGE(PG8_SB(0, 1), cB + hstep, voffB); PG8_STAGE(PG8_SA(0, 1), cA + hstep, voffA);
        if (wr == 1) PG8_BAR;
        PG8_WAIT_V(4); PG8_BAR;
        PG8_STAGE(PG8_SB(1, 0), cB + kstep, voffB); PG8_STAGE(PG8_SA(1, 0), cA + kstep, voffA); PG8_STAGE(PG8_SB(1, 1), cB + hstep + kstep, voffB);
        PG8_WAIT_V(6); PG8_BAR;
    }
    for (;;) {
        const bool has_next = S.next(ui + 1, nxt);
        const char* nA = has_next ? (const char*)g.A + (size_t)nxt.pm * tstep : cA; const char* nB = has_next ? (const char*)g.Bt + (size_t)nxt.pn * tstep : cB;
        for (int t = 0; t < nt; t += 2) {
            const bool last = (t == nt - 2);
            const char* a1 = cA + (size_t)(t + 1) * kstep;
            const char* a2 = last ? nA : cA + (size_t)(t + 2) * kstep; const char* b2 = last ? nB : cB + (size_t)(t + 2) * kstep;
            const char* a3 = a2 + kstep; const char* b3 = b2 + kstep;
            if (last && has_next) S.a_ready(nxt);
            if constexpr (SP2) {
            PG8_LDB(B0, 0, 0); PG8_LDB(B1, 0, 1); PG8_SCHED; PG8_LDA(At, 0, 0); PG8_STAGE(PG8_SA(1, 1), a1 + hstep, voffA);
            PG8_WAIT_V(8); PG8_WAIT_L(0); PG8_BAR; PG8_MMA(0, 0, At, B0); PG8_MMA(0, 1, At, B1); PG8_BAR; PG8_SCHED;
            PG8_LDA(At, 0, 1); PG8_STAGE(PG8_SB(0, 0), b2, voffB); PG8_STAGE(PG8_SB(0, 1), b2 + hstep, voffB); PG8_STAGE(PG8_SA(0, 0), a2, voffA);
            PG8_WAIT_V(8); PG8_WAIT_L(0); PG8_BAR; PG8_MMA(1, 0, At, B0); PG8_MMA(1, 1, At, B1); PG8_BAR; PG8_SCHED;
            PG8_LDB(B0, 1, 0); PG8_LDB(B1, 1, 1); PG8_SCHED; PG8_LDA(At, 1, 0); PG8_STAGE(PG8_SA(0, 1), a2 + hstep, voffA);
            PG8_WAIT_V(8); PG8_WAIT_L(0); PG8_BAR; PG8_MMA(0, 0, At, B0); PG8_MMA(0, 1, At, B1); PG8_BAR; PG8_SCHED;
            PG8_LDA(At, 1, 1); PG8_STAGE(PG8_SB(1, 0), b3, voffB); PG8_STAGE(PG8_SB(1, 1), b3 + hstep, voffB); PG8_STAGE(PG8_SA(1, 0), a3, voffA);
            PG8_WAIT_V(8); PG8_WAIT_L(0); PG8_BAR; PG8_MMA(1, 0, At, B0); PG8_MMA(1, 1, At, B1); PG8_BAR; PG8_SCHED;
            } else {
            PG8_LDB(B0, 0, 0); PG8_SCHED; PG8_LDA(At, 0, 0); PG8_STAGE(PG8_SA(1, 1), a1 + hstep, voffA);
            PG8_WAIT_L(8); PG8_BAR; PG8_WAIT_L(0); PG8_MMA(0, 0, At, B0); PG8_BAR; PG8_SCHED;
            PG8_LDB(B1, 0, 1); PG8_STAGE(PG8_SB(0, 0), b2, voffB);
            PG8_BAR; PG8_WAIT_L(0); PG8_MMA(0, 1, At, B1); PG8_BAR;
            PG8_LDA(At, 0, 1); PG8_STAGE(PG8_SA(0, 0), a2, voffA);
            PG8_BAR; PG8_WAIT_L(0); PG8_MMA(1, 0, At, B0); PG8_BAR; PG8_SCHED;
            PG8_STAGE(PG8_SB(0, 1), b2 + hstep, voffB);
            PG8_WAIT_V(6); PG8_BAR; PG8_MMA(1, 1, At, B1); PG8_BAR;
            PG8_LDB(B0, 1, 0); PG8_SCHED; PG8_LDA(At, 1, 0); PG8_STAGE(PG8_SA(0, 1), a2 + hstep, voffA);
            PG8_WAIT_L(8); PG8_BAR; PG8_WAIT_L(0); PG8_MMA(0, 0, At, B0); PG8_BAR; PG8_SCHED;
            PG8_LDB(B1, 1, 1); PG8_STAGE(PG8_SB(1, 0), b3, voffB);
            PG8_BAR; PG8_WAIT_L(0); PG8_MMA(0, 1, At, B1); PG8_BAR;
            PG8_LDA(At, 1, 1); PG8_STAGE(PG8_SA(1, 0), a3, voffA);
            PG8_BAR; PG8_WAIT_L(0); PG8_MMA(1, 0, At, B0); PG8_BAR; PG8_SCHED;
            PG8_STAGE(PG8_SB(1, 1), b3 + hstep, voffB);
            PG8_WAIT_V(6); PG8_BAR; PG8_MMA(1, 1, At, B1); PG8_BAR;
            }
        }
        if constexpr (ALIGN_EPI) { if (wr == 0) PG8_BAR; }
        if constexpr (!Epi::AFTER_DRAIN) { E(acc, cur, wr, wc, fr, fq); S.done(cur); }
        if (!has_next) break;
#pragma unroll
        for (int a = 0; a < 2; ++a)
#pragma unroll
            for (int b = 0; b < 2; ++b)
#pragma unroll
                for (int m = 0; m < 4; ++m)
#pragma unroll
                    for (int n = 0; n < 2; ++n) acc[a][b][m][n] = (f32x4){0.f, 0.f, 0.f, 0.f};
        cur = nxt; cA = nA; cB = nB; ++ui;
        if constexpr (ALIGN_EPI) { if (wr == 1) PG8_BAR; }
    }
    PG8_WAIT_V(0);
    if constexpr (!ALIGN_EPI) { if (wr == 0) PG8_BAR; }
    PG8_BAR;
    if constexpr (Epi::AFTER_DRAIN) { E.fused(acc, cur, wr, wc, fr, fq, lds, wid, lane); S.done(cur); }
#undef PG8_SA
#undef PG8_SB
#undef PG8_STAGE
#undef PG8_LDA
#undef PG8_LDB
#undef PG8_MMA
#undef PG8_WAIT_V
#undef PG8_WAIT_L
#undef PG8_BAR
#undef PG8_SCHED
}
}

#ifndef PG8_SP2
#define PG8_SP2 true
#endif
#ifndef PG8_ALIGN
#define PG8_ALIGN true
#endif
#define GAS __attribute__((address_space(1)))
#define LAS __attribute__((address_space(3)))
typedef unsigned short bf16;
typedef unsigned v4u __attribute__((ext_vector_type(4)));
typedef float f32x4 __attribute__((ext_vector_type(4)));
typedef short bf16x8 __attribute__((ext_vector_type(8)));
typedef GAS unsigned gu32;
typedef GAS unsigned long long gu64;
#define RLX_AGENT __ATOMIC_RELAXED, __HIP_MEMORY_SCOPE_AGENT
#define LDS_WAIT() asm volatile("s_waitcnt lgkmcnt(0)" ::: "memory")
#define VM_WAIT() asm volatile("s_waitcnt vmcnt(0)" ::: "memory")
__device__ __forceinline__ unsigned long long rt() { return __builtin_amdgcn_s_memrealtime(); }
__device__ __forceinline__ unsigned f2bf(float f) { unsigned u = __builtin_bit_cast(unsigned, f); return (u + 0x7fffu + ((u >> 16) & 1u)) >> 16; }
__device__ __forceinline__ unsigned pk2(float lo, float hi) { return f2bf(lo) | (f2bf(hi) << 16); }

#define XB_TMO      128
#define XB_XCNT(j)  (256  + 64 * (j))
#define XB_XSUB(j)  (1280 + 64 * (j))
#define XB_XGEN(j)  (2304 + 64 * (j))
#define XB_TOP      3328
#define XB_TOPGEN   3392
#define XCD_BAR_WORDS 3456
#define XB_SPIN_CAP (1u << 18)

__device__ __forceinline__ unsigned xb_ld(unsigned* p)              { return __hip_atomic_load(p, __ATOMIC_RELAXED, __HIP_MEMORY_SCOPE_AGENT); }
__device__ __forceinline__ unsigned xb_add(unsigned* p, unsigned v) { return __hip_atomic_fetch_add(p, v, __ATOMIC_RELAXED, __HIP_MEMORY_SCOPE_AGENT); }
__device__ __forceinline__ unsigned xb_xcc_id() { return (unsigned)__builtin_amdgcn_s_getreg((3 << 11) | 20) & 0xFu; }
#define XB_SPIN(cond, bar) do { unsigned _sp = 0; while (cond) { __builtin_amdgcn_s_sleep(1); \
    if ((++_sp & 255u) == 0u) { if (xb_ld(&(bar)[XB_TMO])) break; if (_sp > XB_SPIN_CAP) { atomicAdd(&(bar)[XB_TMO], 1u); break; } } } } while (0)

struct XcdBarrier {
    unsigned* bar; unsigned x;
    volatile LAS unsigned* st;
};

__device__ __forceinline__ XcdBarrier xcd_barrier_post(unsigned* bar, volatile LAS unsigned* st) {
    XcdBarrier b; b.bar = bar; b.x = xb_xcc_id(); b.st = st;
    if (threadIdx.x == 0) (void)xb_add(&bar[XB_XCNT(b.x)], 1u);
    return b;
}
__device__ __forceinline__ void xcd_barrier_complete(unsigned* bar, unsigned x, unsigned& nloc, unsigned& nx, unsigned& xmask) {
    const unsigned G = gridDim.x * gridDim.y * gridDim.z;
    unsigned sum, cnt, mine, msk, sp = 0u;
    for (;;) {
        sum = 0u; cnt = 0u; mine = 0u; msk = 0u;
#pragma unroll
        for (unsigned j = 0; j < 16; ++j) { const unsigned c = xb_ld(&bar[XB_XCNT(j)]); sum += c; cnt += (c > 0u) ? 1u : 0u; msk |= (c > 0u) ? (1u << j) : 0u; mine = (j == x) ? c : mine; }
        if (sum == G) break;
        __builtin_amdgcn_s_sleep(1);
        if ((++sp & 255u) == 0u) { if (xb_ld(&bar[XB_TMO])) break; if (sp > XB_SPIN_CAP) { atomicAdd(&bar[XB_TMO], 1u); break; } }
    }
    nloc = mine > 0u ? mine : 1u; nx = cnt > 0u ? cnt : 1u; xmask = msk | (1u << x);
}

__device__ __forceinline__ void xcd_barrier(const XcdBarrier& b) {
    asm volatile("s_waitcnt vmcnt(0)" ::: "memory");
    __syncthreads();
    if (threadIdx.x == 0) {
        unsigned* bar = b.bar;
        __builtin_amdgcn_s_waitcnt(0);
        unsigned nloc = b.st[0], nx = b.st[1];
        if (nloc == 0u) { unsigned xm; xcd_barrier_complete(bar, b.x, nloc, nx, xm); b.st[0] = nloc; b.st[1] = nx; b.st[2] = xm; }
        const unsigned old = xb_add(&bar[XB_XSUB(b.x)], 1u);
        const unsigned gen = old / nloc;
        __builtin_amdgcn_fence(__ATOMIC_ACQUIRE, "agent");
        if (old + 1u == (gen + 1u) * nloc) {
            __builtin_amdgcn_fence(__ATOMIC_RELEASE, "agent");
            asm volatile("s_waitcnt vmcnt(0)" ::: "memory");
            const unsigned og = xb_add(&bar[XB_TOP], 1u);
            const unsigned tg = og / nx;
            if (og + 1u == (tg + 1u) * nx) {
                const unsigned xm = b.st[2];
#pragma unroll
                for (unsigned j = 0; j < 16; ++j) if ((xm >> j) & 1u) (void)xb_add(&bar[XB_XGEN(j)], 1u);
            } else XB_SPIN(xb_ld(&bar[XB_XGEN(b.x)]) == gen, bar);
            asm volatile("s_waitcnt vmcnt(0)" ::: "memory");
        } else {
            XB_SPIN(xb_ld(&bar[XB_XGEN(b.x)]) == gen, bar);
            asm volatile("s_waitcnt vmcnt(0)" ::: "memory");
        }
    }
    __syncthreads();
}
constexpr int BATCH = 2, SEQ = 8192, DMODEL = 1024, MTOK = BATCH * SEQ, DEPTH = 2;
constexpr int IN_COLS = 2976, NIN = 3072, FFH = 2816, NGU = 2 * FFH;
constexpr float NORM_EPS = 1e-6f;
constexpr float LOG2E = 1.4426950408889634f;
constexpr float C2_DIFF = 0.125f * LOG2E;
constexpr float C2_MLA = 0.10206207261596575f * LOG2E;


template <int K> __device__ __forceinline__ float shx(float v) {
    static_assert(K == 1 || K == 2 || K == 4 || K == 8 || K == 16, "xor distance");
    if constexpr (K == 1) return __builtin_bit_cast(float, __builtin_amdgcn_mov_dpp(__builtin_bit_cast(int, v), 0xB1, 0xF, 0xF, true));
    else if constexpr (K == 2) return __builtin_bit_cast(float, __builtin_amdgcn_mov_dpp(__builtin_bit_cast(int, v), 0x4E, 0xF, 0xF, true));
    else return __builtin_bit_cast(float, __builtin_amdgcn_ds_swizzle(__builtin_bit_cast(int, v), (K << 10) | 0x1F));
}
__device__ __forceinline__ float add_x32(float v) { auto rr = __builtin_amdgcn_permlane32_swap(__float_as_uint(v), __float_as_uint(v), false, false); return __uint_as_float(rr[0]) + __uint_as_float(rr[1]); }
constexpr size_t MiB = 1u << 20;
constexpr size_t WS_CTL = 0, CTL_ZERO_BYTES = 1 * MiB;
constexpr size_t WS_WIN = 1 * MiB, WS_WUQ = 7 * MiB, WS_WUKV = WS_WUQ + 256 * 1024, WS_WOUT = WS_WUKV + 256 * 1024, WS_WGU = WS_WOUT + 2 * MiB, WS_WDN = WS_WGU + 11 * MiB;
constexpr size_t WS_XB = 26 * MiB;
constexpr size_t WS_T64 = 58 * MiB, WS_TM = 62 * MiB;
constexpr size_t WS_QN = 68 * MiB;
constexpr size_t WS_AST = 64 * MiB;
constexpr size_t WS_SSQ = 72 * MiB, WS_CQS = WS_SSQ + 256 * 1024, WS_CKVS = WS_CQS + 256 * 1024;
constexpr size_t WS_A = 73 * MiB;
constexpr size_t WS_DQ = WS_A, WS_DK = WS_DQ + 16 * MiB, WS_DV = WS_DK + 16 * MiB, WS_CQ = WS_DV + 16 * MiB, WS_CKV = WS_CQ + 8 * MiB, WS_MQ = WS_CKV + 8 * MiB, WS_MK = WS_MQ + 12 * MiB,
                 WS_MV = WS_MK + 12 * MiB, WS_RQ = WS_MV + 8 * MiB, WS_RK = WS_RQ + 8 * MiB, WS_RV = WS_RK + 8 * MiB, WS_RG = WS_RV + 8 * MiB, WS_MIX = WS_RG + 8 * MiB, WS_END = WS_MIX + 32 * MiB;
constexpr size_t WS_H = WS_A;
static_assert(WS_WDN + (size_t)1024 * FFH * 2 <= WS_XB && WS_H + (size_t)MTOK * FFH * 2 <= WS_MV && WS_END <= 256 * MiB, "d_ws map");
constexpr int CW_TMO = 0, CW_BAR = 4096, CW_Q = 8192, CW_P = 16384, CW_KM = 49152  ;
constexpr int RING_BYTES = 131072, LDSCTL_OFF = RING_BYTES, MISC_OFF = LDSCTL_OFF + 320, RS_OFF = LDSCTL_OFF + 1024  , LDS_BYTES = 147456;
constexpr int NWAVES = 8;

template <bool RELEASE = true> __device__ __forceinline__ void panel_barrier(gu32* cnt, unsigned expected, gu32* tmo);
namespace pg8 {
typedef float f32x2v __attribute__((ext_vector_type(2)));
__device__ __forceinline__ u32x4 pack8(const f32x4 a, const f32x4 b) { u32x4 w; w.x = cvt_pk_bf16(a[0], a[1]); w.y = cvt_pk_bf16(a[2], a[3]); w.z = cvt_pk_bf16(b[0], b[1]); w.w = cvt_pk_bf16(b[2], b[3]); return w; }
#ifdef WT_STORES
__device__ __forceinline__ void st16(void* p, const u32x4 v) { asm volatile("global_store_dwordx4 %0, %1, off sc1\n\ts_nop 1" :: "v"(p), "v"(v) : "memory"); }
#else
__device__ __forceinline__ void st16(void* p, const u32x4 v) { *(u32x4*)p = v; }
#endif
__device__ __forceinline__ float rstd4(const float* p, float inv_n, float eps) { const f32x4 s = *(const f32x4*)p; return 1.0f / sqrtf(((s[0] + s[1]) + (s[2] + s[3])) * inv_n + eps); }
__device__ __forceinline__ float sumsq4(const f32x4 v) { return (v[0] * v[0] + v[1] * v[1]) + (v[2] * v[2] + v[3] * v[3]); }
__device__ __forceinline__ f32x4 silu4(const f32x4 v) { f32x4 r;
#pragma unroll
    for (int i = 0; i < 4; ++i) r[i] = v[i] * __builtin_amdgcn_rcpf(1.0f + __builtin_amdgcn_exp2f(-v[i] * 1.4426950408889634f)); return r; }

__device__ __forceinline__ void rstd8(float (&rs)[2][4], const float* p, int row0, float inv_n, float eps) {
    f32x4 s[2][4];
#pragma unroll
    for (int ai = 0; ai < 2; ++ai)
#pragma unroll
        for (int m = 0; m < 4; ++m) s[ai][m] = *(const f32x4*)(p + (size_t)(row0 + ai * HALF + m * 16) * 4);
#pragma unroll
    for (int ai = 0; ai < 2; ++ai)
#pragma unroll
        for (int m = 0; m < 4; ++m) rs[ai][m] = 1.0f / sqrtf(((s[ai][m][0] + s[ai][m][1]) + (s[ai][m][2] + s[ai][m][3])) * inv_n + eps);
}
struct EpiG1 {
    static constexpr bool PERM = true, AFTER_DRAIN = false;
    unsigned char* ws;
    int layer;
    const PG8_LAS float* rs_tab;
    __device__ __forceinline__ void scales(float (&rsv)[4], const PG8_LAS float* tab, int lrow0) const {
#pragma unroll
        for (int m = 0; m < 4; ++m) rsv[m] = tab[lrow0 + m * 16];
    }
    __device__ __forceinline__ void operator()(const f32x4 (&acc)[2][2][4][2], const Unit& u, int wr, int wc, int fr, int fq) const {
        { int t_ = threadIdx.x; asm volatile("" : "+v"(t_)); fr = t_ & 15; fq = (t_ >> 4) & 3; }
        const int pn = u.pn; const PG8_LAS float* tab = rs_tab + u.ord * 256;
        if (pn < 4 || pn == 8 || pn == 9) {
            const float* t64 = (const float*)(ws + WS_T64);
            const float sc = pn < 2 ? C2_DIFF : (pn == 9 ? 0.125f : 1.0f);
            bf16_t* dbase; int ld; if (pn < 2) { dbase = (bf16_t*)(ws + WS_DQ) + 256 * pn; ld = 512; } else if (pn < 4) { dbase = (bf16_t*)(ws + WS_DK) + 256 * (pn - 2); ld = 512; } else { dbase = (bf16_t*)(ws + (pn == 8 ? WS_RQ : WS_RK)); ld = 256; }
            dbase += 64 * wc + 8 * fq;
            float kmx = 0.f;
#pragma unroll
            for (int ai = 0; ai < 2; ++ai) {
                const int row0 = u.pm * BM + ai * HALF + wr * 64 + fr; float rsv[4]; scales(rsv, tab, ai * HALF + wr * 64 + fr);
#pragma unroll
                for (int mp = 0; mp < 2; ++mp) {
                    f32x4 tc[2][4];
#pragma unroll
                    for (int k = 0; k < 2; ++k) { const float* tr = t64 + (size_t)(row0 + (2 * mp + k) * 16) * 64 + 8 * fq;
                        tc[k][0] = *(const f32x4*)tr; tc[k][1] = *(const f32x4*)(tr + 4); tc[k][2] = *(const f32x4*)(tr + 32); tc[k][3] = *(const f32x4*)(tr + 36); }
                    asm volatile("" ::: "memory");
#pragma unroll
                    for (int k = 0; k < 2; ++k) { const int m = 2 * mp + k; const float rs = rsv[m];
                        const f32x4 l0 = acc[ai][0][m][0] * rs, l1 = acc[ai][0][m][1] * rs, h0 = acc[ai][1][m][0] * rs, h1 = acc[ai][1][m][1] * rs;
                        const f32x4 c0 = tc[k][0], c1 = tc[k][1], s0 = tc[k][2], s1 = tc[k][3];
                        const f32x4 ol0 = (l0 * c0 - h0 * s0) * sc, ol1 = (l1 * c1 - h1 * s1) * sc, oh0 = (h0 * c0 + l0 * s0) * sc, oh1 = (h1 * c1 + l1 * s1) * sc;
                        bf16_t* dst = dbase + (size_t)(row0 + m * 16) * ld;
                        st16(dst, pack8(ol0, ol1)); st16(dst + 32, pack8(oh0, oh1));
                        if (pn < 4) {
                            float s = (sumsq4(ol0) + sumsq4(ol1)) + (sumsq4(oh0) + sumsq4(oh1)); s += shx<16>(s); s = add_x32(s);
                            kmx = fmaxf(kmx, s); } }
                }
            }
            if (pn < 4) { kmx = fmaxf(kmx, shx<1>(kmx)); kmx = fmaxf(kmx, shx<2>(kmx)); kmx = fmaxf(kmx, shx<4>(kmx)); kmx = fmaxf(kmx, shx<8>(kmx));
                if (fr == 0 && fq == 0) (void)__hip_atomic_fetch_max((int*)(ws + WS_CTL) + CW_KM + (pn < 2 ? 256 + layer * 1024 + u.pm * 8 + 4 * pn + wc : layer * 64 + (u.pm >> 5) * 8 + 4 * (pn - 2) + wc), __float_as_int(sqrtf(kmx)), __ATOMIC_RELAXED, __HIP_MEMORY_SCOPE_AGENT); }
        } else if (pn == 4 || pn == 5 || pn == 10 || pn == 11) {
            bf16_t* dbase; int ld; if (pn < 6) { dbase = (bf16_t*)(ws + WS_DV) + 256 * (pn - 4); ld = 512; } else { dbase = (bf16_t*)(ws + (pn == 10 ? WS_RV : WS_RG)); ld = 256; }
            dbase += 32 * wc + 8 * fq;
#pragma unroll
            for (int ai = 0; ai < 2; ++ai) {
                const int row0 = u.pm * BM + ai * HALF + wr * 64 + fr; float rsv[4]; scales(rsv, tab, ai * HALF + wr * 64 + fr);
#pragma unroll
                for (int m = 0; m < 4; ++m) { const float rs = rsv[m];
                    f32x4 l0 = acc[ai][0][m][0] * rs, l1 = acc[ai][0][m][1] * rs, h0 = acc[ai][1][m][0] * rs, h1 = acc[ai][1][m][1] * rs;
                    if (pn == 11) { l0 = silu4(l0); l1 = silu4(l1); h0 = silu4(h0); h1 = silu4(h1); }
                    bf16_t* dst = dbase + (size_t)(row0 + m * 16) * ld;
                    st16(dst, pack8(l0, l1)); st16(dst + HALF, pack8(h0, h1)); }
            }
        } else if (pn == 6) {
            bf16_t* dbase = (bf16_t*)(ws + WS_CQ) + 32 * wc + 8 * fq; float* CQS = (float*)(ws + WS_CQS);
#pragma unroll
            for (int ai = 0; ai < 2; ++ai) {
                const int row0 = u.pm * BM + ai * HALF + wr * 64 + fr; float rsv[4]; scales(rsv, tab, ai * HALF + wr * 64 + fr);
#pragma unroll
                for (int m = 0; m < 4; ++m) { const float rs = rsv[m]; const int row = row0 + m * 16;
                    const f32x4 l0 = acc[ai][0][m][0] * rs, l1 = acc[ai][0][m][1] * rs, h0 = acc[ai][1][m][0] * rs, h1 = acc[ai][1][m][1] * rs;
                    bf16_t* dst = dbase + (size_t)row * 256;
                    st16(dst, pack8(l0, l1)); st16(dst + HALF, pack8(h0, h1));
                    float s = (sumsq4(l0) + sumsq4(l1)) + (sumsq4(h0) + sumsq4(h1));
                    s += shx<16>(s); s = add_x32(s);
                    if (fq == 0) CQS[(size_t)row * 4 + wc] = s; }
            }
        } else {
            bf16_t* dbase = (bf16_t*)(ws + WS_CKV) + 32 * wc + 8 * fq; float* CKVS = (float*)(ws + WS_CKVS); const float* tm = (const float*)(ws + WS_TM); bf16_t* MK = (bf16_t*)(ws + WS_MK);
            const bool kr = (wc == 0) && (fq < 2);
#pragma unroll
            for (int ai = 0; ai < 2; ++ai) {
                const int row0 = u.pm * BM + ai * HALF + wr * 64 + fr; float rsv[4]; scales(rsv, tab, ai * HALF + wr * 64 + fr);
#pragma unroll
                for (int m = 0; m < 4; ++m) { const float rs = rsv[m]; const int row = row0 + m * 16;
                    const f32x4 l0 = acc[ai][0][m][0] * rs, l1 = acc[ai][0][m][1] * rs, h0 = acc[ai][1][m][0] * rs, h1 = acc[ai][1][m][1] * rs;
                    bf16_t* dst = dbase + (size_t)row * 256;
                    st16(dst, pack8(l0, l1)); st16(dst + HALF, pack8(h0, h1));
                    float s = kr ? 0.f : (sumsq4(l0) + sumsq4(l1)) + (sumsq4(h0) + sumsq4(h1));
                    s += shx<16>(s); s = add_x32(s);
                    if (fq == 0) CKVS[(size_t)row * 4 + wc] = s;
                    if (kr) {
                        const float* tr = tm + (size_t)row * 32 + 8 * fq;
                        const f32x4 c0 = *(const f32x4*)tr, c1 = *(const f32x4*)(tr + 4), s0 = *(const f32x4*)(tr + 16), s1 = *(const f32x4*)(tr + 20);
                        const u32x4 olo = pack8(l0 * c0 - h0 * s0, l1 * c1 - h1 * s1), ohi = pack8(h0 * c0 + l0 * s0, h1 * c1 + l1 * s1);
                        bf16_t* kd = MK + (size_t)row * 384 + 64 + 8 * fq;
#pragma unroll
                        for (int hh = 0; hh < 4; ++hh) { st16(kd + hh * 96, olo); st16(kd + hh * 96 + 16, ohi); }
                    } }
            }
        }
    }
};

struct EpiMQ {
    static constexpr bool PERM = true, AFTER_DRAIN = false;
    unsigned char* ws;
    __device__ __forceinline__ void operator()(const f32x4 (&acc)[2][2][4][2], const Unit& u, int wr, int wc, int fr, int fq) const {
        { int t_ = threadIdx.x; asm volatile("" : "+v"(t_)); fr = t_ & 15; fq = (t_ >> 4) & 3; }
        const int head = 2 * u.pn + (wc >> 1);
        const float* cqs = (const float*)(ws + WS_CQS); const float* tm = (const float*)(ws + WS_TM); bf16_t* MQ = (bf16_t*)(ws + WS_MQ);
        float rsv[2][4]; rstd8(rsv, cqs, u.pm * BM + wr * 64 + fr, 1.0f / 256.0f, NORM_EPS);
#pragma unroll
        for (int ai = 0; ai < 2; ++ai)
#pragma unroll
            for (int m = 0; m < 4; ++m) {
                const int row = u.pm * BM + ai * HALF + wr * 64 + m * 16 + fr;
                const float rs = rsv[ai][m] * C2_MLA;
                const f32x4 l0 = acc[ai][0][m][0] * rs, l1 = acc[ai][0][m][1] * rs, h0 = acc[ai][1][m][0] * rs, h1 = acc[ai][1][m][1] * rs;
                bf16_t* dst = MQ + (size_t)row * 384 + head * 96;
                if ((wc & 1) == 0) { st16(dst + 8 * fq, pack8(l0, l1)); st16(dst + 32 + 8 * fq, pack8(h0, h1)); }
                else if (fq < 2) {
                    const float* tr = tm + (size_t)row * 32 + 8 * fq;
                    const f32x4 c0 = *(const f32x4*)tr, c1 = *(const f32x4*)(tr + 4), s0 = *(const f32x4*)(tr + 16), s1 = *(const f32x4*)(tr + 20);
                    st16(dst + 64 + 8 * fq, pack8(l0 * c0 - h0 * s0, l1 * c1 - h1 * s1)); st16(dst + 80 + 8 * fq, pack8(h0 * c0 + l0 * s0, h1 * c1 + l1 * s1));
                }
            }
    }
};
struct EpiMKV {
    static constexpr bool PERM = true, AFTER_DRAIN = false;
    unsigned char* ws;
    __device__ __forceinline__ void operator()(const f32x4 (&acc)[2][2][4][2], const Unit& u, int wr, int wc, int fr, int fq) const {
        { int t_ = threadIdx.x; asm volatile("" : "+v"(t_)); fr = t_ & 15; fq = (t_ >> 4) & 3; }
        const int head = 2 * u.pn + (wc >> 1);
        const float* ckvs = (const float*)(ws + WS_CKVS); bf16_t* MK = (bf16_t*)(ws + WS_MK); bf16_t* MV = (bf16_t*)(ws + WS_MV);
        float rsv[2][4]; rstd8(rsv, ckvs, u.pm * BM + wr * 64 + fr, 1.0f / 128.0f, NORM_EPS);
#pragma unroll
        for (int ai = 0; ai < 2; ++ai)
#pragma unroll
            for (int m = 0; m < 4; ++m) {
                const int row = u.pm * BM + ai * HALF + wr * 64 + m * 16 + fr;
                const float rs = rsv[ai][m];
                const f32x4 l0 = acc[ai][0][m][0] * rs, l1 = acc[ai][0][m][1] * rs, h0 = acc[ai][1][m][0] * rs, h1 = acc[ai][1][m][1] * rs;
                bf16_t* dst = (wc & 1) ? MV + (size_t)row * 256 + head * 64 : MK + (size_t)row * 384 + head * 96;
                st16(dst + 8 * fq, pack8(l0, l1)); st16(dst + 32 + 8 * fq, pack8(h0, h1));
            }
    }
};

struct EpiGU {
    static constexpr bool PERM = true, AFTER_DRAIN = false;
    unsigned char* ws; const PG8_LAS float* rs_tab;
    __device__ __forceinline__ void operator()(const f32x4 (&acc)[2][2][4][2], const Unit& u, int wr, int wc, int fr, int fq) const {
        { int t_ = threadIdx.x; asm volatile("" : "+v"(t_)); fr = t_ & 15; fq = (t_ >> 4) & 3; }
        bf16_t* H = (bf16_t*)(ws + WS_H);
        float rsv[2][4];
#pragma unroll
        for (int ai = 0; ai < 2; ++ai)
#pragma unroll
            for (int m = 0; m < 4; ++m) rsv[ai][m] = rs_tab[u.ord * 256 + ai * HALF + wr * 64 + m * 16 + fr];
#pragma unroll
        for (int ai = 0; ai < 2; ++ai)
#pragma unroll
            for (int m = 0; m < 4; ++m) {
                if (u.half != 0 && u.half != ai + 1) continue;
                const int row = u.pm * BM + ai * HALF + wr * 64 + m * 16 + fr;
                const float rs = rsv[ai][m];
                const f32x4 g0 = acc[ai][0][m][0] * rs, g1 = acc[ai][0][m][1] * rs, u0 = acc[ai][1][m][0] * rs, u1 = acc[ai][1][m][1] * rs;
                st16(H + (size_t)row * FFH + u.pn * HALF + 32 * wc + 8 * fq, pack8(silu4(g0) * u0, silu4(g1) * u1));
            }
    }
};

struct EpiRes {
    static constexpr bool PERM = true, AFTER_DRAIN = true;
    unsigned char* ws; int dry;
    int fin; const float* fnw; float* outp;
    __device__ __forceinline__ void fused(f32x4 (&acc)[2][2][4][2], const Unit& u, int wr, int wc, int fr, int fq, PG8_LAS unsigned char* lds, int wid, int lane) const {
        { int t_ = threadIdx.x; asm volatile("" : "+v"(t_)); fr = t_ & 15; fq = (t_ >> 4) & 3; }
        PG8_LAS float* P = (PG8_LAS float*)lds;
        bf16_t* xb = (bf16_t*)(ws + WS_XB); float* ssq = (float*)(ws + WS_SSQ);
        const int col0 = u.pn * BM + wc * 32 + 8 * fq;
        u32x4 xi[2][2];
#define ER_LOAD(k) do { const size_t off_ = (size_t)(u.pm * BM + ((k) >> 2) * HALF + wr * 64 + ((k) & 3) * 16 + fr) * DMODEL + col0; \
        _Pragma("unroll") for (int q_ = 0; q_ < 2; ++q_) xi[(k) & 1][q_] = *(const u32x4*)(xb + off_ + q_ * HALF); } while (0)
        ER_LOAD(0);
#pragma unroll
        for (int k = 0; k < 8; ++k) { const int ai = k >> 2, m = k & 3, r = ai * HALF + wr * 64 + m * 16 + fr; const size_t off = (size_t)(u.pm * BM + r) * DMODEL + col0; float s = 0.f;
            if (k < 7) ER_LOAD(k + 1);
            asm volatile("" ::: "memory");
#pragma unroll
            for (int bj = 0; bj < 2; ++bj) { const u32x4 x4 = xi[k & 1][bj];
                const f32x4 xv0 = {__uint_as_float(x4.x << 16), __uint_as_float(x4.x & 0xffff0000u), __uint_as_float(x4.y << 16), __uint_as_float(x4.y & 0xffff0000u)};
                const f32x4 xv1 = {__uint_as_float(x4.z << 16), __uint_as_float(x4.z & 0xffff0000u), __uint_as_float(x4.w << 16), __uint_as_float(x4.w & 0xffff0000u)};
                const f32x4 v0 = xv0 + acc[ai][bj][m][0], v1 = xv1 + acc[ai][bj][m][1];
                if (fin) { acc[ai][bj][m][0] = v0; acc[ai][bj][m][1] = v1; }
                else { u32x4 w; w.x = cvt_pk_bf16(v0[0], v0[1]); w.y = cvt_pk_bf16(v0[2], v0[3]); w.z = cvt_pk_bf16(v1[0], v1[1]); w.w = cvt_pk_bf16(v1[2], v1[3]); if (!dry) *(u32x4*)(xb + off + bj * HALF) = w; }
                s += sumsq4(v0) + sumsq4(v1); }
            s += shx<16>(s); s = add_x32(s);
            if (fq == 0) P[r * 4 + wc] = s;
            asm volatile("" ::: "memory"); }
#undef ER_LOAD
        asm volatile("s_waitcnt lgkmcnt(0)" ::: "memory"); __builtin_amdgcn_s_barrier(); asm volatile("" ::: "memory");
        const int t = wid * 64 + lane;
        if (t < 256 && !dry) { const PG8_LAS f32x4* P4 = (const PG8_LAS f32x4*)lds; const f32x4 p = P4[t]; const float tot = (p[0] + p[1]) + (p[2] + p[3]);
            if (fin) __hip_atomic_store(ssq + (size_t)(u.pm * BM + t) * 4 + u.pn, tot, __ATOMIC_RELAXED, __HIP_MEMORY_SCOPE_AGENT);
            else ssq[(size_t)(u.pm * BM + t) * 4 + u.pn] = tot; }
        asm volatile("s_waitcnt lgkmcnt(0)" ::: "memory"); __builtin_amdgcn_s_barrier(); asm volatile("" ::: "memory");
        if (fin) {
            panel_barrier<false>((gu32*)(ws + WS_CTL) + CW_P + (2 * 64 + u.pm) * 64, 4u, (gu32*)(ws + WS_CTL) + CW_TMO);
            f32x4 ps[8];
#pragma unroll
            for (int k = 0; k < 8; ++k) { const int r = (k >> 2) * HALF + wr * 64 + (k & 3) * 16 + fr; ps[k] = *(const f32x4*)(ssq + (size_t)(u.pm * BM + r) * 4); }
            f32x4 gv[2][2];
#pragma unroll
            for (int bj = 0; bj < 2; ++bj)
#pragma unroll
                for (int n = 0; n < 2; ++n) gv[bj][n] = *(const f32x4*)(fnw + col0 + bj * HALF + n * 4);
#pragma unroll
            for (int k = 0; k < 8; ++k) { const int ai = k >> 2, m = k & 3, r = ai * HALF + wr * 64 + m * 16 + fr; const size_t off = (size_t)(u.pm * BM + r) * DMODEL + col0;
                const float rs = 1.0f / sqrtf(((ps[k][0] + ps[k][1]) + (ps[k][2] + ps[k][3])) * (1.0f / 1024.0f) + NORM_EPS);
#pragma unroll
                for (int bj = 0; bj < 2; ++bj)
#pragma unroll
                    for (int n = 0; n < 2; ++n) { const f32x4 o4 = acc[ai][bj][m][n] * rs * gv[bj][n]; if (!dry) *(f32x4*)(outp + off + bj * HALF + n * 4) = o4; } }
        }
    }
};
}
namespace at {
using bf16 = unsigned short;
using bf16x8 = __attribute__((ext_vector_type(8))) short;
using s16x4 = __attribute__((ext_vector_type(4))) short;
using f32x16 = __attribute__((ext_vector_type(16))) float;
using f32x4 = __attribute__((ext_vector_type(4))) float;
using u32x4 = __attribute__((ext_vector_type(4))) unsigned;
#define SBAR() __builtin_amdgcn_sched_barrier(0)
constexpr float THR2 = 8.f;
__device__ __forceinline__ int crow(int r, int hi) { return (r & 3) + 8 * (r >> 2) + 4 * hi; }
__device__ __forceinline__ unsigned cvtpk(float lo, float hi) { unsigned r; asm volatile("v_cvt_pk_bf16_f32 %0, %1, %2" : "=v"(r) : "v"(lo), "v"(hi)); return r; }
__device__ __forceinline__ float bf2f(short b) { return __uint_as_float(((unsigned)(unsigned short)b) << 16); }
template <int NB> __device__ __forceinline__ int v_st(int k, int c) { const int kk = (k & ~0xC) | ((k & 4) << 1) | ((k & 8) >> 1); return ((kk >> 3) * NB + (c >> 5)) * 512 + ((kk & 7) * 32 + (c & 31)) * 2; }
__device__ __forceinline__ int v_rd_base(int lane) { return ((lane & 3) << 3) | (((lane >> 2) & 3) << 6) | (((lane >> 4) & 1) << 5) | (((lane >> 5) & 1) << 8); }
template <int NB> constexpr int v_rd_off(int d0, int ks, int half) { return d0 * 512 + ks * (2 * NB * 512) + half * (NB * 512); }
template <int KRS> __device__ __forceinline__ int k_swz(int row) { return KRS == 128 ? (((row >> 1) & 7) << 4) : ((row & 7) << 4); }
template <int KRS> __device__ __forceinline__ int k_addr(int row, int chunk) { return row * KRS + ((chunk * 16) ^ k_swz<KRS>(row)); }

__device__ __forceinline__ void mask_tile(f32x16& p0, f32x16& p1, int dq) {
    const float NEG = -__builtin_inff();
#pragma unroll
    for (int r = 0; r < 16; ++r) { const int c = (r & 3) + 8 * (r >> 2); if (dq - c < 0) p0[r] = NEG; if (dq - c - 32 < 0) p1[r] = NEG; }
}
__device__ __forceinline__ void partialSM(f32x16& p0, f32x16& p1, float& m_reg, float& alpha) {
    float pmax = p0[0];
#pragma unroll
    for (int r = 1; r < 16; ++r) pmax = fmaxf(pmax, p0[r]);
#pragma unroll
    for (int r = 0; r < 16; ++r) pmax = fmaxf(pmax, p1[r]);
    { auto rr = __builtin_amdgcn_permlane32_swap(__float_as_uint(pmax), __float_as_uint(pmax), false, false); pmax = fmaxf(__uint_as_float(rr[0]), __uint_as_float(rr[1])); }
    float mn;
    if (__builtin_expect(__all(pmax - m_reg <= THR2), 1)) { mn = m_reg; alpha = 1.f; }
    else { mn = fmaxf(m_reg, pmax); alpha = __builtin_amdgcn_exp2f(m_reg - mn); m_reg = mn; }
#pragma unroll
    for (int r = 0; r < 16; ++r) { p0[r] -= mn; p1[r] -= mn; }
#pragma unroll
    for (int r = 0; r < 16; ++r) p0[r] = __builtin_amdgcn_exp2f(p0[r]);
}
#define AT_PK4(P, B_, OUT) do { unsigned a0 = cvtpk(P[B_ + 0], P[B_ + 1]), a1 = cvtpk(P[B_ + 2], P[B_ + 3]); unsigned b0 = cvtpk(P[B_ + 4], P[B_ + 5]), b1 = cvtpk(P[B_ + 6], P[B_ + 7]); \
        auto r0 = __builtin_amdgcn_permlane32_swap(a0, b0, false, false); auto r1 = __builtin_amdgcn_permlane32_swap(a1, b1, false, false); \
        u32x4 w = {r0[0], r1[0], r0[1], r1[1]}; OUT = *reinterpret_cast<bf16x8*>(&w); } while (0)
__device__ __forceinline__ void pack_p(const f32x16& p0, const f32x16& p1, bf16x8& pa0, bf16x8& pa1, bf16x8& pa2, bf16x8& pa3) { AT_PK4(p0, 0, pa0); AT_PK4(p0, 8, pa1); AT_PK4(p1, 0, pa2); AT_PK4(p1, 8, pa3); }
__device__ __forceinline__ void finishSM(f32x16& p0, f32x16& p1, float alpha, float& l_reg, bf16x8& pa0, bf16x8& pa1, bf16x8& pa2, bf16x8& pa3) {
#pragma unroll
    for (int r = 0; r < 16; ++r) p1[r] = __builtin_amdgcn_exp2f(p1[r]);
    float ps = 0;
#pragma unroll
    for (int r = 0; r < 16; ++r) ps += p0[r];
#pragma unroll
    for (int r = 0; r < 16; ++r) ps += p1[r];
    { auto rr = __builtin_amdgcn_permlane32_swap(__float_as_uint(ps), __float_as_uint(ps), false, false); ps = __uint_as_float(rr[0]) + __uint_as_float(rr[1]); }
    l_reg = l_reg * alpha + ps;
    pack_p(p0, p1, pa0, pa1, pa2, pa3);
}
template <int DQK, int KRS> __device__ __forceinline__ void qkt(f32x16& p0, f32x16& p1, const char* Kimg, int r32, int hi, const bf16x8* qr) {
    p0 = f32x16{}; p1 = f32x16{};
    const char* kb[4];
#pragma unroll
    for (int dd = 0; dd < 4; ++dd) kb[dd] = Kimg + k_addr<KRS>(r32, 2 * dd + hi);
#pragma unroll
    for (int d0 = 0; d0 < DQK / 16; ++d0) { const char* a = kb[d0 & 3] + (d0 >> 2) * 128;
        const bf16x8 b0 = *reinterpret_cast<const bf16x8*>(a), b1 = *reinterpret_cast<const bf16x8*>(a + 32 * KRS);
        p0 = __builtin_amdgcn_mfma_f32_32x32x16_bf16(b0, qr[d0], p0, 0, 0, 0);
        p1 = __builtin_amdgcn_mfma_f32_32x32x16_bf16(b1, qr[d0], p1, 0, 0, 0); }
}
struct VFr { s16x4 l0, l1, l2, l3, h0, h1, h2, h3; };
#define AT_TRRD(dst, off) asm volatile("ds_read_b64_tr_b16 %0, %1 offset:%2" : "=&v"(dst) : "v"(vb), "i"(off) : "memory")
template <int NB, int D0> __device__ __forceinline__ void v_reads(VFr& f, int vb) {
    AT_TRRD(f.l0, (v_rd_off<NB>(D0, 0, 0))); AT_TRRD(f.h0, (v_rd_off<NB>(D0, 0, 1))); AT_TRRD(f.l1, (v_rd_off<NB>(D0, 1, 0))); AT_TRRD(f.h1, (v_rd_off<NB>(D0, 1, 1)));
    AT_TRRD(f.l2, (v_rd_off<NB>(D0, 2, 0))); AT_TRRD(f.h2, (v_rd_off<NB>(D0, 2, 1))); AT_TRRD(f.l3, (v_rd_off<NB>(D0, 3, 0))); AT_TRRD(f.h3, (v_rd_off<NB>(D0, 3, 1)));
}
#undef AT_TRRD
#define AT_PK(L, H) (bf16x8){L[0], L[1], L[2], L[3], H[0], H[1], H[2], H[3]}
__device__ __forceinline__ void pv_mma(f32x16& od, const VFr& f, bf16x8 pa0, bf16x8 pa1, bf16x8 pa2, bf16x8 pa3) {
    od = __builtin_amdgcn_mfma_f32_32x32x16_bf16(pa0, AT_PK(f.l0, f.h0), od, 0, 0, 0);
    od = __builtin_amdgcn_mfma_f32_32x32x16_bf16(pa1, AT_PK(f.l1, f.h1), od, 0, 0, 0);
    od = __builtin_amdgcn_mfma_f32_32x32x16_bf16(pa2, AT_PK(f.l2, f.h2), od, 0, 0, 0);
    od = __builtin_amdgcn_mfma_f32_32x32x16_bf16(pa3, AT_PK(f.l3, f.h3), od, 0, 0, 0);
}
#undef AT_PK
#define AT_LW(n) asm volatile("s_waitcnt lgkmcnt(" #n ")" ::: "memory")
template <int NB> __device__ __forceinline__ void pv_all(f32x16* o, int vb, bf16x8 pa0, bf16x8 pa1, bf16x8 pa2, bf16x8 pa3) {
    VFr fa, fb;
    v_reads<NB, 0>(fa, vb); v_reads<NB, 1>(fb, vb);
    AT_LW(8); SBAR(); pv_mma(o[0], fa, pa0, pa1, pa2, pa3); SBAR();
    if constexpr (NB == 4) {
        v_reads<NB, 2>(fa, vb); AT_LW(8); SBAR(); pv_mma(o[1], fb, pa0, pa1, pa2, pa3); SBAR();
        v_reads<NB, 3>(fb, vb); AT_LW(8); SBAR(); pv_mma(o[2], fa, pa0, pa1, pa2, pa3); SBAR();
        AT_LW(0); SBAR(); pv_mma(o[3], fb, pa0, pa1, pa2, pa3);
    } else { AT_LW(0); SBAR(); pv_mma(o[1], fb, pa0, pa1, pa2, pa3); }
}
#undef AT_LW

template <int DQK, int DV, int LDQ, int LDK, int LDV, int LDO>
__device__ __forceinline__ void attn_unit(const bf16* __restrict__ Qb, const bf16* __restrict__ Kh, const bf16* __restrict__ Vh, bf16* __restrict__ Ob, int qb, char* lds, int kvmul = 1) {
    constexpr int KRS = DQK == 64 ? 128 : 256, KB = 64 * KRS, NB = DV / 32, VB = 64 * DV * 2, KCH = DQK / 8, NKP = (64 * KCH + 511) / 512, VCH = DV / 8, NVP = 64 * VCH / 512;
    static_assert(NKP <= 2 && (NVP == 1 || NVP == 2), "staging piece counts");
    int tid_ = threadIdx.x; asm volatile("" : "+v"(tid_));
    const int tid = tid_, wid = __builtin_amdgcn_readfirstlane(tid >> 6), lane = tid & 63, r32 = lane & 31, hi = lane >> 5;
    char* V_lds = lds; char* K_lds = lds + 2 * VB;
    float* ws = (float*)(lds + 2 * VB + 2 * KB) + wid * 64; float* li_l = ws; float* al_l = ws + 32;
    float m_reg = -1e30f, l_reg = 0; f32x16 o[NB];
#pragma unroll
    for (int d = 0; d < NB; ++d) o[d] = f32x16{};
    bf16x8 qr[DQK / 16];
    const bf16* Qw = Qb + (size_t)(wid * 32 + r32) * LDQ + hi * 8;
#pragma unroll
    for (int d0 = 0; d0 < DQK / 16; ++d0) qr[d0] = *reinterpret_cast<const bf16x8*>(Qw + d0 * 16);
    const int kr0 = tid / KCH, kc0 = tid % KCH, kr1 = (tid + 512) / KCH, kc1 = (tid + 512) % KCH; const bool k2 = (NKP == 2) && (tid + 512 < 64 * KCH);
    const int kw0 = k_addr<KRS>(kr0, kc0), kw1 = k_addr<KRS>(kr1 & 63, kc1);
    const int vr = tid / VCH, vc = (tid % VCH) * 8, vst0 = v_st<NB>(vr, vc), vst1 = v_st<NB>((32 + vr) & 63, vc);
    const int vb0 = (int)(uintptr_t)V_lds + v_rd_base(lane);
    bf16x8 sk0, sk1, sv0, sv1;
#define AT_SLOAD(k0_) do { const int k0 = (k0_) * kvmul; sv0 = *reinterpret_cast<const bf16x8*>(Vh + (size_t)((k0) + vr) * LDV + vc); if (NVP == 2) sv1 = *reinterpret_cast<const bf16x8*>(Vh + (size_t)((k0) + 32 + vr) * LDV + vc); \
        sk0 = *reinterpret_cast<const bf16x8*>(Kh + (size_t)((k0) + kr0) * LDK + kc0 * 8); if (k2) sk1 = *reinterpret_cast<const bf16x8*>(Kh + (size_t)((k0) + kr1) * LDK + kc1 * 8); } while (0)
#define AT_SWRITE(b) do { *(bf16x8*)(V_lds + (b) * VB + vst0) = sv0; if (NVP == 2) *(bf16x8*)(V_lds + (b) * VB + vst1) = sv1; \
        *(bf16x8*)(K_lds + (b) * KB + kw0) = sk0; if (k2) *(bf16x8*)(K_lds + (b) * KB + kw1) = sk1; } while (0)
#define AT_VMW() asm volatile("s_waitcnt vmcnt(0)" ::: "memory")
#define AT_RESC(a) do { if (__any((a) < 1.f)) { if (hi == 0) al_l[r32] = (a); asm volatile("s_waitcnt lgkmcnt(0)" ::: "memory"); \
        _Pragma("unroll") for (int d_ = 0; d_ < NB; ++d_) _Pragma("unroll") for (int r = 0; r < 16; ++r) o[d_][r] *= al_l[crow(r, hi)]; } } while (0)
    const int NT = 4 * (qb + 1);
    const int qlo = 256 * qb + wid * 32, qm = qlo + r32 - 4 * hi;
#define AT_MASK(P0_, P1_, t) do { const int kb_ = (t) * 64; if (kb_ + 63 > qlo) mask_tile(P0_, P1_, qm - kb_); } while (0)
    f32x16 pA0, pA1, pB0, pB1; float alA, alB; bf16x8 pa0, pa1, pa2, pa3;
    AT_SLOAD(0); AT_VMW(); AT_SWRITE(0); __syncthreads();
    qkt<DQK, KRS>(pA0, pA1, K_lds, r32, hi, qr); AT_MASK(pA0, pA1, 0); partialSM(pA0, pA1, m_reg, alA);
    AT_SLOAD(64); AT_VMW(); AT_SWRITE(1); __syncthreads();
    for (int j = 1; j + 1 < NT; j += 2) {
        SBAR(); qkt<DQK, KRS>(pB0, pB1, K_lds + KB, r32, hi, qr);
        finishSM(pA0, pA1, alA, l_reg, pa0, pa1, pa2, pa3); SBAR();
        AT_SLOAD((j + 1) * 64); SBAR();
        pv_all<NB>(o, vb0, pa0, pa1, pa2, pa3); AT_MASK(pB0, pB1, j); partialSM(pB0, pB1, m_reg, alB);
        __syncthreads(); AT_VMW(); AT_SWRITE(0);
        AT_RESC(alB); __syncthreads();
        SBAR(); qkt<DQK, KRS>(pA0, pA1, K_lds, r32, hi, qr);
        finishSM(pB0, pB1, alB, l_reg, pa0, pa1, pa2, pa3); SBAR();
        AT_SLOAD((j + 2) * 64); SBAR();
        pv_all<NB>(o, vb0 + VB, pa0, pa1, pa2, pa3); AT_MASK(pA0, pA1, j + 1); partialSM(pA0, pA1, m_reg, alA);
        __syncthreads(); AT_VMW(); AT_SWRITE(1);
        AT_RESC(alA); __syncthreads();
    }
    SBAR(); qkt<DQK, KRS>(pB0, pB1, K_lds + KB, r32, hi, qr);
    finishSM(pA0, pA1, alA, l_reg, pa0, pa1, pa2, pa3); SBAR();
    pv_all<NB>(o, vb0, pa0, pa1, pa2, pa3); AT_MASK(pB0, pB1, NT - 1); partialSM(pB0, pB1, m_reg, alB);
    AT_RESC(alB);
    finishSM(pB0, pB1, alB, l_reg, pa0, pa1, pa2, pa3); SBAR();
    pv_all<NB>(o, vb0 + VB, pa0, pa1, pa2, pa3);
    if (hi == 0) li_l[r32] = l_reg; asm volatile("s_waitcnt lgkmcnt(0)" ::: "memory");
    float rli[16];
#pragma unroll
    for (int r = 0; r < 16; ++r) rli[r] = __builtin_amdgcn_rcpf(li_l[crow(r, hi)]);
    bf16* Ow = Ob + (size_t)(wid * 32) * LDO;
#pragma unroll
    for (int r = 0; r < 16; ++r) { const int orow = crow(r, hi);
#pragma unroll
        for (int d0 = 0; d0 < NB; ++d0) { const float v = o[d0][r] * rli[r]; const float vn = shx<1>(v);
            if ((r32 & 1) == 0 && kvmul) *(unsigned*)(Ow + (size_t)orow * LDO + d0 * 32 + r32) = cvtpk(v, vn); } }
    __syncthreads();
#undef AT_SLOAD
#undef AT_SWRITE
#undef AT_VMW
#undef AT_RESC
#undef AT_MASK
}
}
namespace at2 {
using namespace at;
typedef __attribute__((address_space(3))) const char* lds_cptr;
typedef short v4i16_t __attribute__((ext_vector_type(4)));
__device__ __forceinline__ void glds16(const void* gsrc, unsigned lds_dst) { unsigned keep;
    asm volatile("s_mov_b32 %0, m0\n\ts_mov_b32 m0, %2\n\ts_nop 0\n\tglobal_load_lds_dwordx4 %1, off\n\ts_mov_b32 m0, %0" : "=&s"(keep) : "v"(gsrc), "s"(lds_dst) : "memory"); }
__device__ __forceinline__ s16x4 vtr(lds_cptr p) { return __builtin_bit_cast(s16x4, __builtin_amdgcn_ds_read_tr16_b64_v4i16((__attribute__((address_space(3))) v4i16_t*)p)); }
__device__ __forceinline__ bf16x8 kld(lds_cptr p) { return *(const __attribute__((address_space(3))) bf16x8*)p; }
typedef float f32x2_t __attribute__((ext_vector_type(2))); typedef __bf16 bf16x2_t __attribute__((ext_vector_type(2)));
__device__ __forceinline__ unsigned cvtpk_s(float lo, float hi) { f32x2_t v = {lo, hi}; bf16x2_t b = __builtin_convertvector(v, bf16x2_t); return __builtin_bit_cast(unsigned, b); }
constexpr float THRL = 8.f;

template <int DQK, int DV, int LDQ, int LDK, int LDV, int LDO>
__device__ __forceinline__ void attn_unit(const bf16* __restrict__ Qb, const bf16* __restrict__ Kh, const bf16* __restrict__ Vh, bf16* __restrict__ Ob, int qb, char* shm, int kvmul = 1) {
    constexpr int NKS = DQK / 16, NB = DV / 32, KSL = 64 * DQK * 2, VSL = 64 * DV * 2, NKC = DQK / 8, NVP = DV / 8, LDS_K = 0, LDS_V = 3 * KSL, LDS_WS = 3 * KSL + 3 * VSL;
    static_assert(NKC <= 16 && (NVP == 8 || NVP == 16), "piece counts");
    int tid_ = threadIdx.x; asm volatile("" : "+v"(tid_));
    const int tid = tid_, lane = tid & 63, r32 = lane & 31, hi = lane >> 5, wid = __builtin_amdgcn_readfirstlane(tid >> 6);
    const unsigned lds0 = (unsigned)(uintptr_t)shm;
    float* wsf = (float*)(shm + LDS_WS) + wid * 64;
    const bool k2 = (NKC > 8) && (wid < NKC - 8);
    const bf16* ksrc = Kh + (size_t)lane * LDK + wid * 8;
    const bf16* vsrc = Vh + (size_t)(16 * (wid & 3) + (lane >> 2)) * LDV + (wid >> 2) * 32 + (lane & 3) * 8;
#define A2_DMA_K(t, s) do { glds16(ksrc + (size_t)(t) * 64 * LDK, (unsigned)__builtin_amdgcn_readfirstlane(lds0 + LDS_K + (s) * KSL + wid * 1024)); \
        if (k2) glds16(ksrc + (size_t)(t) * 64 * LDK + 64, (unsigned)__builtin_amdgcn_readfirstlane(lds0 + LDS_K + (s) * KSL + (wid + 8) * 1024)); } while (0)
#define A2_DMA_V(t, s) do { glds16(vsrc + (size_t)(t) * 64 * LDV, (unsigned)__builtin_amdgcn_readfirstlane(lds0 + LDS_V + (s) * VSL + wid * 1024)); \
        if (NVP == 16) glds16(vsrc + (size_t)(t) * 64 * LDV + 64, (unsigned)__builtin_amdgcn_readfirstlane(lds0 + LDS_V + (s) * VSL + (wid + 8) * 1024)); } while (0)
#define A2_WAIT_BAR_K() do { if ((k2 ? 2 : 1) + (NVP == 16 ? 2 : 1) == 3) asm volatile("s_waitcnt vmcnt(3) lgkmcnt(0)\n\ts_barrier" ::: "memory"); else asm volatile("s_waitcnt vmcnt(2) lgkmcnt(0)\n\ts_barrier" ::: "memory"); } while (0)
#define A2_WAIT_BAR_0() asm volatile("s_waitcnt vmcnt(0) lgkmcnt(0)\n\ts_barrier" ::: "memory")
    const lds_cptr shm3 = (lds_cptr)shm;
    const lds_cptr kp0 = shm3 + LDS_K + hi * 1024 + r32 * 16;
    const lds_cptr vp0 = shm3 + LDS_V + ((lane >> 4) & 1) * 32 + (lane & 3) * 8 + (4 * hi + ((lane & 15) >> 2)) * 64;
    const int NT = 4 * (qb + 1);
    A2_DMA_K(0, 0); A2_DMA_V(0, 0); A2_DMA_K(1, 1); A2_DMA_V(1, 1);
    bf16x8 qr[NKS];
    { const bf16* Qw = Qb + (size_t)(wid * 32 + r32) * LDQ + hi * 8;
#pragma unroll
      for (int d0 = 0; d0 < NKS; ++d0) qr[d0] = *reinterpret_cast<const bf16x8*>(Qw + d0 * 16); }
    float mhat = 0.f, l_reg = 0.f; f32x16 o[NB];
#pragma unroll
    for (int d = 0; d < NB; ++d) o[d] = f32x16{};
    f32x16 negm = f32x16{};
    const int qlo = 256 * qb + wid * 32, qm = qlo + r32 - 4 * hi;
    A2_WAIT_BAR_0();
    int sl = 0;
#pragma unroll 1
    for (int t = 0; t < NT; ++t) {
        const int sl2 = sl == 0 ? 2 : sl - 1;
        if (t + 2 < NT) { A2_DMA_K(t + 2, sl2); A2_DMA_V(t + 2, sl2); }
        f32x16 c0, c1;
        { const lds_cptr kp = kp0 + sl * KSL;
#pragma unroll
          for (int d0 = 0; d0 < NKS; ++d0) { const bf16x8 b0 = kld(kp + d0 * 2048), b1 = kld(kp + d0 * 2048 + 512);
              c0 = __builtin_amdgcn_mfma_f32_32x32x16_bf16(b0, qr[d0], d0 == 0 ? negm : c0, 0, 0, 0);
              c1 = __builtin_amdgcn_mfma_f32_32x32x16_bf16(b1, qr[d0], d0 == 0 ? negm : c1, 0, 0, 0); } }
        if (t * 64 + 63 > qlo) mask_tile(c0, c1, qm - t * 64);
        float rm = c0[0];
#pragma unroll
        for (int r = 1; r < 16; ++r) rm = fmaxf(rm, c0[r]);
#pragma unroll
        for (int r = 0; r < 16; ++r) rm = fmaxf(rm, c1[r]);
        { auto rr = __builtin_amdgcn_permlane32_swap(__float_as_uint(rm), __float_as_uint(rm), false, false); rm = fmaxf(__uint_as_float(rr[0]), __uint_as_float(rr[1])); }
        if (t == 0 || __builtin_expect(__any(rm > THRL), 0)) {
            const float dl = t == 0 ? rm : fmaxf(rm, 0.f); mhat += dl;
#pragma unroll
            for (int r = 0; r < 16; ++r) { c0[r] -= dl; c1[r] -= dl; }
#pragma unroll
            for (int r = 0; r < 16; ++r) negm[r] = -mhat;
            if (t != 0) { const float f = __builtin_amdgcn_exp2f(-dl); l_reg *= f; if (hi == 0) wsf[r32] = f; asm volatile("s_waitcnt lgkmcnt(0)" ::: "memory");
#pragma unroll
                for (int d_ = 0; d_ < NB; ++d_)
#pragma unroll
                    for (int r = 0; r < 16; ++r) o[d_][r] *= wsf[crow(r, hi)]; }
        }
        float sacc = 0.f;
#pragma unroll
        for (int r = 0; r < 16; ++r) { c0[r] = __builtin_amdgcn_exp2f(c0[r]); sacc += c0[r]; }
#pragma unroll
        for (int r = 0; r < 16; ++r) { c1[r] = __builtin_amdgcn_exp2f(c1[r]); sacc += c1[r]; }
        l_reg += sacc;
        u32x4 pw[4];
#pragma unroll
        for (int k = 0; k < 2; ++k) { pw[k] = (u32x4){cvtpk_s(c0[8 * k], c0[8 * k + 1]), cvtpk_s(c0[8 * k + 2], c0[8 * k + 3]), cvtpk_s(c0[8 * k + 4], c0[8 * k + 5]), cvtpk_s(c0[8 * k + 6], c0[8 * k + 7])};
                                      pw[2 + k] = (u32x4){cvtpk_s(c1[8 * k], c1[8 * k + 1]), cvtpk_s(c1[8 * k + 2], c1[8 * k + 3]), cvtpk_s(c1[8 * k + 4], c1[8 * k + 5]), cvtpk_s(c1[8 * k + 6], c1[8 * k + 7])}; }
        { const lds_cptr vp = vp0 + sl * VSL;
#pragma unroll
          for (int d0 = 0; d0 < NB; ++d0)
#pragma unroll
              for (int ks = 0; ks < 4; ++ks) { const s16x4 lo = vtr(vp + d0 * 4096 + ks * 1024), hh = vtr(vp + d0 * 4096 + ks * 1024 + 512);
                  o[d0] = __builtin_amdgcn_mfma_f32_32x32x16_bf16(__builtin_bit_cast(bf16x8, pw[ks]), (bf16x8){lo[0], lo[1], lo[2], lo[3], hh[0], hh[1], hh[2], hh[3]}, o[d0], 0, 0, 0); } }
        if (t + 2 < NT) A2_WAIT_BAR_K(); else A2_WAIT_BAR_0();
        sl = sl == 2 ? 0 : sl + 1;
    }
    { auto rr = __builtin_amdgcn_permlane32_swap(__float_as_uint(l_reg), __float_as_uint(l_reg), false, false); l_reg = __uint_as_float(rr[0]) + __uint_as_float(rr[1]); }
    if (hi == 0) wsf[32 + r32] = l_reg; asm volatile("s_waitcnt lgkmcnt(0)" ::: "memory");
    float rli[16];
#pragma unroll
    for (int r = 0; r < 16; ++r) rli[r] = __builtin_amdgcn_rcpf(wsf[32 + crow(r, hi)]);
    bf16* Ow = Ob + (size_t)(wid * 32) * LDO;
#pragma unroll
    for (int r = 0; r < 16; ++r) { const int orow = crow(r, hi);
#pragma unroll
        for (int d0 = 0; d0 < NB; ++d0) { const float v = o[d0][r] * rli[r]; const float vn = shx<1>(v);
            if ((r32 & 1) == 0) *(unsigned*)(Ow + (size_t)orow * LDO + d0 * 32 + r32) = cvtpk(v, vn); } }
    asm volatile("s_waitcnt vmcnt(0) lgkmcnt(0)\n\ts_barrier" ::: "memory");
#undef A2_DMA_K
#undef A2_DMA_V
#undef A2_WAIT_BAR_K
#undef A2_WAIT_BAR_0
}
}
namespace at3 {
using namespace at2;
__device__ __forceinline__ void glds16s(const void* sbase, unsigned voff, unsigned lds_dst) { unsigned keep;
    asm volatile("s_mov_b32 %0, m0\n\ts_mov_b32 m0, %3\n\ts_nop 0\n\tglobal_load_lds_dwordx4 %1, %2\n\ts_mov_b32 m0, %0" : "=&s"(keep) : "v"(voff), "s"(sbase), "s"(lds_dst) : "memory"); }
#ifdef A3_HALFPRIO
#define A3_PRIO(p) do { if (wid >= 4) __builtin_amdgcn_s_setprio((p) + 1); else __builtin_amdgcn_s_setprio(p); } while (0)
#else
#define A3_PRIO(p) __builtin_amdgcn_s_setprio(p)
#endif
#ifndef A3_TWOLV
#define A3_TWOLV 1
#endif
#define A3_PIN(x) asm volatile("" : "+v"(x))
#define A3_PEL(P0, P1, e) ((e) < 16 ? P0[(e) & 15] : P1[(e) & 15])
template <int DQK, int DV, int LDQ, int LDK, int LDV, int LDO, int FIXM = 0>
__device__ __forceinline__ unsigned attn_unit(const bf16* __restrict__ Qb, const bf16* __restrict__ Kh, const bf16* __restrict__ Vh, bf16* __restrict__ Ob, int qb, char* shm, gu32* qp, volatile LAS unsigned* misc, const float* qn = nullptr, float kmax = 0.f, int kvmul = 1) {
    constexpr int NKS = DQK / 16, NQK = DQK / 8, NB = DV / 32, NPV = 4 * NB, KSL = 64 * DQK * 2, VSL = 64 * DV * 2, NKC = DQK / 8, NVP = DV / 8, LDS_K = 0, LDS_V = 3 * KSL, LDS_WS = 3 * KSL + 3 * VSL;
    static_assert(NKC <= 16 && (NVP == 8 || NVP == 16) && 32 % NQK != 1 && 32 % NPV == 0, "shape");
    int tid_ = threadIdx.x; asm volatile("" : "+v"(tid_));
    const int tid = tid_, lane = tid & 63, r32 = lane & 31, hi = lane >> 5, wid = __builtin_amdgcn_readfirstlane(tid >> 6);
    const int rb = wid < 4 ? wid : 11 - wid;
    const unsigned lds0 = (unsigned)(uintptr_t)shm;
    float* wsf = (float*)(shm + LDS_WS) + wid * 64;
    const bool k2 = (NKC > 8) && (wid < NKC - 8);
    const unsigned kvo = (unsigned)(lane * LDK) * 2u, vvo = (unsigned)((lane >> 2) * LDV + (lane & 3) * 8) * 2u;
    const char* kbs = (const char*)(Kh + wid * 8); const char* vbs = (const char*)(Vh + (size_t)(16 * (wid & 3)) * LDV + (wid >> 2) * 32);
#define A3_DMA_K(t, s) do { const char* b_ = kbs + (size_t)((t) * kvmul) * (64 * LDK * 2); glds16s(b_, kvo, (unsigned)__builtin_amdgcn_readfirstlane(lds0 + LDS_K + (s) * KSL + wid * 1024)); \
        if (k2) glds16s(b_ + 128, kvo, (unsigned)__builtin_amdgcn_readfirstlane(lds0 + LDS_K + (s) * KSL + (wid + 8) * 1024)); } while (0)
#define A3_DMA_V(t, s) do { const char* b_ = vbs + (size_t)((t) * kvmul) * (64 * LDV * 2); glds16s(b_, vvo, (unsigned)__builtin_amdgcn_readfirstlane(lds0 + LDS_V + (s) * VSL + wid * 1024)); \
        if (NVP == 16) glds16s(b_ + 128, vvo, (unsigned)__builtin_amdgcn_readfirstlane(lds0 + LDS_V + (s) * VSL + (wid + 8) * 1024)); } while (0)
#define A3_WB(n) asm volatile("s_waitcnt vmcnt(" #n ") lgkmcnt(0)\n\ts_barrier" ::: "memory")
#define A3_WAIT_BAR(gk, gv) do { const int n_ = ((gk) ? (k2 ? 2 : 1) : 0) + ((gv) ? NVP / 8 : 0); \
        if (n_ == 0) A3_WB(0); else if (n_ == 1) A3_WB(1); else if (n_ == 2) A3_WB(2); else if (n_ == 3) A3_WB(3); else A3_WB(4); } while (0)
    const lds_cptr shm3 = (lds_cptr)shm;
    const lds_cptr kp0 = shm3 + LDS_K + hi * 1024 + r32 * 16;
    const lds_cptr vp0 = shm3 + LDS_V + ((lane >> 4) & 1) * 32 + (lane & 3) * 8 + (4 * hi + ((lane & 15) >> 2)) * 64;
    const int NT = 4 * (qb + 1);
    A3_DMA_K(0, 0); A3_DMA_V(0, 0); A3_DMA_K(1, 1);
    bf16x8 qr[NKS];
    { const bf16* Qw = Qb + (size_t)(rb * 32 + r32) * LDQ + hi * 8;
#pragma unroll
      for (int d0 = 0; d0 < NKS; ++d0) qr[d0] = *reinterpret_cast<const bf16x8*>(Qw + d0 * 16); }
    float mhat = 0.f, l_reg = 0.f; f32x16 o[NB];
#pragma unroll
    for (int d = 0; d < NB; ++d) o[d] = f32x16{};
    constexpr bool FIXC = FIXM == 1;
    f32x16 negm = f32x16{}; if (!FIXC) asm volatile("" : "+v"(negm));
    const int qlo = 256 * qb + rb * 32, qm = qlo + r32 - 4 * hi, lastw = 4 * qb + (rb >> 1);
    bool fix = FIXC;
    if (!FIXC && qn != nullptr) { const float bnd = qn[(size_t)(rb * 32 + r32) * 8] * kmax * 1.01f; fix = !__any(!(bnd < 100.f)); }
    u32x4 pw[4]; asm volatile("" : "=v"(pw[0]), "=v"(pw[1]), "=v"(pw[2]), "=v"(pw[3])); bool resc = false;
    int slk = 0, slv = 0;
#define A3_KFRAG(kp_, i) kld((kp_) + ((i) >> 1) * 2048 + ((i) & 1) * 512)
#define A3_VFRAG(vp_, j) ((vp_) + ((j) % NB) * 4096 + ((j) / NB) * 1024)
#define A3_MASK(C0_, C1_, t) do { if ((t) * 64 + 63 > qlo) mask_tile(C0_, C1_, qm - (t) * 64); } while (0)
#define A3_ROWMAX(C0_, C1_, rm_) do { float a_ = fmaxf(fmaxf(C0_[0], C0_[1]), C1_[0]), b_ = fmaxf(fmaxf(C0_[2], C0_[3]), C1_[1]); a_ = fmaxf(fmaxf(a_, C1_[2]), C1_[3]); \
        _Pragma("unroll") for (int r = 4; r < 16; r += 4) { a_ = fmaxf(fmaxf(a_, C0_[r]), C0_[r + 1]); b_ = fmaxf(fmaxf(b_, C0_[r + 2]), C0_[r + 3]); a_ = fmaxf(fmaxf(a_, C1_[r]), C1_[r + 1]); b_ = fmaxf(fmaxf(b_, C1_[r + 2]), C1_[r + 3]); } \
        rm_ = fmaxf(a_, b_); { auto rr_ = __builtin_amdgcn_permlane32_swap(__float_as_uint(rm_), __float_as_uint(rm_), false, false); rm_ = fmaxf(__uint_as_float(rr_[0]), __uint_as_float(rr_[1])); } } while (0)
#define A3_STEP(C0, C1, P0, P1, t, BAND) do { \
        const bool gk_ = !(BAND) || ((t) + 2 < NT), gv_ = !(BAND) || ((t) + 1 < NT); \
        const lds_cptr kp_ = kp0 + slk * KSL; const lds_cptr vp_ = vp0 + slv * VSL; \
        bf16x8 kf_[3]; s16x4 vl_[3], vh_[3]; float sacc_ = 0.f; \
        kf_[0] = A3_KFRAG(kp_, 0); kf_[1] = A3_KFRAG(kp_, 1); SBAR(); A3_PRIO(1); \
        _Pragma("unroll") for (int i = 0; i < NQK; ++i) { \
            if (i + 2 < NQK) kf_[(i + 2) % 3] = A3_KFRAG(kp_, i + 2); \
            if (i == NQK - 2) { vl_[0] = vtr(A3_VFRAG(vp_, 0)); vh_[0] = vtr(A3_VFRAG(vp_, 0) + 512); } \
            if (i == NQK - 1) { vl_[1] = vtr(A3_VFRAG(vp_, 1)); vh_[1] = vtr(A3_VFRAG(vp_, 1) + 512); } \
            SBAR(); \
            if ((i & 1) == 0) C0 = __builtin_amdgcn_mfma_f32_32x32x16_bf16(kf_[i % 3], qr[i >> 1], i < 2 ? negm : C0, 0, 0, 0); \
            else C1 = __builtin_amdgcn_mfma_f32_32x32x16_bf16(kf_[i % 3], qr[i >> 1], i < 2 ? negm : C1, 0, 0, 0); \
            _Pragma("unroll") for (int e = (i * 32) / NQK; e < ((i + 1) * 32) / NQK; ++e) sacc_ += A3_PEL(P0, P1, e); \
            A3_PIN(sacc_); \
            _Pragma("unroll") for (int c = (i * 16) / NQK; c < ((i + 1) * 16) / NQK; ++c) { const int e = 2 * c; pw[c >> 2][c & 3] = cvtpk_s(A3_PEL(P0, P1, e), A3_PEL(P0, P1, e + 1)); } \
            A3_PIN(pw[((i * 16) / NQK) >> 2]); \
            SBAR(); } \
        A3_PRIO(0); l_reg += sacc_; \
        if (gk_) A3_DMA_K((t) + 2, slk == 0 ? 2 : slk - 1); if (gv_) A3_DMA_V((t) + 1, slv == 0 ? 2 : slv - 1); \
        if (BAND) A3_MASK(C0, C1, t); \
        if (!FIXC && !fix) { float rm_; A3_ROWMAX(C0, C1, rm_); resc = false; \
          if (__builtin_expect(__any(rm_ > THRL), 0)) { const float dl = fmaxf(rm_, 0.f); mhat += dl; \
              _Pragma("unroll") for (int r = 0; r < 16; ++r) { C0[r] -= dl; C1[r] -= dl; } \
              _Pragma("unroll") for (int r = 0; r < 16; ++r) negm[r] = -mhat; asm volatile("" : "+v"(negm)); \
              const float f = __builtin_amdgcn_exp2f(-dl); l_reg *= f; if (hi == 0) wsf[r32] = f; resc = true; } } \
        SBAR(); A3_PRIO(1); \
        _Pragma("unroll") for (int j = 0; j < NPV; ++j) { \
            if (j + 2 < NPV) { vl_[(j + 2) % 3] = vtr(A3_VFRAG(vp_, j + 2)); vh_[(j + 2) % 3] = vtr(A3_VFRAG(vp_, j + 2) + 512); } \
            SBAR(); \
            o[j % NB] = __builtin_amdgcn_mfma_f32_32x32x16_bf16(__builtin_bit_cast(bf16x8, pw[j / NB]), \
                (bf16x8){vl_[j % 3][0], vl_[j % 3][1], vl_[j % 3][2], vl_[j % 3][3], vh_[j % 3][0], vh_[j % 3][1], vh_[j % 3][2], vh_[j % 3][3]}, o[j % NB], 0, 0, 0); \
            _Pragma("unroll") for (int e = (j * 32) / NPV; e < ((j + 1) * 32) / NPV; ++e) { if (e < 16) C0[e & 15] = __builtin_amdgcn_exp2f(C0[e & 15]); else C1[e & 15] = __builtin_amdgcn_exp2f(C1[e & 15]); } \
            if (((j * 32) / NPV) < 16) A3_PIN(C0); else A3_PIN(C1); \
            SBAR(); } \
        A3_PRIO(0); A3_WAIT_BAR(gk_, gv_); \
        if (!FIXC && resc) { asm volatile("s_waitcnt lgkmcnt(0)" ::: "memory"); \
            _Pragma("unroll") for (int d_ = 0; d_ < NB; ++d_) _Pragma("unroll") for (int r = 0; r < 16; ++r) o[d_][r] *= wsf[crow(r, hi)]; } \
        slk = slk == 2 ? 0 : slk + 1; slv = (t) == 0 ? 0 : (slv == 2 ? 0 : slv + 1); \
    } while (0)
    f32x16 pA0, pA1, pB0, pB1;
    A3_WB(0);
    { const lds_cptr kp_ = kp0;
#pragma unroll
      for (int i = 0; i < NQK; ++i) { const bf16x8 kf = A3_KFRAG(kp_, i);
          if ((i & 1) == 0) pA0 = __builtin_amdgcn_mfma_f32_32x32x16_bf16(kf, qr[i >> 1], i < 2 ? negm : pA0, 0, 0, 0); else pA1 = __builtin_amdgcn_mfma_f32_32x32x16_bf16(kf, qr[i >> 1], i < 2 ? negm : pA1, 0, 0, 0); }
      A3_DMA_K(2, 2); A3_DMA_V(1, 1);
      A3_MASK(pA0, pA1, 0);
      if (!FIXC && !fix) { float rm; A3_ROWMAX(pA0, pA1, rm); mhat = rm;
#pragma unroll
          for (int r = 0; r < 16; ++r) { pA0[r] -= rm; pA1[r] -= rm; }
#pragma unroll
          for (int r = 0; r < 16; ++r) negm[r] = -mhat;
          asm volatile("" : "+v"(negm)); }
#pragma unroll
      for (int r = 0; r < 16; ++r) { pA0[r] = __builtin_amdgcn_exp2f(pA0[r]); pA1[r] = __builtin_amdgcn_exp2f(pA1[r]); }
      A3_WAIT_BAR(true, true);
      slk = 1; slv = 0; }
    int t = 1;
#pragma unroll 1
    for (; t + 5 < NT; t += 2) { A3_STEP(pB0, pB1, pA0, pA1, t, false); A3_STEP(pA0, pA1, pB0, pB1, t + 1, false); }
#define A3_DRAINP(P0, P1) do { float sacc = 0.f; \
        _Pragma("unroll") for (int r = 0; r < 16; ++r) sacc += P0[r]; \
        _Pragma("unroll") for (int r = 0; r < 16; ++r) sacc += P1[r]; \
        l_reg += sacc; \
        _Pragma("unroll") for (int c = 0; c < 16; ++c) { const int e = 2 * c; pw[c >> 2][c & 3] = cvtpk_s(A3_PEL(P0, P1, e), A3_PEL(P0, P1, e + 1)); } \
        const lds_cptr vq_ = vp0 + slv * VSL; \
        s16x4 vl_[3], vh_[3]; vl_[0] = vtr(A3_VFRAG(vq_, 0)); vh_[0] = vtr(A3_VFRAG(vq_, 0) + 512); vl_[1] = vtr(A3_VFRAG(vq_, 1)); vh_[1] = vtr(A3_VFRAG(vq_, 1) + 512); SBAR(); \
        _Pragma("unroll") for (int j = 0; j < NPV; ++j) { \
            if (j + 2 < NPV) { vl_[(j + 2) % 3] = vtr(A3_VFRAG(vq_, j + 2)); vh_[(j + 2) % 3] = vtr(A3_VFRAG(vq_, j + 2) + 512); } \
            SBAR(); \
            o[j % NB] = __builtin_amdgcn_mfma_f32_32x32x16_bf16(__builtin_bit_cast(bf16x8, pw[j / NB]), \
                (bf16x8){vl_[j % 3][0], vl_[j % 3][1], vl_[j % 3][2], vl_[j % 3][3], vh_[j % 3][0], vh_[j % 3][1], vh_[j % 3][2], vh_[j % 3][3]}, o[j % NB], 0, 0, 0); \
            SBAR(); } } while (0)
#define A3_TAIL(t) do { const bool gk_ = (t) + 2 < NT, gv_ = (t) + 1 < NT; \
        if (gk_) A3_DMA_K((t) + 2, slk == 0 ? 2 : slk - 1); if (gv_) A3_DMA_V((t) + 1, slv == 0 ? 2 : slv - 1); \
        A3_WAIT_BAR(gk_, gv_); slk = slk == 2 ? 0 : slk + 1; slv = slv == 2 ? 0 : slv + 1; } while (0)
    if (FIXC && A3_TWOLV) {
#pragma unroll 1
        for (; t + 3 < NT; t += 2) { A3_STEP(pB0, pB1, pA0, pA1, t, true); A3_STEP(pA0, pA1, pB0, pB1, t + 1, true); }
        A3_STEP(pB0, pB1, pA0, pA1, NT - 3, true);
        const int cls = rb >> 1;
        if (cls >= 2) { A3_STEP(pA0, pA1, pB0, pB1, NT - 2, true); }
        else { A3_DMA_V(NT - 1, slv == 0 ? 2 : slv - 1); A3_WAIT_BAR(false, true); }
        if (cls == 3) { A3_STEP(pB0, pB1, pA0, pA1, NT - 1, true); }
        else { if (cls == 2) { pB0 = pA0; pB1 = pA1; } A3_WAIT_BAR(false, false); }
    } else {
#pragma unroll 1
    for (; t + 1 < NT; t += 2) { A3_STEP(pB0, pB1, pA0, pA1, t, true); A3_STEP(pA0, pA1, pB0, pB1, t + 1, true); }
    if ((rb >> 1) == 3) { A3_STEP(pB0, pB1, pA0, pA1, NT - 1, true); }
    else { pB0 = pA0; pB1 = pA1; A3_WAIT_BAR(false, false); }
    }
    A3_DRAINP(pB0, pB1);
#undef A3_TAIL
#undef A3_DRAINP
    { auto rr = __builtin_amdgcn_permlane32_swap(__float_as_uint(l_reg), __float_as_uint(l_reg), false, false); l_reg = __uint_as_float(rr[0]) + __uint_as_float(rr[1]); }
    if (hi == 0) wsf[32 + r32] = l_reg; asm volatile("s_waitcnt lgkmcnt(0)" ::: "memory");
    float rli[16];
#pragma unroll
    for (int r = 0; r < 16; ++r) rli[r] = __builtin_amdgcn_rcpf(wsf[32 + crow(r, hi)]);
    constexpr int PC = 64, NPASS = DV / PC, BPP = PC / 32;
    unsigned nxt = 0u; if (tid == 0) nxt = __hip_atomic_fetch_add(qp, 1u, __ATOMIC_RELAXED, __HIP_MEMORY_SCOPE_AGENT);
    LAS char* stg = (LAS char*)shm + LDS_WS + 2048 + wid * 4096;
    LAS char* stw = stg + hi * 512 + r32 * 2;
    bf16* Ow = Ob + (size_t)(rb * 32 + (lane >> 3)) * LDO + (lane & 7) * 8;
#pragma unroll
    for (int ps = 0; ps < NPASS; ++ps) {
#pragma unroll
        for (int r = 0; r < 16; r += 2)
#pragma unroll
            for (int b = 0; b < BPP; ++b) { const unsigned pk = cvtpk(o[ps * BPP + b][r] * rli[r], o[ps * BPP + b][r + 1] * rli[r + 1]);
                *(LAS unsigned short*)(stw + crow(r, 0) * 128 + b * 64) = (unsigned short)pk; *(LAS unsigned short*)(stw + crow(r + 1, 0) * 128 + b * 64) = (unsigned short)(pk >> 16); }
        asm volatile("s_waitcnt lgkmcnt(0)" ::: "memory");
        u32x4 ov[4];
#pragma unroll
        for (int i = 0; i < 4; ++i) ov[i] = *(const LAS u32x4*)(stg + i * 1024 + lane * 16);
        asm volatile("s_waitcnt lgkmcnt(0)" ::: "memory");
        if (kvmul) {
#pragma unroll
            for (int i = 0; i < 4; ++i) *(u32x4*)(Ow + (size_t)(i * 8) * LDO + ps * PC) = ov[i]; }
    }
    if (tid == 0) misc[0] = nxt;
    asm volatile("s_waitcnt lgkmcnt(0)\n\ts_barrier" ::: "memory");
    const unsigned nidx = (unsigned)__builtin_amdgcn_readfirstlane((int)misc[0]);
#undef A3_DMA_K
#undef A3_DMA_V
#undef A3_WB
#undef A3_WAIT_BAR
#undef A3_KFRAG
#undef A3_VFRAG
#undef A3_MASK
#undef A3_ROWMAX
#undef A3_STEP
    return nidx;
}
#undef A3_PIN
#undef A3_PEL
}
namespace ret {
using namespace at;
__device__ __forceinline__ float log2_gamma(int h) { return h == 0 ? -0.04580368961312479f : h == 1 ? -0.02272007650008353f : h == 2 ? -0.011315313227834146f : -0.005646563141142063f; }
constexpr int IMG = 8192;
template <int OFF> __device__ __forceinline__ s16x4 trr(int vb) { s16x4 r; asm volatile("ds_read_b64_tr_b16 %0, %1 offset:%2" : "=&v"(r) : "v"(vb), "i"(OFF) : "memory"); return r; }

__device__ __forceinline__ void state_item(const bf16* __restrict__ RK, const bf16* __restrict__ RV, float* __restrict__ AST, int b, int h, int cp, char* lds) {
    int tid_ = threadIdx.x; asm volatile("" : "+v"(tid_));
    const int tid = tid_, wid = __builtin_amdgcn_readfirstlane(tid >> 6), lane = tid & 63, r32 = lane & 31, hi = lane >> 5;
    const float l2g = log2_gamma(h);
    const size_t row0 = (size_t)b * SEQ + 256 * cp;
    const int key = tid >> 3, c = (tid & 7) * 8, vst = v_st<2>(key, c);
    bf16x8 kk[4], vv[4];
#pragma unroll
    for (int t = 0; t < 4; ++t) { kk[t] = *reinterpret_cast<const bf16x8*>(RK + (row0 + 64 * t + key) * 256 + h * 64 + c); vv[t] = *reinterpret_cast<const bf16x8*>(RV + (row0 + 64 * t + key) * 256 + h * 64 + c); }
#pragma unroll
    for (int t = 0; t < 4; ++t) { const int j = (64 * t + key) & 127; const float z = __builtin_amdgcn_exp2f((float)(127 - j) * l2g);
        u32x4 w; w.x = cvtpk(bf2f(kk[t][0]) * z, bf2f(kk[t][1]) * z); w.y = cvtpk(bf2f(kk[t][2]) * z, bf2f(kk[t][3]) * z); w.z = cvtpk(bf2f(kk[t][4]) * z, bf2f(kk[t][5]) * z); w.w = cvtpk(bf2f(kk[t][6]) * z, bf2f(kk[t][7]) * z);
        *(u32x4*)(lds + t * IMG + vst) = w; *(bf16x8*)(lds + (4 + t) * IMG + vst) = vv[t]; }
    __syncthreads();
    const int half = wid >> 2, db = (wid >> 1) & 1, eb = wid & 1;
    const int va = (int)(uintptr_t)lds + v_rd_base(lane) + db * 512, vb = (int)(uintptr_t)lds + 4 * IMG + v_rd_base(lane) + eb * 512;
    f32x16 acc = f32x16{};
#define RT_STEP(T, KS) do { const s16x4 al = trr<(T) * IMG + v_rd_off<2>(0, KS, 0)>(va2), ah = trr<(T) * IMG + v_rd_off<2>(0, KS, 1)>(va2), bl = trr<(T) * IMG + v_rd_off<2>(0, KS, 0)>(vb2), bh = trr<(T) * IMG + v_rd_off<2>(0, KS, 1)>(vb2); \
        asm volatile("s_waitcnt lgkmcnt(0)" ::: "memory"); SBAR(); \
        acc = __builtin_amdgcn_mfma_f32_32x32x16_bf16((bf16x8){al[0], al[1], al[2], al[3], ah[0], ah[1], ah[2], ah[3]}, (bf16x8){bl[0], bl[1], bl[2], bl[3], bh[0], bh[1], bh[2], bh[3]}, acc, 0, 0, 0); } while (0)
    { const int va2 = va + half * 2 * IMG, vb2 = vb + half * 2 * IMG;
      RT_STEP(0, 0); RT_STEP(0, 1); RT_STEP(0, 2); RT_STEP(0, 3); RT_STEP(1, 0); RT_STEP(1, 1); RT_STEP(1, 2); RT_STEP(1, 3); }
#undef RT_STEP
    asm volatile("s_nop 7\n\ts_nop 7\n\ts_nop 7" : "+v"(acc));
    bf16* dst = (bf16*)AST + ((size_t)((b * 4 + h) * 64 + 2 * cp + half)) * 4096 + (size_t)(32 * db) * 64 + 32 * eb + r32;
#pragma unroll
    for (int r = 0; r < 16; r += 2) { const unsigned pk = cvtpk(acc[r], acc[r + 1]); *(unsigned short*)(dst + crow(r, hi) * 64) = (unsigned short)pk; *(unsigned short*)(dst + crow(r + 1, hi) * 64) = (unsigned short)(pk >> 16); }
    __syncthreads();
}

__device__ __forceinline__ void ret_unit(const bf16* __restrict__ RQ, const bf16* __restrict__ RK, const bf16* __restrict__ RV, const bf16* __restrict__ RG, const float* __restrict__ AST,
                                         const float* __restrict__ gnw, const float* __restrict__ gnb, bf16* __restrict__ MIX, int b, int h, int cp, char* lds) {
    int tid_ = threadIdx.x; asm volatile("" : "+v"(tid_));
    const int tid = tid_, wid = __builtin_amdgcn_readfirstlane(tid >> 6), lane = tid & 63, r32 = lane & 31, hi = lane >> 5;
    const float l2g = log2_gamma(h);
    const size_t row0 = (size_t)b * SEQ + 256 * cp;
    char* K_lds = lds; char* V_lds = lds + 4 * IMG; char* R_lds = lds + 8 * IMG; char* S_lds = lds;
    { const int key = tid >> 3, ch = tid & 7, c = ch * 8, vst = v_st<2>(key, c), kst = k_addr<128>(key, ch);
      bf16x8 kk[4], vv[4];
#pragma unroll
      for (int t = 0; t < 4; ++t) { kk[t] = *reinterpret_cast<const bf16x8*>(RK + (row0 + 64 * t + key) * 256 + h * 64 + c); vv[t] = *reinterpret_cast<const bf16x8*>(RV + (row0 + 64 * t + key) * 256 + h * 64 + c); }
      const float gC = __builtin_amdgcn_exp2f(128.f * l2g);
      const bf16* ap = (const bf16*)AST + (size_t)((b * 4 + h) * 64) * 4096 + (size_t)key * 64 + c;
#define RT_LO4(x) ((f32x4){bf2f((x)[0]), bf2f((x)[1]), bf2f((x)[2]), bf2f((x)[3])})
#define RT_HI4(x) ((f32x4){bf2f((x)[4]), bf2f((x)[5]), bf2f((x)[6]), bf2f((x)[7])})
      f32x4 r0 = {0.f, 0.f, 0.f, 0.f}, r1 = {0.f, 0.f, 0.f, 0.f};
      const int nprev = 2 * cp;
      { float w = 1.0f;
        int j = nprev - 1;
        for (; j >= 7; j -= 8) { bf16x8 xs[8];
#pragma unroll
            for (int q = 0; q < 8; ++q) xs[q] = *reinterpret_cast<const bf16x8*>(ap + (size_t)(j - q) * 4096);
#pragma unroll
            for (int q = 0; q < 8; ++q) { r0 += RT_LO4(xs[q]) * w; r1 += RT_HI4(xs[q]) * w; w *= gC; } }
        if (j >= 1) { bf16x8 xs[6];
#pragma unroll
            for (int q = 0; q < 6; ++q) { if (j - q >= 0) xs[q] = *reinterpret_cast<const bf16x8*>(ap + (size_t)(j - q) * 4096); else xs[q] = bf16x8{}; }
#pragma unroll
            for (int q = 0; q < 6; ++q) { r0 += RT_LO4(xs[q]) * w; r1 += RT_HI4(xs[q]) * w; w *= gC; } } }
      *(u32x4*)(R_lds + vst) = (u32x4){cvtpk(r0[0], r0[1]), cvtpk(r0[2], r0[3]), cvtpk(r1[0], r1[1]), cvtpk(r1[2], r1[3])};
      { const bf16x8 an = *reinterpret_cast<const bf16x8*>(ap + (size_t)nprev * 4096); r0 = RT_LO4(an) + r0 * gC; r1 = RT_HI4(an) + r1 * gC; }
#undef RT_LO4
#undef RT_HI4
      *(u32x4*)(R_lds + IMG + vst) = (u32x4){cvtpk(r0[0], r0[1]), cvtpk(r0[2], r0[3]), cvtpk(r1[0], r1[1]), cvtpk(r1[2], r1[3])};
#pragma unroll
      for (int t = 0; t < 4; ++t) { *(bf16x8*)(K_lds + t * IMG + kst) = kk[t]; *(bf16x8*)(V_lds + t * IMG + vst) = vv[t]; }
    }
    __syncthreads();
    const int half = wid >> 2, wq = wid & 3;
    bf16x8 qr[4];
    { const bf16* Qw = RQ + (row0 + 128 * half + 32 * wq + r32) * 256 + h * 64 + hi * 8;
#pragma unroll
      for (int d0 = 0; d0 < 4; ++d0) qr[d0] = *reinterpret_cast<const bf16x8*>(Qw + d0 * 16); }
    f32x16 o[2]; o[0] = f32x16{}; o[1] = f32x16{};
    const int vbase = (int)(uintptr_t)V_lds + v_rd_base(lane);
    const int iq = 32 * wq + r32;
#pragma unroll
    for (int tt = 0; tt < 2; ++tt) {
        if (64 * tt > 32 * wq + 31) continue;
        f32x16 p0, p1; bf16x8 pa0, pa1, pa2, pa3;
        qkt<64, 128>(p0, p1, K_lds + (2 * half + tt) * IMG, r32, hi, qr);
#pragma unroll
        for (int r = 0; r < 16; ++r) { const int d0_ = iq - (64 * tt + crow(r, hi)), d1_ = d0_ - 32;
            p0[r] = d0_ >= 0 ? p0[r] * __builtin_amdgcn_exp2f((float)d0_ * l2g) : 0.f; p1[r] = d1_ >= 0 ? p1[r] * __builtin_amdgcn_exp2f((float)d1_ * l2g) : 0.f; }
        pack_p(p0, p1, pa0, pa1, pa2, pa3);
        pv_all<2>(o, vbase + (2 * half + tt) * IMG, pa0, pa1, pa2, pa3);
    }
    { f32x16 oc[2]; oc[0] = f32x16{}; oc[1] = f32x16{};
      pv_all<2>(oc, (int)(uintptr_t)R_lds + half * IMG + v_rd_base(lane), qr[0], qr[1], qr[2], qr[3]);
#pragma unroll
      for (int r = 0; r < 16; ++r) { const float xi = __builtin_amdgcn_exp2f((float)(32 * wq + crow(r, hi) + 1) * l2g); o[0][r] += oc[0][r] * xi; o[1][r] += oc[1][r] * xi; } }
    __syncthreads();
    float* st = (float*)(S_lds + wid * 8448);
#pragma unroll
    for (int r = 0; r < 16; ++r) { st[crow(r, hi) * 66 + r32] = o[0][r]; st[crow(r, hi) * 66 + 32 + r32] = o[1][r]; }
    asm volatile("s_waitcnt lgkmcnt(0)" ::: "memory");
    { const int rr = lane >> 1, hh = lane & 1; const float* sp = st + rr * 66 + hh * 32; float x[32]; float s = 0.f;
#pragma unroll
      for (int k = 0; k < 32; ++k) { x[k] = sp[k]; s += x[k]; }
      s += shx<1>(s); const float mean = s * (1.0f / 64.0f); float q = 0.f;
#pragma unroll
      for (int k = 0; k < 32; ++k) { x[k] -= mean; q += x[k] * x[k]; }
      q += shx<1>(q); const float rstd = 1.0f / sqrtf(q * (1.0f / 64.0f) + 1e-6f);
      const size_t grow = row0 + 128 * half + 32 * wq + rr; const int cb = h * 64 + hh * 32;
      const bf16* gp = RG + grow * 256 + cb; bf16* op = MIX + grow * 1024 + 768 + cb;
#pragma unroll
      for (int k8 = 0; k8 < 4; ++k8) { const bf16x8 g8 = *reinterpret_cast<const bf16x8*>(gp + 8 * k8); const f32x4 w0 = *(const f32x4*)(gnw + cb + 8 * k8), w1 = *(const f32x4*)(gnw + cb + 8 * k8 + 4), bb0 = *(const f32x4*)(gnb + cb + 8 * k8), bb1 = *(const f32x4*)(gnb + cb + 8 * k8 + 4);
          float y[8];
#pragma unroll
          for (int k = 0; k < 8; ++k) y[k] = (x[8 * k8 + k] * rstd * (k < 4 ? w0[k & 3] : w1[k & 3]) + (k < 4 ? bb0[k & 3] : bb1[k & 3])) * bf2f(g8[k]);
          *(u32x4*)(op + 8 * k8) = (u32x4){cvtpk(y[0], y[1]), cvtpk(y[2], y[3]), cvtpk(y[4], y[5]), cvtpk(y[6], y[7])}; } }
    __syncthreads();
}

__device__ __forceinline__ void combine_row(const bf16* __restrict__ OD, const float* __restrict__ subln, float lam, float oml, bf16* __restrict__ MIX, size_t row, int lane) {
    const int head = lane >> 4, e0 = (lane & 15) * 8;
    const bf16x8 a = *reinterpret_cast<const bf16x8*>(OD + row * 1024 + head * 256 + e0), b2 = *reinterpret_cast<const bf16x8*>(OD + row * 1024 + head * 256 + 128 + e0);
    float o[8]; float s = 0.f;
#pragma unroll
    for (int k = 0; k < 8; ++k) { o[k] = bf2f(a[k]) - lam * bf2f(b2[k]); s += o[k] * o[k]; }
    s += shx<1>(s); s += shx<2>(s); s += shx<4>(s); s += shx<8>(s);
    const float rs = oml / sqrtf(s * (1.0f / 128.0f) + 1e-5f);
    const f32x4 g0 = *(const f32x4*)(subln + e0), g1 = *(const f32x4*)(subln + e0 + 4);
    *(u32x4*)(MIX + row * 1024 + head * 128 + e0) = (u32x4){cvtpk(o[0] * rs * g0[0], o[1] * rs * g0[1]), cvtpk(o[2] * rs * g0[2], o[3] * rs * g0[3]), cvtpk(o[4] * rs * g1[0], o[5] * rs * g1[1]), cvtpk(o[6] * rs * g1[2], o[7] * rs * g1[3])};
}
__device__ __forceinline__ void combine_rows4(const bf16* __restrict__ OD, const float* __restrict__ subln, float lam, float oml, bf16* __restrict__ MIX, size_t row, size_t stride, int lane) {
    const int head = lane >> 4, e0 = (lane & 15) * 8;
    bf16x8 a[4], b2[4];
#pragma unroll
    for (int k = 0; k < 4; ++k) { a[k] = *reinterpret_cast<const bf16x8*>(OD + (row + k * stride) * 1024 + head * 256 + e0); b2[k] = *reinterpret_cast<const bf16x8*>(OD + (row + k * stride) * 1024 + head * 256 + 128 + e0); }
    const f32x4 g0 = *(const f32x4*)(subln + e0), g1 = *(const f32x4*)(subln + e0 + 4);
#pragma unroll
    for (int k = 0; k < 4; ++k) { float o[8]; float s = 0.f;
#pragma unroll
        for (int j = 0; j < 8; ++j) { o[j] = bf2f(a[k][j]) - lam * bf2f(b2[k][j]); s += o[j] * o[j]; }
        s += shx<1>(s); s += shx<2>(s); s += shx<4>(s); s += shx<8>(s);
        const float rs = oml / sqrtf(s * (1.0f / 128.0f) + 1e-5f);
        const u32x4 w = (u32x4){cvtpk(o[0] * rs * g0[0], o[1] * rs * g0[1]), cvtpk(o[2] * rs * g0[2], o[3] * rs * g0[3]), cvtpk(o[4] * rs * g1[0], o[5] * rs * g1[1]), cvtpk(o[6] * rs * g1[2], o[7] * rs * g1[3])};
        asm volatile("global_store_dwordx4 %0, %1, off sc1\n\ts_nop 1" :: "v"(MIX + (row + k * stride) * 1024 + head * 128 + e0), "v"(w) : "memory"); }
}
}
#ifndef MK_N_LAUNCHES
#define MK_N_LAUNCHES 1
#endif
constexpr int N_PHASES = 16;

struct Args { const void* in[21]; float* out; unsigned char* ws; int ph_lo, ph_hi; };
static_assert(sizeof(Args) == 23 * 8 + 8, "no padding");

__device__ __forceinline__ float wave_sum(float v) { v += shx<1>(v); v += shx<2>(v); v += shx<4>(v); v += shx<8>(v); v += shx<16>(v); return add_x32(v); }
__device__ const float INVF[32] = { 1.000000000e+00f, 7.498942018e-01f, 5.623413324e-01f, 4.216965139e-01f, 3.162277639e-01f, 2.371373922e-01f, 1.778279394e-01f, 1.333521456e-01f, 1.000000015e-01f, 7.498941571e-02f, 5.623412877e-02f,
    4.216964915e-02f, 3.162277862e-02f, 2.371373586e-02f, 1.778279431e-02f, 1.333521493e-02f, 9.999999776e-03f, 7.498942316e-03f, 5.623413250e-03f, 4.216964822e-03f, 3.162277862e-03f, 2.371373819e-03f, 1.778279431e-03f,
    1.333521446e-03f, 1.000000047e-03f, 7.498941850e-04f, 5.623413017e-04f, 4.216965463e-04f, 3.162277862e-04f, 2.371373848e-04f, 1.778279402e-04f, 1.333521504e-04f };

struct WSrc { const float *w_in, *attn_norm, *w_uq, *q_norm, *w_ukv, *kv_norm, *w_out, *w_gate, *w_up, *ffn_norm, *w_down; };
__device__ __forceinline__ int ckv_slot(int p) { const int x = p & 127; if (x < 16) return -1; const int s = ((p >> 7) ? 112 : 0) + x - 16; return s < 128 ? s : -1; }
__device__ __forceinline__ bool src_in(const WSrc& w, int n, int k, const float*& p, float& g) {
    const int pn = n >> 8, q = n & 255, bj = q >> 7, x = q & 127, wc = x >> 5, y = x & 31, rp = 64 * wc + 32 * bj + y; int c;
    switch (pn) {
        case 0: case 1: c = 256 * pn + rp; break;
        case 2: case 3: c = 512 + 256 * (pn - 2) + rp; break;
        case 4: case 5: c = 1024 + 256 * (pn - 4) + q; break;
        case 6: c = 1536 + q; break;
        case 7: if (x < 16) c = 1920 + 16 * bj + x; else { const int s = ckv_slot(q); if (s < 0) return false; c = 1792 + s; } break;
        case 8: c = 1952 + rp; break;
        case 9: c = 2208 + rp; break;
        case 10: c = 2464 + q; break;
        default: c = 2720 + q; break;
    }
    p = w.w_in + (size_t)k * IN_COLS + c; g = w.attn_norm[k]; return true;
}
__device__ __forceinline__ bool src_uq(const WSrc& w, int n, int k, const float*& p, float& g) {
    const int pn = n >> 8, q = n & 255, bj = q >> 7, x = q & 127, wc = x >> 5, y = x & 31, head = 2 * pn + (wc >> 1); int c;
    if ((wc & 1) == 0) c = head * 96 + 32 * bj + y; else { if (y >= 16) return false; c = head * 96 + 64 + 16 * bj + y; }
    p = w.w_uq + (size_t)k * 384 + c; g = w.q_norm[k]; return true;
}
__device__ __forceinline__ bool src_ukv(const WSrc& w, int n, int k, const float*& p, float& g) {
    const int pn = n >> 8, q = n & 255, bj = q >> 7, x = q & 127, wc = x >> 5, y = x & 31, head = 2 * pn + (wc >> 1), c = head * 128 + 64 * (wc & 1) + 32 * bj + y;
    const int s = ckv_slot(k); if (s < 0) return false;
    p = w.w_ukv + (size_t)s * 512 + c; g = w.kv_norm[s]; return true;
}
__device__ __forceinline__ bool src_out(const WSrc& w, int n, int k, const float*& p, float& g) { p = w.w_out + (size_t)k * 1024 + n; g = 1.0f; return true; }
__device__ __forceinline__ bool src_gu(const WSrc& w, int n, int k, const float*& p, float& g) { const int c = 128 * (n >> 8) + (n & 127); p = ((n >> 7) & 1 ? w.w_up : w.w_gate) + (size_t)k * FFH + c; g = w.ffn_norm[k]; return true; }
__device__ __forceinline__ bool src_dn(const WSrc& w, int n, int k, const float*& p, float& g) { p = w.w_down + (size_t)k * 1024 + n; g = 1.0f; return true; }

template <int WHICH> __device__ __forceinline__ void wconv_item(const WSrc& w, bf16* WT, int K, int N, LAS float* scr, int item, int lane) {
    const int nblk = N / 32, kb = item / nblk, nb = item % nblk, k0 = 64 * kb, n0 = 32 * nb;
    const int n4 = n0 + 4 * (lane & 7);
    f32x4 vv[8];
#pragma unroll
    for (int i = 0; i < 8; ++i) { const int k = k0 + 8 * i + (lane >> 3); const float* p = nullptr; float g = 0.f; bool ok;
        if (WHICH == 0) ok = src_in(w, n4, k, p, g); else if (WHICH == 1) ok = src_uq(w, n4, k, p, g); else if (WHICH == 2) ok = src_ukv(w, n4, k, p, g); else if (WHICH == 3) ok = src_out(w, n4, k, p, g); else if (WHICH == 4) ok = src_gu(w, n4, k, p, g); else ok = src_dn(w, n4, k, p, g);
        vv[i] = ok ? *(const GAS f32x4*)p * g : (f32x4){0.f, 0.f, 0.f, 0.f}; }
#pragma unroll
    for (int i = 0; i < 8; ++i) { LAS float* d = scr + (8 * i + (lane >> 3)) * 33 + 4 * (lane & 7); d[0] = vv[i].x; d[1] = vv[i].y; d[2] = vv[i].z; d[3] = vv[i].w; }
    LDS_WAIT(); asm volatile("" ::: "memory");
    const int c = lane & 7;
#pragma unroll
    for (int j = 0; j < 4; ++j) { const int n = (lane >> 3) + 8 * j; const LAS float* s = scr + (8 * c) * 33 + n;
        v4u o; o.x = pk2(s[0 * 33], s[1 * 33]); o.y = pk2(s[2 * 33], s[3 * 33]); o.z = pk2(s[4 * 33], s[5 * 33]); o.w = pk2(s[6 * 33], s[7 * 33]);
        *(GAS v4u*)(WT + (size_t)(n0 + n) * K + k0 + 8 * c) = o; }
    LDS_WAIT(); asm volatile("" ::: "memory");
}
struct Args;
__device__ __forceinline__ int cv_next(gu32* ctr, int gw, int prev, int NGW, int lane) {
    if (!ctr) return prev < 0 ? gw : prev + NGW;
    if (prev >= 0 && (prev & 1) == 0) return prev + 1;
    unsigned v = 0; if (lane == 0) v = __hip_atomic_fetch_add(ctr, 2u, __ATOMIC_RELAXED, __HIP_MEMORY_SCOPE_AGENT);
    return (int)__builtin_amdgcn_readfirstlane((int)v);
}
__device__ __forceinline__ void convert_group(const __attribute__((address_space(4))) Args* a, unsigned char* ws, int layer, int grp, LAS unsigned char* lds, int gw, int NGW, int wave, int lane, gu32* ctr = nullptr) {
    WSrc w;
    w.w_in = (const float*)a->in[3] + (size_t)layer * 1024 * IN_COLS; w.attn_norm = (const float*)a->in[2] + layer * 1024;
    w.w_uq = (const float*)a->in[10] + (size_t)layer * 256 * 384; w.q_norm = (const float*)a->in[9] + layer * 256;
    w.w_ukv = (const float*)a->in[12] + (size_t)layer * 128 * 512; w.kv_norm = (const float*)a->in[11] + layer * 128;
    w.w_out = (const float*)a->in[15] + (size_t)layer * 1024 * 1024; w.ffn_norm = (const float*)a->in[16] + layer * 1024;
    w.w_gate = (const float*)a->in[17] + (size_t)layer * 1024 * FFH; w.w_up = (const float*)a->in[18] + (size_t)layer * 1024 * FFH; w.w_down = (const float*)a->in[19] + (size_t)layer * FFH * 1024;
    LAS float* scr = (LAS float*)(lds + wave * 16384);
    if (grp == 0) {
        constexpr int I0 = (1024 / 64) * (NIN / 32), I1 = (256 / 64) * (512 / 32), I2 = I1;
        for (int it = cv_next(ctr, gw, -1, NGW, lane); it < I0 + I1 + I2; it = cv_next(ctr, gw, it, NGW, lane)) {
            if (it < I0) wconv_item<0>(w, (bf16*)(ws + WS_WIN), 1024, NIN, scr, it, lane);
            else if (it < I0 + I1) wconv_item<1>(w, (bf16*)(ws + WS_WUQ), 256, 512, scr, it - I0, lane);
            else wconv_item<2>(w, (bf16*)(ws + WS_WUKV), 256, 512, scr, it - I0 - I1, lane);
        }
    } else {
        constexpr int I0 = (1024 / 64) * (1024 / 32), I1 = (1024 / 64) * (NGU / 32), I2 = (FFH / 64) * (1024 / 32);
        for (int it = cv_next(ctr, gw, -1, NGW, lane); it < I0 + I1 + I2; it = cv_next(ctr, gw, it, NGW, lane)) {
            if (it < I0) wconv_item<3>(w, (bf16*)(ws + WS_WOUT), 1024, 1024, scr, it, lane);
            else if (it < I0 + I1) wconv_item<4>(w, (bf16*)(ws + WS_WGU), 1024, NGU, scr, it - I0, lane);
            else wconv_item<5>(w, (bf16*)(ws + WS_WDN), FFH, 1024, scr, it - I0 - I1, lane);
        }
    }
}

typedef const __attribute__((address_space(4))) Args* KArgs;
#define P_(T, OFF) ((T*)(ws + (OFF)))
#define ENV() KArgs ap = (KArgs)__builtin_amdgcn_kernarg_segment_ptr(); asm volatile("" : "+s"(ap)); unsigned char* const ws = ap->ws; float* const out = ap->out; (void)out; \
    int tid_o = threadIdx.x; asm volatile("" : "+v"(tid_o)); const int lane_o = tid_o & 63, wave = __builtin_amdgcn_readfirstlane(tid_o >> 6); (void)lane_o; \
    const int G = gridDim.x, bx = blockIdx.x, vcu = (G % 8 == 0) ? (bx % 8) * (G / 8) + bx / 8 : bx, gw = vcu * NWAVES + wave, NGW = G * NWAVES; (void)gw; (void)NGW
#ifndef PROBE_DUP
#define PROBE_DUP 0
#endif
#ifdef PROBE_KV0
#define PROBE_KVARG , (rep == 0 ? 1 : 0)
#else
#define PROBE_KVARG
#endif
#ifndef ATT
#define ATT at3
#endif
#ifndef PROBE_M1S
#define PROBE_M1S 1
#endif
#define NREP(j) (((PROBE_DUP >> (j)) & 1) ? 2 : 1)
__device__ __forceinline__ bool ph_in(int k) { KArgs ap = (KArgs)__builtin_amdgcn_kernarg_segment_ptr(); return ap->ph_lo <= k && k < ap->ph_hi; }
__device__ __forceinline__ void grid_bar(int k, LAS unsigned char* L) {
    if (MK_N_LAUNCHES != 1) return;
    if (!(ph_in(k) && ph_in(k + 1))) return;
    KArgs ap = (KArgs)__builtin_amdgcn_kernarg_segment_ptr();
    XcdBarrier b; b.bar = (unsigned*)(ap->ws + WS_CTL) + CW_BAR; b.x = xb_xcc_id(); b.st = (volatile LAS unsigned*)(L + MISC_OFF) + 8;
    xcd_barrier(b);
#ifdef PROBE_XBAR
    xcd_barrier(b);
#endif
}
template <bool RELEASE> __device__ __forceinline__ void panel_barrier(gu32* cnt, unsigned expected, gu32* tmo) {
    asm volatile("s_waitcnt vmcnt(0)" ::: "memory");
    __syncthreads();
    if (threadIdx.x == 0) {
        if (RELEASE) { __builtin_amdgcn_fence(__ATOMIC_RELEASE, "agent"); asm volatile("s_waitcnt vmcnt(0)" ::: "memory"); }
        (void)__hip_atomic_fetch_add(cnt, 1u, __ATOMIC_RELAXED, __HIP_MEMORY_SCOPE_AGENT);
        __builtin_amdgcn_fence(__ATOMIC_ACQUIRE, "agent");
        unsigned sp = 0;
        while (__hip_atomic_load(cnt, __ATOMIC_RELAXED, __HIP_MEMORY_SCOPE_AGENT) < expected) { __builtin_amdgcn_s_sleep(2);
            if ((++sp & 255u) == 0u) { if (__hip_atomic_load(tmo, __ATOMIC_RELAXED, __HIP_MEMORY_SCOPE_AGENT)) break; if (sp > (1u << 20)) { atomicAdd((unsigned*)tmo, 1u); break; } } }
        asm volatile("s_waitcnt vmcnt(0)" ::: "memory");
    }
    __syncthreads();
}
template <class Sched> __device__ __forceinline__ void prep_row_scales(const Sched& S_, const float* ssq, float inv_n, LAS unsigned char* L) {
    Sched S = S_; asm volatile("" : "+s"(S.c));
    LAS float* tab = (LAS float*)(L + RS_OFF); int t = threadIdx.x; asm volatile("" : "+v"(t));
    if (t < 256) {
        f32x4 v[8]; bool ok[8];
#pragma unroll
        for (int i = 0; i < 8; ++i) { pg8::Unit u; ok[i] = S.next(i, u); if (ok[i]) v[i] = *(const GAS f32x4*)(ssq + (size_t)(u.pm * 256 + t) * 4); }
#pragma unroll
        for (int i = 0; i < 8; ++i) if (ok[i]) tab[i * 256 + t] = 1.0f / sqrtf(((v[i].x + v[i].y) + (v[i].z + v[i].w)) * inv_n + NORM_EPS);
    }
    __syncthreads();
}
__global__ void __launch_bounds__(NWAVES * 64, 2) hyb_fwd(Args args) {
    extern __shared__ __attribute__((aligned(16))) unsigned char lds[];
    LAS unsigned char* L = (LAS unsigned char*)lds;
    volatile LAS unsigned* MISC = (volatile LAS unsigned*)(L + MISC_OFF);
    for (int u = threadIdx.x; u < (LDS_BYTES - LDSCTL_OFF) / 4; u += NWAVES * 64) ((LAS unsigned*)(L + LDSCTL_OFF))[u] = 0u;
    __syncthreads();
    if (MK_N_LAUNCHES == 1) { (void)xcd_barrier_post((unsigned*)(args.ws + WS_CTL) + CW_BAR, MISC + 8); }

    if (ph_in(0)) for (int rep = 0; rep < NREP(7); ++rep) {
        { ENV(); convert_group(ap, ws, 0, 0, L, gw, NGW, wave, lane_o); }
        { ENV(); convert_group(ap, ws, 0, 1, L, gw, NGW, wave, lane_o); }
        { ENV(); const float* x_in = (const float*)ap->in[0]; bf16* XB = P_(bf16, WS_XB); float* SSQ = P_(float, WS_SSQ);
          for (int m = gw; m < MTOK; m += 2 * NGW) {
            f32x4 v[2][4]; float s[2];
#pragma unroll
            for (int k = 0; k < 2; ++k) { const GAS f32x4* xr = (const GAS f32x4*)(x_in + (size_t)(m + k * NGW) * DMODEL) + lane_o;
#pragma unroll
                for (int j = 0; j < 4; ++j) v[k][j] = xr[64 * j]; }
#pragma unroll
            for (int k = 0; k < 2; ++k) { GAS unsigned long long* o8 = (GAS unsigned long long*)(XB + (size_t)(m + k * NGW) * DMODEL) + lane_o; s[k] = 0.f;
#pragma unroll
                for (int j = 0; j < 4; ++j) { const f32x4 w = v[k][j]; s[k] += (w.x * w.x + w.y * w.y) + (w.z * w.z + w.w * w.w); o8[64 * j] = (unsigned long long)pk2(w.x, w.y) | ((unsigned long long)pk2(w.z, w.w) << 32); }
                s[k] = wave_sum(s[k]);
                if (lane_o == 0) *(GAS f32x4*)(SSQ + (size_t)(m + k * NGW) * 4) = (f32x4){s[k], 0.f, 0.f, 0.f}; }
          } }
        { ENV(); const int* pos = (const int*)ap->in[1]; float* T64 = P_(float, WS_T64); float* TM = P_(float, WS_TM);
          for (int i = bx * (NWAVES * 64) + tid_o; i < MTOK * 32; i += G * NWAVES * 64) {
            const int row = i >> 5, f = i & 31; const float ang = (float)pos[row] * INVF[f];
            const double ad = (double)ang, kd = __builtin_rint(ad * 0.15915494309189535), rd = __builtin_fma(-kd, 6.283185307179586, ad);
            const float rev = (float)(rd * 0.15915494309189535), sn = __builtin_amdgcn_sinf(rev), cs = __builtin_amdgcn_cosf(rev);
            T64[(size_t)row * 64 + f] = cs; T64[(size_t)row * 64 + 32 + f] = sn;
            if ((f & 1) == 0) { TM[(size_t)row * 32 + (f >> 1)] = cs; TM[(size_t)row * 32 + 16 + (f >> 1)] = sn; }
          } }
    }
    grid_bar(0, L);

#pragma unroll 1
    for (int layer = 0; layer < DEPTH; ++layer) {
        const int P = 1 + 7 * layer;
        if (ph_in(P)) {
            ENV();
            pg8::Gemm g{P_(bf16, WS_XB), P_(const bf16, WS_WIN), MTOK, NIN, DMODEL}; pg8::StaticOrder S; S.init(MTOK, NIN, G, bx);
            prep_row_scales(S, P_(const float, WS_SSQ), 1.0f / 1024.0f, L);
            pg8::EpiG1 E{ws, layer, (const LAS float*)(L + RS_OFF)};
            for (int rep = 0; rep < NREP(0); ++rep) pg8::gemm_phase<pg8::EpiG1, pg8::StaticOrder, true, true>(L, g, S, E);
        }
        grid_bar(P, L);
        if (ph_in(P + 1)) {
            for (int rep = 0; rep < NREP(1); ++rep) {
            { ENV(); int K1 = 256; asm volatile("" : "+s"(K1));
              pg8::Gemm g{P_(bf16, WS_CQ), P_(const bf16, WS_WUQ), MTOK, 512, K1}; pg8::StaticOrder S; S.init(MTOK, 512, G, bx);
              pg8::EpiMQ E{ws}; pg8::gemm_phase<pg8::EpiMQ, pg8::StaticOrder, true, true>(L, g, S, E); }
            { ENV(); int K1 = 256; asm volatile("" : "+s"(K1));
              pg8::Gemm g{P_(bf16, WS_CKV), P_(const bf16, WS_WUKV), MTOK, 512, K1}; pg8::StaticOrder S; S.init(MTOK, 512, G, (bx + G / 2) % G);
              pg8::EpiMKV E{ws}; pg8::gemm_phase<pg8::EpiMKV, pg8::StaticOrder, true, true>(L, g, S, E); }
            for (int rs_ = 0; rs_ < PROBE_M1S; ++rs_) { ENV(); for (int u = bx; u < 256; u += G) ret::state_item(P_(bf16, WS_RK), P_(bf16, WS_RV), P_(float, WS_AST), u >> 7, (u >> 5) & 3, u & 31, (char*)lds); }
            }
        }
        grid_bar(P + 1, L);
        if (ph_in(P + 2)) {
            for (int rep = 0; rep < NREP(2); ++rep) {
            const unsigned myx = xb_xcc_id() & 7u;
            for (unsigned s = 0; s < 8; ++s) { const unsigned xq = (myx + s) & 7u;
                gu32* qp; { ENV(); qp = (gu32*)(ws + WS_CTL) + CW_Q + layer * 1024 + rep * 512 + 64 * xq; }
#define POP_SYNC() do { int t0_ = threadIdx.x; asm volatile("" : "+v"(t0_)); __syncthreads(); if (t0_ == 0) MISC[0] = __hip_atomic_fetch_add(qp, 1u, __ATOMIC_RELAXED, __HIP_MEMORY_SCOPE_AGENT); __syncthreads(); idx = (unsigned)__builtin_amdgcn_readfirstlane((int)MISC[0]); } while (0)
                unsigned idx; POP_SYNC();
                while (idx < 128u) {
                    ENV();
                    if (idx >= 96u) { ret::ret_unit(P_(bf16, WS_RQ), P_(bf16, WS_RK), P_(bf16, WS_RV), P_(bf16, WS_RG), P_(float, WS_AST), (const float*)ap->in[13] + layer * 256, (const float*)ap->in[14] + layer * 256,
                                                    P_(bf16, WS_MIX), (int)(xq >> 2), (int)(xq & 3u), 127 - (int)idx, (char*)lds); POP_SYNC(); continue; }
                    const int qb = 31 - (int)(idx / 3u), kind = (int)(idx % 3u), b = (int)(xq >> 2), head = (int)(xq & 3u);
                    const size_t r0 = (size_t)b * SEQ, rq = r0 + 256 * qb;
                    if (kind < 2) { const float* km = (const float*)((gu32*)(ws + WS_CTL) + CW_KM);
                        const float bnd = __hip_atomic_load(km + 256 + layer * 1024 + (b * 32 + qb) * 8 + head * 2 + kind, __ATOMIC_RELAXED, __HIP_MEMORY_SCOPE_AGENT) * __hip_atomic_load(km + layer * 64 + b * 8 + head * 2 + kind, __ATOMIC_RELAXED, __HIP_MEMORY_SCOPE_AGENT) * 1.01f;
                        const bf16* q_ = P_(bf16, WS_DQ) + rq * 512 + head * 128 + kind * 64; const bf16* k_ = P_(bf16, WS_DK) + r0 * 512 + head * 128 + kind * 64; const bf16* v_ = P_(bf16, WS_DV) + r0 * 512 + head * 128;
                        bf16* o_ = (bf16*)out + rq * 1024 + head * 256 + kind * 128;
                        if (bnd < 100.f) idx = ATT::attn_unit<64, 128, 512, 512, 512, 1024, 1>(q_, k_, v_, o_, qb, (char*)lds, qp, MISC);
                        else idx = ATT::attn_unit<64, 128, 512, 512, 512, 1024, 0>(q_, k_, v_, o_, qb, (char*)lds, qp, MISC); }
                    else idx = ATT::attn_unit<96, 64, 384, 384, 256, 1024>(P_(bf16, WS_MQ) + rq * 384 + head * 96, P_(bf16, WS_MK) + r0 * 384 + head * 96, P_(bf16, WS_MV) + r0 * 256 + head * 64, P_(bf16, WS_MIX) + rq * 1024 + 512 + head * 64, qb, (char*)lds, qp, MISC PROBE_KVARG);
                } }
            { ENV(); if (layer == 1 || G != 256) convert_group(ap, ws, 1, layer == 0 ? 0 : 1, L, gw, NGW, wave, lane_o); }
            }
        }
        grid_bar(P + 2, L);
        if (ph_in(P + 4)) {
            ENV();
            pg8::Gemm g{P_(bf16, WS_MIX), P_(const bf16, WS_WOUT), MTOK, DMODEL, DMODEL}; pg8::StaticOrder S; S.init(MTOK, DMODEL, G, bx);
            if (G == 256) {
                pg8::Unit u0; (void)S.next(0, u0);
                { const float s1 = wave_sum(((const float*)ap->in[4])[layer * 64 + lane_o] * ((const float*)ap->in[5])[layer * 64 + lane_o]), s2 = wave_sum(((const float*)ap->in[6])[layer * 64 + lane_o] * ((const float*)ap->in[7])[layer * 64 + lane_o]);
                  const float lam_init = layer == 0 ? 0.2f : 0.35550906759096934f, lam = __builtin_amdgcn_exp2f(s1 * LOG2E) - __builtin_amdgcn_exp2f(s2 * LOG2E) + lam_init;
                  const float* subln = (const float*)ap->in[8] + layer * 128;
                  const size_t r0 = (size_t)u0.pm * 256 + (size_t)u0.pn * 64 + (size_t)wave * 8;
                  ret::combine_rows4((const bf16*)out, subln, lam, 1.0f - lam_init, P_(bf16, WS_MIX), r0, (size_t)1, lane_o);
                  ret::combine_rows4((const bf16*)out, subln, lam, 1.0f - lam_init, P_(bf16, WS_MIX), r0 + 4, (size_t)1, lane_o); }
                panel_barrier<false>((gu32*)(ws + WS_CTL) + CW_P + (layer * 64 + u0.pm) * 64, 4u, (gu32*)(ws + WS_CTL) + CW_TMO);
                pg8::EpiRes E{ws, 0, 0, nullptr, nullptr};
                for (int rep = 0; rep < NREP(4); ++rep) { E.dry = rep; pg8::gemm_phase<pg8::EpiRes, pg8::StaticOrder, false, true>(L, g, S, E); }
            }
        }
        grid_bar(P + 4, L);
        if (ph_in(P + 5)) {
            ENV();
            pg8::Gemm g{P_(bf16, WS_XB), P_(const bf16, WS_WGU), MTOK, NGU, DMODEL}; pg8::StaticOrder S; S.init(MTOK, NGU, G, bx);
            prep_row_scales(S, P_(const float, WS_SSQ), 1.0f / 1024.0f, L);
            pg8::EpiGU E{ws, (const LAS float*)(L + RS_OFF)};
            for (int rep = 0; rep < NREP(5); ++rep) pg8::gemm_phase<pg8::EpiGU, pg8::StaticOrder, true, true>(L, g, S, E);
            if (layer == 0 && G == 256 && bx >= 128) convert_group(ap, ws, 1, 0, L, (bx - 128) * NWAVES + wave, 128 * NWAVES, wave, lane_o);
        }
        grid_bar(P + 5, L);
        if (ph_in(P + 6)) {
            ENV();
            pg8::Gemm g{P_(bf16, WS_H), P_(const bf16, WS_WDN), MTOK, DMODEL, FFH}; pg8::StaticOrder S; S.init(MTOK, DMODEL, G, bx);
            const bool ffin = layer == 1 && G == 256 && ph_in(15);
            pg8::EpiRes E{ws, 0, ffin ? 1 : 0, (const float*)ap->in[20], out};
            if (G == 256) for (int rep = 0; rep < NREP(6); ++rep) { E.dry = rep; pg8::gemm_phase<pg8::EpiRes, pg8::StaticOrder, false, true>(L, g, S, E); }
        }
        if (!(layer == 1 && gridDim.x == 256 && ph_in(P + 6))) grid_bar(P + 6, L);
    }
    if (ph_in(15) && !(gridDim.x == 256 && ph_in(14))) {
        for (int rep = NREP(8) - 1; rep >= 0; --rep) {
        ENV(); const float* fn = (const float*)ap->in[20]; const float* SSQ = P_(float, WS_SSQ);
        for (int m = gw; m < MTOK; m += 2 * NGW) {
            bf16x8 v[2][2]; f32x4 s4[2];
#pragma unroll
            for (int k = 0; k < 2; ++k) { const bf16* xr = P_(bf16, WS_XB) + (size_t)(m + k * NGW) * DMODEL + 8 * lane_o; s4[k] = *(const f32x4*)(SSQ + (size_t)(m + k * NGW) * 4);
                v[k][0] = *(const bf16x8*)xr; v[k][1] = *(const bf16x8*)(xr + 512); }
#pragma unroll
            for (int k = 0; k < 2; ++k) { float* orow = out + (size_t)(m + k * NGW) * DMODEL + 8 * lane_o;
                const float rs = 1.0f / sqrtf(((s4[k][0] + s4[k][1]) + (s4[k][2] + s4[k][3])) * (1.0f / 1024.0f) + NORM_EPS);
#pragma unroll
                for (int hh = 0; hh < 2; ++hh) { const f32x4 g0 = *(const f32x4*)(fn + hh * 512 + 8 * lane_o), g1 = *(const f32x4*)(fn + hh * 512 + 8 * lane_o + 4); const bf16x8 b = v[k][hh];
                    const f32x4 w0 = {at::bf2f(b[0]) * rs * g0[0], at::bf2f(b[1]) * rs * g0[1], at::bf2f(b[2]) * rs * g0[2], at::bf2f(b[3]) * rs * g0[3]}, w1 = {at::bf2f(b[4]) * rs * g1[0], at::bf2f(b[5]) * rs * g1[1], at::bf2f(b[6]) * rs * g1[2], at::bf2f(b[7]) * rs * g1[3]};
                    if (rep == 0) { *(f32x4*)(orow + hh * 512) = w0; *(f32x4*)(orow + hh * 512 + 4) = w1; } } }
        }
        }
    }
}

extern "C" void kernel_launch(void* const* d_in, const int* in_sizes, int n_in, void* d_out, int out_size, void* d_ws, size_t ws_size, hipStream_t stream) {
    static int grid = 0;
    if (grid == 0) {
        if (n_in != 21 || in_sizes[0] != MTOK * DMODEL || out_size != MTOK * DMODEL || ws_size < WS_END) { fprintf(stderr, "kernel_launch: unexpected shapes (n_in %d, in0 %d, out %d, ws %zu)\n", n_in, n_in > 0 ? in_sizes[0] : -1, out_size, ws_size); grid = -1; return; }
        int dev = 0, cus = 0, per_cu = 0;
        if (hipGetDevice(&dev) != hipSuccess || hipDeviceGetAttribute(&cus, hipDeviceAttributeMultiprocessorCount, dev) != hipSuccess) { grid = -1; return; }
        if (hipFuncSetAttribute((const void*)hyb_fwd, hipFuncAttributeMaxDynamicSharedMemorySize, LDS_BYTES) != hipSuccess) { fprintf(stderr, "kernel_launch: hipFuncSetAttribute failed\n"); grid = -1; return; }
        if (hipOccupancyMaxActiveBlocksPerMultiprocessor(&per_cu, (const void*)hyb_fwd, NWAVES * 64, LDS_BYTES) != hipSuccess) per_cu = 0;
        (void)hipGetLastError();
        if (per_cu < 1 || cus * per_cu < 256) { fprintf(stderr, "kernel_launch: %d CUs x %d resident workgroups cannot hold the 256-workgroup grid\n", cus, per_cu); grid = -1; return; }
        grid = 256;
    }
    if (grid < 0) return;
    (void)hipMemsetAsync((char*)d_ws + WS_CTL, 0, CTL_ZERO_BYTES, stream);
    Args a{};
    for (int i = 0; i < 21; ++i) a.in[i] = d_in[i];
    a.out = (float*)d_out; a.ws = (unsigned char*)d_ws;
    if (MK_N_LAUNCHES == 1) { a.ph_lo = 0; a.ph_hi = N_PHASES; hipLaunchKernelGGL(hyb_fwd, dim3(grid), dim3(NWAVES * 64), LDS_BYTES, stream, a); }
    else for (int p = 0; p < N_PHASES; ++p) { a.ph_lo = p; a.ph_hi = p + 1; hipLaunchKernelGGL(hyb_fwd, dim3(grid), dim3(NWAVES * 64), LDS_BYTES, stream, a); }
}
```

```cpp
#include <hip/hip_runtime.h>
#include <hip/hip_bf16.h>
#include <cstdio>
#include <cstdint>
#include <cmath>
namespace pg8 {
#define PG8_LAS __attribute__((address_space(3)))
typedef unsigned short bf16_t;
typedef short bf16x8 __attribute__((ext_vector_type(8)));
typedef float f32x4 __attribute__((ext_vector_type(4)));
typedef unsigned u32x4 __attribute__((ext_vector_type(4)));
constexpr int BM = 256, BK = 64, HALF = 128, HTB = HALF * BK * 2  , STAGE_BYTES = 8 * HTB, NXCD = 8, WGM = 8;

__host__ __device__ __forceinline__ int lds_byte(int r, int c) { const int st = (r >> 4) * 2 + (c >> 5), rr = r & 15, cc = c & 31, ob = rr * 64 + cc * 2; return st * 1024 + (ob ^ (((ob >> 9) & 1) << 5)); }
__host__ __device__ __forceinline__ void stage_rc(int b, int& R, int& C) { const int st = b / 1024, sb = b % 1024, swz = sb ^ (((sb >> 9) & 1) << 5); R = (st >> 1) * 16 + swz / 64; C = (st & 1) * 32 + (swz % 64) / 2; }
__host__ __device__ __forceinline__ int perm32(int rho) { const int n = rho >> 4, i = rho & 15; return 8 * (i >> 2) + 4 * n + (i & 3); }

struct Unit { int pm, pn, half, ord; };
struct Gemm { const bf16_t* A; const bf16_t* Bt; int M, N, K; };

struct StaticOrder {
    int nM, nN, nwg, G, c;
    __host__ __device__ void init(int M, int N, int G_, int c_) { nM = M / BM; nN = N / BM; nwg = nM * nN; G = G_; c = c_; }
    __host__ __device__ __attribute__((always_inline)) bool next(int i, Unit& u) const {
        const long L = (long)i * G + c; if (L >= nwg) return false;
        int wgid = (int)L; { const int q = nwg / NXCD, r = nwg % NXCD, xcd = wgid % NXCD, off = wgid / NXCD; wgid = (xcd < r ? xcd * (q + 1) : r * (q + 1) + (xcd - r) * q) + off; }
        const int nig = WGM * nN, gid = wgid / nig, fm = gid * WGM, gsz = (nM - fm) < WGM ? (nM - fm) : WGM;
        u.pm = fm + ((wgid % nig) % gsz); u.pn = (wgid % nig) / gsz; u.half = 0; u.ord = i; return true;
    }
    __device__ __forceinline__ void a_ready(const Unit&) const {}
    __device__ __forceinline__ void done(const Unit&) const {}
};
struct StaticOrderSplit {
    StaticOrder so; int nfull, rem, mode;
    __host__ __device__ void init(int M, int N, int G_, int c_, int mode_ = 0) { so.init(M, N, G_, c_); nfull = so.nwg / G_; rem = so.nwg % G_; mode = mode_; }
    __host__ __device__ __attribute__((always_inline)) bool next(int i, Unit& u) const {
        if (mode == 1 && i >= nfull) return false;
        if (mode == 2) { if (i > 0) return false; i = nfull; }
        if (i < nfull || 2 * rem != so.G) return so.next(i, u);
        if (i > nfull) return false;
        StaticOrder t = so; t.c = so.c >> 1; t.G = so.G; const long L = (long)nfull * so.G + (so.c >> 1); if (L >= so.nwg) return false;
        StaticOrder t2 = so; t2.c = (int)(L - (long)nfull * so.G);
        if (!t2.next(nfull, u)) return false; u.half = 1 + (so.c & 1); return true;
    }
    __device__ __forceinline__ void a_ready(const Unit&) const {}
    __device__ __forceinline__ void done(const Unit&) const {}
};

__device__ __forceinline__ unsigned cvt_pk_bf16(float lo, float hi) { unsigned r; asm volatile("v_cvt_pk_bf16_f32 %0, %1, %2" : "=v"(r) : "v"(lo), "v"(hi)); return r; }
typedef float f32x2 __attribute__((ext_vector_type(2)));
template <class Epi, class Sched, bool ALIGN_EPI = false, bool SP2 = false, bool HALF_OK = false>
__device__ __forceinline__ void gemm_phase(PG8_LAS unsigned char* lds, const Gemm g, const Sched& S, const Epi& E) {
    int tid_ = threadIdx.x; asm volatile("" : "+v"(tid_));
    const int tid = tid_, wid = __builtin_amdgcn_readfirstlane(tid >> 6), lane = tid & 63, wr = wid >> 2, wc = wid & 3, fr = lane & 15, fq = lane >> 4;
    const int K = g.K, nt = K / BK;
    unsigned voffA[2], voffB[2];
#pragma unroll
    for (int i = 0; i < 2; ++i) { int R, C; stage_rc(tid * 16 + i * 8192, R, C); const int Rb = Epi::PERM ? ((R & ~31) + perm32(R & 31)) : R;
        voffA[i] = (unsigned)(R * K + C) * 2u; voffB[i] = (unsigned)(Rb * K + C) * 2u; }
    const size_t kstep = (size_t)(BK * 2);
    const size_t hstep = (size_t)HALF * K * 2;
    const size_t tstep = 2 * hstep;
    const unsigned ldsw = (unsigned)wid * 1024u;
    const int aoff = lds_byte(wr * 64 + fr, fq * 8), boff = lds_byte(wc * 32 + fr, fq * 8);
#define PG8_SA(b, h) (((b) * 2 + (h)) * HTB)
#define PG8_SB(b, h) ((4 + (b) * 2 + (h)) * HTB)
#define PG8_STAGE(bufoff, gbase, voff) do { _Pragma("unroll") for (int _i = 0; _i < 2; ++_i) \
        __builtin_amdgcn_global_load_lds((const unsigned*)((const char*)(gbase) + (voff)[_i]), (PG8_LAS unsigned*)(lds + (bufoff) + ldsw + _i * 8192), 16, 0, 0); } while (0)
#define PG8_LDA(dst, b, h) do { _Pragma("unroll") for (int m = 0; m < 4; ++m) _Pragma("unroll") for (int k = 0; k < 2; ++k) dst[m][k] = *(const PG8_LAS bf16x8*)(lds + PG8_SA(b, h) + aoff + m * 2048 + k * 1024); } while (0)
#define PG8_LDB(dst, b, h) do { _Pragma("unroll") for (int n = 0; n < 2; ++n) _Pragma("unroll") for (int k = 0; k < 2; ++k) dst[n][k] = *(const PG8_LAS bf16x8*)(lds + PG8_SB(b, h) + boff + n * 2048 + k * 1024); } while (0)
#define PG8_MMA(ai, bj, At, Bt) do { if (HALF_OK && cur.half != 0 && cur.half != (ai) + 1) break; __builtin_amdgcn_s_setprio(1); _Pragma("unroll") for (int m = 0; m < 4; ++m) _Pragma("unroll") for (int n = 0; n < 2; ++n) _Pragma("unroll") for (int k = 0; k < 2; ++k) \
        acc[ai][bj][m][n] = __builtin_amdgcn_mfma_f32_16x16x32_bf16(Bt[n][k], At[m][k], acc[ai][bj][m][n], 0, 0, 0); __builtin_amdgcn_s_setprio(0); } while (0)
#define PG8_WAIT_V(n) asm volatile("s_waitcnt vmcnt(" #n ")" ::: "memory")
#define PG8_WAIT_L(n) asm volatile("s_waitcnt lgkmcnt(" #n ")" ::: "memory")
#define PG8_BAR __builtin_amdgcn_s_barrier()
#define PG8_SCHED __builtin_amdgcn_sched_barrier(0)
    Unit cur, nxt; int ui = 0;
    if (!S.next(0, cur)) return;
    f32x4 acc[2][2][4][2];
#pragma unroll
    for (int a = 0; a < 2; ++a)
#pragma unroll
        for (int b = 0; b < 2; ++b)
#pragma unroll
            for (int m = 0; m < 4; ++m)
#pragma unroll
                for (int n = 0; n < 2; ++n) acc[a][b][m][n] = (f32x4){0.f, 0.f, 0.f, 0.f};
    bf16x8 At[4][2], B0[2][2], B1[2][2];
    const char* cA = (const char*)g.A + (size_t)cur.pm * tstep; const char* cB = (const char*)g.Bt + (size_t)cur.pn * tstep;
    S.a_ready(cur);
    if constexpr (SP2) {
        PG8_STAGE(PG8_SB(0, 0), cB, voffB); PG8_STAGE(PG8_SB(0, 1), cB + hstep, voffB); PG8_STAGE(PG8_SA(0, 0), cA, voffA); PG8_STAGE(PG8_SA(0, 1), cA + hstep, voffA);
        if (wr == 1) PG8_BAR;
        PG8_WAIT_V(2); PG8_BAR;
        PG8_STAGE(PG8_SB(1, 0), cB + kstep, voffB); PG8_STAGE(PG8_SA(1, 0), cA + kstep, voffA); PG8_STAGE(PG8_SB(1, 1), cB + hstep + kstep, voffB);
        PG8_WAIT_V(6); PG8_BAR;
    } else {
        PG8_STAGE(PG8_SB(0, 0), cB, voffB); PG8_STAGE(PG8_SA(0, 0), cA, voffA); PG8_STAGE(PG8_SB(0, 1), cB + hstep, voffB); PG8_STAGE(PG8_SA(0, 1), cA + hstep, voffA);
        if (wr == 1) PG8_BAR;
        PG8_WAIT_V(4); PG8_BAR;
        PG8_STAGE(PG8_SB(1, 0), cB + kstep, voffB); PG8_STAGE(PG8_SA(1, 0), cA + kstep, voffA); PG8_STAGE(PG8_SB(1, 1), cB + hstep + kstep, voffB);
        PG8_WAIT_V(6); PG8_BAR;
    }
    for (;;) {
        const bool has_next = S.next(ui + 1, nxt);
        const char* nA = has_next ? (const char*)g.A + (size_t)nxt.pm * tstep : cA; const char* nB = has_next ? (const char*)g.Bt + (size_t)nxt.pn * tstep : cB;
        for (int t = 0; t < nt; t += 2) {
            const bool last = (t == nt - 2);
            const char* a1 = cA + (size_t)(t + 1) * kstep;
            const char* a2 = last ? nA : cA + (size_t)(t + 2) * kstep; const char* b2 = last ? nB : cB + (size_t)(t + 2) * kstep;
            const char* a3 = a2 + kstep; const char* b3 = b2 + kstep;
            if (last && has_next) S.a_ready(nxt);
            if constexpr (SP2) {
            PG8_LDB(B0, 0, 0); PG8_LDB(B1, 0, 1); PG8_SCHED; PG8_LDA(At, 0, 0); PG8_STAGE(PG8_SA(1, 1), a1 + hstep, voffA);
            PG8_WAIT_V(8); PG8_WAIT_L(0); PG8_BAR; PG8_MMA(0, 0, At, B0); PG8_MMA(0, 1, At, B1); PG8_BAR; PG8_SCHED;
            PG8_LDA(At, 0, 1); PG8_STAGE(PG8_SB(0, 0), b2, voffB); PG8_STAGE(PG8_SB(0, 1), b2 + hstep, voffB); PG8_STAGE(PG8_SA(0, 0), a2, voffA);
            PG8_WAIT_V(8); PG8_WAIT_L(0); PG8_BAR; PG8_MMA(1, 0, At, B0); PG8_MMA(1, 1, At, B1); PG8_BAR; PG8_SCHED;
            PG8_LDB(B0, 1, 0); PG8_LDB(B1, 1, 1); PG8_SCHED; PG8_LDA(At, 1, 0); PG8_STAGE(PG8_SA(0, 1), a2 + hstep, voffA);
            PG8_WAIT_V(8); PG8_WAIT_L(0); PG8_BAR; PG8_MMA(0, 0, At, B0); PG8_MMA(0, 1, At, B1); PG8_BAR; PG8_SCHED;
            PG8_LDA(At, 1, 1); PG8_STAGE(PG8_SB(1, 0), b3, voffB); PG8_STAGE(PG8_SB(1, 1), b3 + hstep, voffB); PG8_STAGE(PG8_SA(1, 0), a3, voffA);
            PG8_WAIT_V(8); PG8_WAIT_L(0); PG8_BAR; PG8_MMA(1, 0, At, B0); PG8_MMA(1, 1, At, B1); PG8_BAR; PG8_SCHED;
            } else {
            PG8_LDB(B0, 0, 0); PG8_SCHED; PG8_LDA(At, 0, 0); PG8_STAGE(PG8_SA(1, 1), a1 + hstep, voffA);
            PG8_WAIT_L(8); PG8_BAR; PG8_WAIT_L(0); PG8_MMA(0, 0, At, B0); PG8_BAR; PG8_SCHED;
            PG8_LDB(B1, 0, 1); PG8_STAGE(PG8_SB(0, 0), b2, voffB);
            PG8_BAR; PG8_WAIT_L(0); PG8_MMA(0, 1, At, B1); PG8_BAR;
            PG8_LDA(At, 0, 1); PG8_STAGE(PG8_SA(0, 0), a2, voffA);
            PG8_BAR; PG8_WAIT_L(0); PG8_MMA(1, 0, At, B0); PG8_BAR; PG8_SCHED;
            PG8_STAGE(PG8_SB(0, 1), b2 + hstep, voffB);
            PG8_WAIT_V(6); PG8_BAR; PG8_MMA(1, 1, At, B1); PG8_BAR;
            PG8_LDB(B0, 1, 0); PG8_SCHED; PG8_LDA(At, 1, 0); PG8_STAGE(PG8_SA(0, 1), a2 + hstep, voffA);
            PG8_WAIT_L(8); PG8_BAR; PG8_WAIT_L(0); PG8_MMA(0, 0, At, B0); PG8_BAR; PG8_SCHED;
            PG8_LDB(B1, 1, 1); PG8_STAGE(PG8_SB(1, 0), b3, voffB);
            PG8_BAR; PG8_WAIT_L(0); PG8_MMA(0, 1, At, B1); PG8_BAR;
            PG8_LDA(At, 1, 1); PG8_STAGE(PG8_SA(1, 0), a3, voffA);
            PG8_BAR; PG8_WAIT_L(0); PG8_MMA(1, 0, At, B0); PG8_BAR; PG8_SCHED;
            PG8_STAGE(PG8_SB(1, 1), b3 + hstep, voffB);
            PG8_WAIT_V(6); PG8_BAR; PG8_MMA(1, 1, At, B1); PG8_BAR;
            }
        }
        if constexpr (ALIGN_EPI) { if (wr == 0) PG8_BAR; }
        if constexpr (!Epi::AFTER_DRAIN) { E(acc, cur, wr, wc, fr, fq); S.done(cur); }
        if (!has_next) break;
#pragma unroll
        for (int a = 0; a < 2; ++a)
#pragma unroll
            for (int b = 0; b < 2; ++b)
#pragma unroll
                for (int m = 0; m < 4; ++m)
#pragma unroll
                    for (int n = 0; n < 2; ++n) acc[a][b][m][n] = (f32x4){0.f, 0.f, 0.f, 0.f};
        cur = nxt; cA = nA; cB = nB; ++ui;
        if constexpr (ALIGN_EPI) { if (wr == 1) PG8_BAR; }
    }
    PG8_WAIT_V(0);
    if constexpr (!ALIGN_EPI) { if (wr == 0) PG8_BAR; }
    PG8_BAR;
    if constexpr (Epi::AFTER_DRAIN) { E.fused(acc, cur, wr, wc, fr, fq, lds, wid, lane); S.done(cur); }
#undef PG8_SA
#undef PG8_SB
#undef PG8_STAGE
#undef PG8_LDA
#undef PG8_LDB
#undef PG8_MMA
#undef PG8_WAIT_V
#undef PG8_WAIT_L
#undef PG8_BAR
#undef PG8_SCHED
}
}

#ifndef PG8_SP2
#define PG8_SP2 true
#endif
#ifndef PG8_ALIGN
#define PG8_ALIGN true
#endif
#define GAS __attribute__((address_space(1)))
#define LAS __attribute__((address_space(3)))
typedef unsigned short bf16;
typedef unsigned v4u __attribute__((ext_vector_type(4)));
typedef float f32x4 __attribute__((ext_vector_type(4)));
typedef short bf16x8 __attribute__((ext_vector_type(8)));
typedef GAS unsigned gu32;
typedef GAS unsigned long long gu64;
#define RLX_AGENT __ATOMIC_RELAXED, __HIP_MEMORY_SCOPE_AGENT
#define LDS_WAIT() asm volatile("s_waitcnt lgkmcnt(0)" ::: "memory")
#define VM_WAIT() asm volatile("s_waitcnt vmcnt(0)" ::: "memory")
__device__ __forceinline__ unsigned long long rt() { return __builtin_amdgcn_s_memrealtime(); }
__device__ __forceinline__ unsigned f2bf(float f) { unsigned u = __builtin_bit_cast(unsigned, f); return (u + 0x7fffu + ((u >> 16) & 1u)) >> 16; }
__device__ __forceinline__ unsigned pk2(float lo, float hi) { return f2bf(lo) | (f2bf(hi) << 16); }

#define XB_TMO      128
#define XB_XCNT(j)  (256  + 64 * (j))
#define XB_XSUB(j)  (1280 + 64 * (j))
#define XB_XGEN(j)  (2304 + 64 * (j))
#define XB_TOP      3328
#define XB_TOPGEN   3392
#define XCD_BAR_WORDS 3456
#define XB_SPIN_CAP (1u << 18)

__device__ __forceinline__ unsigned xb_ld(unsigned* p)              { return __hip_atomic_load(p, __ATOMIC_RELAXED, __HIP_MEMORY_SCOPE_AGENT); }
__device__ __forceinline__ unsigned xb_add(unsigned* p, unsigned v) { return __hip_atomic_fetch_add(p, v, __ATOMIC_RELAXED, __HIP_MEMORY_SCOPE_AGENT); }
__device__ __forceinline__ unsigned xb_xcc_id() { return (unsigned)__builtin_amdgcn_s_getreg((3 << 11) | 20) & 0xFu; }
#define XB_SPIN(cond, bar) do { unsigned _sp = 0; while (cond) { __builtin_amdgcn_s_sleep(1); \
    if ((++_sp & 255u) == 0u) { if (xb_ld(&(bar)[XB_TMO])) break; if (_sp > XB_SPIN_CAP) { atomicAdd(&(bar)[XB_TMO], 1u); break; } } } } while (0)

struct XcdBarrier {
    unsigned* bar; unsigned x;
    volatile LAS unsigned* st;
};

__device__ __forceinline__ XcdBarrier xcd_barrier_post(unsigned* bar, volatile LAS unsigned* st) {
    XcdBarrier b; b.bar = bar; b.x = xb_xcc_id(); b.st = st;
    if (threadIdx.x == 0) (void)xb_add(&bar[XB_XCNT(b.x)], 1u);
    return b;
}
__device__ __forceinline__ void xcd_barrier_complete(unsigned* bar, unsigned x, unsigned& nloc, unsigned& nx, unsigned& xmask) {
    const unsigned G = gridDim.x * gridDim.y * gridDim.z;
    unsigned sum, cnt, mine, msk, sp = 0u;
    for (;;) {
        sum = 0u; cnt = 0u; mine = 0u; msk = 0u;
#pragma unroll
        for (unsigned j = 0; j < 16; ++j) { const unsigned c = xb_ld(&bar[XB_XCNT(j)]); sum += c; cnt += (c > 0u) ? 1u : 0u; msk |= (c > 0u) ? (1u << j) : 0u; mine = (j == x) ? c : mine; }
        if (sum == G) break;
        __builtin_amdgcn_s_sleep(1);
        if ((++sp & 255u) == 0u) { if (xb_ld(&bar[XB_TMO])) break; if (sp > XB_SPIN_CAP) { atomicAdd(&bar[XB_TMO], 1u); break; } }
    }
    nloc = mine > 0u ? mine : 1u; nx = cnt > 0u ? cnt : 1u; xmask = msk | (1u << x);
}

__device__ __forceinline__ void xcd_barrier(const XcdBarrier& b) {
    asm volatile("s_waitcnt vmcnt(0)" ::: "memory");
    __syncthreads();
    if (threadIdx.x == 0) {
        unsigned* bar = b.bar;
        __builtin_amdgcn_s_waitcnt(0);
        unsigned nloc = b.st[0], nx = b.st[1];
        if (nloc == 0u) { unsigned xm; xcd_barrier_complete(bar, b.x, nloc, nx, xm); b.st[0] = nloc; b.st[1] = nx; b.st[2] = xm; }
        const unsigned old = xb_add(&bar[XB_XSUB(b.x)], 1u);
        const unsigned gen = old / nloc;
        __builtin_amdgcn_fence(__ATOMIC_ACQUIRE, "agent");
        if (old + 1u == (gen + 1u) * nloc) {
            __builtin_amdgcn_fence(__ATOMIC_RELEASE, "agent");
            asm volatile("s_waitcnt vmcnt(0)" ::: "memory");
            const unsigned og = xb_add(&bar[XB_TOP], 1u);
            const unsigned tg = og / nx;
            if (og + 1u == (tg + 1u) * nx) {
                const unsigned xm = b.st[2];
#pragma unroll
                for (unsigned j = 0; j < 16; ++j) if ((xm >> j) & 1u) (void)xb_add(&bar[XB_XGEN(j)], 1u);
            } else XB_SPIN(xb_ld(&bar[XB_XGEN(b.x)]) == gen, bar);
            asm volatile("s_waitcnt vmcnt(0)" ::: "memory");
        } else {
            XB_SPIN(xb_ld(&bar[XB_XGEN(b.x)]) == gen, bar);
            asm volatile("s_waitcnt vmcnt(0)" ::: "memory");
        }
    }
    __syncthreads();
}
constexpr int BATCH = 2, SEQ = 8192, DMODEL = 1024, MTOK = BATCH * SEQ, DEPTH = 2;
constexpr int IN_COLS = 2976, NIN = 3072, FFH = 2816, NGU = 2 * FFH;
constexpr float NORM_EPS = 1e-6f;
constexpr float LOG2E = 1.4426950408889634f;
constexpr float C2_DIFF = 0.125f * LOG2E;
constexpr float C2_MLA = 0.10206207261596575f * LOG2E;


template <int K> __device__ __forceinline__ float shx(float v) {
    static_assert(K == 1 || K == 2 || K == 4 || K == 8 || K == 16, "xor distance");
    if constexpr (K == 1) return __builtin_bit_cast(float, __builtin_amdgcn_mov_dpp(__builtin_bit_cast(int, v), 0xB1, 0xF, 0xF, true));
    else if constexpr (K == 2) return __builtin_bit_cast(float, __builtin_amdgcn_mov_dpp(__builtin_bit_cast(int, v), 0x4E, 0xF, 0xF, true));
    else return __builtin_bit_cast(float, __builtin_amdgcn_ds_swizzle(__builtin_bit_cast(int, v), (K << 10) | 0x1F));
}
__device__ __forceinline__ float add_x32(float v) { auto rr = __builtin_amdgcn_permlane32_swap(__float_as_uint(v), __float_as_uint(v), false, false); return __uint_as_float(rr[0]) + __uint_as_float(rr[1]); }
constexpr size_t MiB = 1u << 20;
constexpr size_t WS_CTL = 0, CTL_ZERO_BYTES = 1 * MiB;
constexpr size_t WS_WIN = 1 * MiB, WS_WUQ = 7 * MiB, WS_WUKV = WS_WUQ + 256 * 1024, WS_WOUT = WS_WUKV + 256 * 1024, WS_WGU = WS_WOUT + 2 * MiB, WS_WDN = WS_WGU + 11 * MiB;
constexpr size_t WS_XB = 26 * MiB;
constexpr size_t WS_T64 = 58 * MiB, WS_TM = 62 * MiB;
constexpr size_t WS_QN = 68 * MiB;
constexpr size_t WS_AST = 64 * MiB;
constexpr size_t WS_SSQ = 72 * MiB, WS_CQS = WS_SSQ + 256 * 1024, WS_CKVS = WS_CQS + 256 * 1024;
constexpr size_t WS_A = 73 * MiB;
constexpr size_t WS_DQ = WS_A, WS_DK = WS_DQ + 16 * MiB, WS_DV = WS_DK + 16 * MiB, WS_CQ = WS_DV + 16 * MiB, WS_CKV = WS_CQ + 8 * MiB, WS_MQ = WS_CKV + 8 * MiB, WS_MK = WS_MQ + 12 * MiB,
                 WS_MV = WS_MK + 12 * MiB, WS_RQ = WS_MV + 8 * MiB, WS_RK = WS_RQ + 8 * MiB, WS_RV = WS_RK + 8 * MiB, WS_RG = WS_RV + 8 * MiB, WS_MIX = WS_RG + 8 * MiB, WS_END = WS_MIX + 32 * MiB;
constexpr size_t WS_H = WS_A;
static_assert(WS_WDN + (size_t)1024 * FFH * 2 <= WS_XB && WS_H + (size_t)MTOK * FFH * 2 <= WS_MV && WS_END <= 256 * MiB, "d_ws map");
constexpr int CW_TMO = 0, CW_BAR = 4096, CW_Q = 8192, CW_P = 16384, CW_KM = 49152  ;
constexpr int RING_BYTES = 131072, LDSCTL_OFF = RING_BYTES, MISC_OFF = LDSCTL_OFF + 320, RS_OFF = LDSCTL_OFF + 1024  , LDS_BYTES = 147456;
constexpr int NWAVES = 8;

template <bool RELEASE = true> __device__ __forceinline__ void panel_barrier(gu32* cnt, unsigned expected, gu32* tmo);
namespace pg8 {
typedef float f32x2v __attribute__((ext_vector_type(2)));
__device__ __forceinline__ u32x4 pack8(const f32x4 a, const f32x4 b) { u32x4 w; w.x = cvt_pk_bf16(a[0], a[1]); w.y = cvt_pk_bf16(a[2], a[3]); w.z = cvt_pk_bf16(b[0], b[1]); w.w = cvt_pk_bf16(b[2], b[3]); return w; }
#ifdef WT_STORES
__device__ __forceinline__ void st16(void* p, const u32x4 v) { asm volatile("global_store_dwordx4 %0, %1, off sc1\n\ts_nop 1" :: "v"(p), "v"(v) : "memory"); }
#else
__device__ __forceinline__ void st16(void* p, const u32x4 v) { *(u32x4*)p = v; }
#endif
__device__ __forceinline__ float rstd4(const float* p, float inv_n, float eps) { const f32x4 s = *(const f32x4*)p; return 1.0f / sqrtf(((s[0] + s[1]) + (s[2] + s[3])) * inv_n + eps); }
__device__ __forceinline__ float sumsq4(const f32x4 v) { return (v[0] * v[0] + v[1] * v[1]) + (v[2] * v[2] + v[3] * v[3]); }
__device__ __forceinline__ f32x4 silu4(const f32x4 v) { f32x4 r;
#pragma unroll
    for (int i = 0; i < 4; ++i) r[i] = v[i] * __builtin_amdgcn_rcpf(1.0f + __builtin_amdgcn_exp2f(-v[i] * 1.4426950408889634f)); return r; }

__device__ __forceinline__ void rstd8(float (&rs)[2][4], const float* p, int row0, float inv_n, float eps) {
    f32x4 s[2][4];
#pragma unroll
    for (int ai = 0; ai < 2; ++ai)
#pragma unroll
        for (int m = 0; m < 4; ++m) s[ai][m] = *(const f32x4*)(p + (size_t)(row0 + ai * HALF + m * 16) * 4);
#pragma unroll
    for (int ai = 0; ai < 2; ++ai)
#pragma unroll
        for (int m = 0; m < 4; ++m) rs[ai][m] = 1.0f / sqrtf(((s[ai][m][0] + s[ai][m][1]) + (s[ai][m][2] + s[ai][m][3])) * inv_n + eps);
}
struct EpiG1 {
    static constexpr bool PERM = true, AFTER_DRAIN = false;
    unsigned char* ws;
    int layer;
    const PG8_LAS float* rs_tab;
    __device__ __forceinline__ void scales(float (&rsv)[4], const PG8_LAS float* tab, int lrow0) const {
#pragma unroll
        for (int m = 0; m < 4; ++m) rsv[m] = tab[lrow0 + m * 16];
    }
    __device__ __forceinline__ void operator()(const f32x4 (&acc)[2][2][4][2], const Unit& u, int wr, int wc, int fr, int fq) const {
        { int t_ = threadIdx.x; asm volatile("" : "+v"(t_)); fr = t_ & 15; fq = (t_ >> 4) & 3; }
        const int pn = u.pn; const PG8_LAS float* tab = rs_tab + u.ord * 256;
        if (pn < 4 || pn == 8 || pn == 9) {
            const float* t64 = (const float*)(ws + WS_T64);
            const float sc = pn < 2 ? C2_DIFF : (pn == 9 ? 0.125f : 1.0f);
            bf16_t* dbase; int ld; if (pn < 2) { dbase = (bf16_t*)(ws + WS_DQ) + 256 * pn; ld = 512; } else if (pn < 4) { dbase = (bf16_t*)(ws + WS_DK) + 256 * (pn - 2); ld = 512; } else { dbase = (bf16_t*)(ws + (pn == 8 ? WS_RQ : WS_RK)); ld = 256; }
            dbase += 64 * wc + 8 * fq;
            float kmx = 0.f;
#pragma unroll
            for (int ai = 0; ai < 2; ++ai) {
                const int row0 = u.pm * BM + ai * HALF + wr * 64 + fr; float rsv[4]; scales(rsv, tab, ai * HALF + wr * 64 + fr);
#pragma unroll
                for (int mp = 0; mp < 2; ++mp) {
                    f32x4 tc[2][4];
#pragma unroll
                    for (int k = 0; k < 2; ++k) { const float* tr = t64 + (size_t)(row0 + (2 * mp + k) * 16) * 64 + 8 * fq;
                        tc[k][0] = *(const f32x4*)tr; tc[k][1] = *(const f32x4*)(tr + 4); tc[k][2] = *(const f32x4*)(tr + 32); tc[k][3] = *(const f32x4*)(tr + 36); }
                    asm volatile("" ::: "memory");
#pragma unroll
                    for (int k = 0; k < 2; ++k) { const int m = 2 * mp + k; const float rs = rsv[m];
                        const f32x4 l0 = acc[ai][0][m][0] * rs, l1 = acc[ai][0][m][1] * rs, h0 = acc[ai][1][m][0] * rs, h1 = acc[ai][1][m][1] * rs;
                        const f32x4 c0 = tc[k][0], c1 = tc[k][1], s0 = tc[k][2], s1 = tc[k][3];
                        const f32x4 ol0 = (l0 * c0 - h0 * s0) * sc, ol1 = (l1 * c1 - h1 * s1) * sc, oh0 = (h0 * c0 + l0 * s0) * sc, oh1 = (h1 * c1 + l1 * s1) * sc;
                        bf16_t* dst = dbase + (size_t)(row0 + m * 16) * ld;
                        st16(dst, pack8(ol0, ol1)); st16(dst + 32, pack8(oh0, oh1));
                        if (pn < 4) {
                            float s = (sumsq4(ol0) + sumsq4(ol1)) + (sumsq4(oh0) + sumsq4(oh1)); s += shx<16>(s); s = add_x32(s);
                            kmx = fmaxf(kmx, s); } }
                }
            }
            if (pn < 4) { kmx = fmaxf(kmx, shx<1>(kmx)); kmx = fmaxf(kmx, shx<2>(kmx)); kmx = fmaxf(kmx, shx<4>(kmx)); kmx = fmaxf(kmx, shx<8>(kmx));
                if (fr == 0 && fq == 0) (void)__hip_atomic_fetch_max((int*)(ws + WS_CTL) + CW_KM + (pn < 2 ? 256 + layer * 1024 + u.pm * 8 + 4 * pn + wc : layer * 64 + (u.pm >> 5) * 8 + 4 * (pn - 2) + wc), __float_as_int(sqrtf(kmx)), __ATOMIC_RELAXED, __HIP_MEMORY_SCOPE_AGENT); }
        } else if (pn == 4 || pn == 5 || pn == 10 || pn == 11) {
            bf16_t* dbase; int ld; if (pn < 6) { dbase = (bf16_t*)(ws + WS_DV) + 256 * (pn - 4); ld = 512; } else { dbase = (bf16_t*)(ws + (pn == 10 ? WS_RV : WS_RG)); ld = 256; }
            dbase += 32 * wc + 8 * fq;
#pragma unroll
            for (int ai = 0; ai < 2; ++ai) {
                const int row0 = u.pm * BM + ai * HALF + wr * 64 + fr; float rsv[4]; scales(rsv, tab, ai * HALF + wr * 64 + fr);
#pragma unroll
                for (int m = 0; m < 4; ++m) { const float rs = rsv[m];
                    f32x4 l0 = acc[ai][0][m][0] * rs, l1 = acc[ai][0][m][1] * rs, h0 = acc[ai][1][m][0] * rs, h1 = acc[ai][1][m][1] * rs;
                    if (pn == 11) { l0 = silu4(l0); l1 = silu4(l1); h0 = silu4(h0); h1 = silu4(h1); }
                    bf16_t* dst = dbase + (size_t)(row0 + m * 16) * ld;
                    st16(dst, pack8(l0, l1)); st16(dst + HALF, pack8(h0, h1)); }
            }
        } else if (pn == 6) {
            bf16_t* dbase = (bf16_t*)(ws + WS_CQ) + 32 * wc + 8 * fq; float* CQS = (float*)(ws + WS_CQS);
#pragma unroll
            for (int ai = 0; ai < 2; ++ai) {
                const int row0 = u.pm * BM + ai * HALF + wr * 64 + fr; float rsv[4]; scales(rsv, tab, ai * HALF + wr * 64 + fr);
#pragma unroll
                for (int m = 0; m < 4; ++m) { const float rs = rsv[m]; const int row = row0 + m * 16;
                    const f32x4 l0 = acc[ai][0][m][0] * rs, l1 = acc[ai][0][m][1] * rs, h0 = acc[ai][1][m][0] * rs, h1 = acc[ai][1][m][1] * rs;
                    bf16_t* dst = dbase + (size_t)row * 256;
                    st16(dst, pack8(l0, l1)); st16(dst + HALF, pack8(h0, h1));
                    float s = (sumsq4(l0) + sumsq4(l1)) + (sumsq4(h0) + sumsq4(h1));
                    s += shx<16>(s); s = add_x32(s);
                    if (fq == 0) CQS[(size_t)row * 4 + wc] = s; }
            }
        } else {
            bf16_t* dbase = (bf16_t*)(ws + WS_CKV) + 32 * wc + 8 * fq; float* CKVS = (float*)(ws + WS_CKVS); const float* tm = (const float*)(ws + WS_TM); bf16_t* MK = (bf16_t*)(ws + WS_MK);
            const bool kr = (wc == 0) && (fq < 2);
#pragma unroll
            for (int ai = 0; ai < 2; ++ai) {
                const int row0 = u.pm * BM + ai * HALF + wr * 64 + fr; float rsv[4]; scales(rsv, tab, ai * HALF + wr * 64 + fr);
#pragma unroll
                for (int m = 0; m < 4; ++m) { const float rs = rsv[m]; const int row = row0 + m * 16;
                    const f32x4 l0 = acc[ai][0][m][0] * rs, l1 = acc[ai][0][m][1] * rs, h0 = acc[ai][1][m][0] * rs, h1 = acc[ai][1][m][1] * rs;
                    bf16_t* dst = dbase + (size_t)row * 256;
                    st16(dst, pack8(l0, l1)); st16(dst + HALF, pack8(h0, h1));
                    float s = kr ? 0.f : (sumsq4(l0) + sumsq4(l1)) + (sumsq4(h0) + sumsq4(h1));
                    s += shx<16>(s); s = add_x32(s);
                    if (fq == 0) CKVS[(size_t)row * 4 + wc] = s;
                    if (kr) {
                        const float* tr = tm + (size_t)row * 32 + 8 * fq;
                        const f32x4 c0 = *(const f32x4*)tr, c1 = *(const f32x4*)(tr + 4), s0 = *(const f32x4*)(tr + 16), s1 = *(const f32x4*)(tr + 20);
                        const u32x4 olo = pack8(l0 * c0 - h0 * s0, l1 * c1 - h1 * s1), ohi = pack8(h0 * c0 + l0 * s0, h1 * c1 + l1 * s1);
                        bf16_t* kd = MK + (size_t)row * 384 + 64 + 8 * fq;
#pragma unroll
                        for (int hh = 0; hh < 4; ++hh) { st16(kd + hh * 96, olo); st16(kd + hh * 96 + 16, ohi); }
                    } }
            }
        }
    }
};

struct EpiMQ {
    static constexpr bool PERM = true, AFTER_DRAIN = false;
    unsigned char* ws;
    __device__ __forceinline__ void operator()(const f32x4 (&acc)[2][2][4][2], const Unit& u, int wr, int wc, int fr, int fq) const {
        { int t_ = threadIdx.x; asm volatile("" : "+v"(t_)); fr = t_ & 15; fq = (t_ >> 4) & 3; }
        const int head = 2 * u.pn + (wc >> 1);
        const float* cqs = (const float*)(ws + WS_CQS); const float* tm = (const float*)(ws + WS_TM); bf16_t* MQ = (bf16_t*)(ws + WS_MQ);
        float rsv[2][4]; rstd8(rsv, cqs, u.pm * BM + wr * 64 + fr, 1.0f / 256.0f, NORM_EPS);
#pragma unroll
        for (int ai = 0; ai < 2; ++ai)
#pragma unroll
            for (int m = 0; m < 4; ++m) {
                const int row = u.pm * BM + ai * HALF + wr * 64 + m * 16 + fr;
                const float rs = rsv[ai][m] * C2_MLA;
                const f32x4 l0 = acc[ai][0][m][0] * rs, l1 = acc[ai][0][m][1] * rs, h0 = acc[ai][1][m][0] * rs, h1 = acc[ai][1][m][1] * rs;
                bf16_t* dst = MQ + (size_t)row * 384 + head * 96;
                if ((wc & 1) == 0) { st16(dst + 8 * fq, pack8(l0, l1)); st16(dst + 32 + 8 * fq, pack8(h0, h1)); }
                else if (fq < 2) {
                    const float* tr = tm + (size_t)row * 32 + 8 * fq;
                    const f32x4 c0 = *(const f32x4*)tr, c1 = *(const f32x4*)(tr + 4), s0 = *(const f32x4*)(tr + 16), s1 = *(const f32x4*)(tr + 20);
                    st16(dst + 64 + 8 * fq, pack8(l0 * c0 - h0 * s0, l1 * c1 - h1 * s1)); st16(dst + 80 + 8 * fq, pack8(h0 * c0 + l0 * s0, h1 * c1 + l1 * s1));
                }
            }
    }
};
struct EpiMKV {
    static constexpr bool PERM = true, AFTER_DRAIN = false;
    unsigned char* ws;
    __device__ __forceinline__ void operator()(const f32x4 (&acc)[2][2][4][2], const Unit& u, int wr, int wc, int fr, int fq) const {
        { int t_ = threadIdx.x; asm volatile("" : "+v"(t_)); fr = t_ & 15; fq = (t_ >> 4) & 3; }
        const int head = 2 * u.pn + (wc >> 1);
        const float* ckvs = (const float*)(ws + WS_CKVS); bf16_t* MK = (bf16_t*)(ws + WS_MK); bf16_t* MV = (bf16_t*)(ws + WS_MV);
        float rsv[2][4]; rstd8(rsv, ckvs, u.pm * BM + wr * 64 + fr, 1.0f / 128.0f, NORM_EPS);
#pragma unroll
        for (int ai = 0; ai < 2; ++ai)
#pragma unroll
            for (int m = 0; m < 4; ++m) {
                const int row = u.pm * BM + ai * HALF + wr * 64 + m * 16 + fr;
                const float rs = rsv[ai][m];
                const f32x4 l0 = acc[ai][0][m][0] * rs, l1 = acc[ai][0][m][1] * rs, h0 = acc[ai][1][m][0] * rs, h1 = acc[ai][1][m][1] * rs;
                bf16_t* dst = (wc & 1) ? MV + (size_t)row * 256 + head * 64 : MK + (size_t)row * 384 + head * 96;
                st16(dst + 8 * fq, pack8(l0, l1)); st16(dst + 32 + 8 * fq, pack8(h0, h1));
            }
    }
};

struct EpiGU {
    static constexpr bool PERM = true, AFTER_DRAIN = false;
    unsigned char* ws; const PG8_LAS float* rs_tab;
    __device__ __forceinline__ void operator()(const f32x4 (&acc)[2][2][4][2], const Unit& u, int wr, int wc, int fr, int fq) const {
        { int t_ = threadIdx.x; asm volatile("" : "+v"(t_)); fr = t_ & 15; fq = (t_ >> 4) & 3; }
        bf16_t* H = (bf16_t*)(ws + WS_H);
        float rsv[2][4];
#pragma unroll
        for (int ai = 0; ai < 2; ++ai)
#pragma unroll
            for (int m = 0; m < 4; ++m) rsv[ai][m] = rs_tab[u.ord * 256 + ai * HALF + wr * 64 + m * 16 + fr];
#pragma unroll
        for (int ai = 0; ai < 2; ++ai)
#pragma unroll
            for (int m = 0; m < 4; ++m) {
                if (u.half != 0 && u.half != ai + 1) continue;
                const int row = u.pm * BM + ai * HALF + wr * 64 + m * 16 + fr;
                const float rs = rsv[ai][m];
                const f32x4 g0 = acc[ai][0][m][0] * rs, g1 = acc[ai][0][m][1] * rs, u0 = acc[ai][1][m][0] * rs, u1 = acc[ai][1][m][1] * rs;
                st16(H + (size_t)row * FFH + u.pn * HALF + 32 * wc + 8 * fq, pack8(silu4(g0) * u0, silu4(g1) * u1));
            }
    }
};

struct EpiRes {
    static constexpr bool PERM = true, AFTER_DRAIN = true;
    unsigned char* ws; int dry;
    int fin; const float* fnw; float* outp;
    __device__ __forceinline__ void fused(f32x4 (&acc)[2][2][4][2], const Unit& u, int wr, int wc, int fr, int fq, PG8_LAS unsigned char* lds, int wid, int lane) const {
        { int t_ = threadIdx.x; asm volatile("" : "+v"(t_)); fr = t_ & 15; fq = (t_ >> 4) & 3; }
        PG8_LAS float* P = (PG8_LAS float*)lds;
        bf16_t* xb = (bf16_t*)(ws + WS_XB); float* ssq = (float*)(ws + WS_SSQ);
        const int col0 = u.pn * BM + wc * 32 + 8 * fq;
        u32x4 xi[2][2];
#define ER_LOAD(k) do { const size_t off_ = (size_t)(u.pm * BM + ((k) >> 2) * HALF + wr * 64 + ((k) & 3) * 16 + fr) * DMODEL + col0; \
        _Pragma("unroll") for (int q_ = 0; q_ < 2; ++q_) xi[(k) & 1][q_] = *(const u32x4*)(xb + off_ + q_ * HALF); } while (0)
        ER_LOAD(0);
#pragma unroll
        for (int k = 0; k < 8; ++k) { const int ai = k >> 2, m = k & 3, r = ai * HALF + wr * 64 + m * 16 + fr; const size_t off = (size_t)(u.pm * BM + r) * DMODEL + col0; float s = 0.f;
            if (k < 7) ER_LOAD(k + 1);
            asm volatile("" ::: "memory");
#pragma unroll
            for (int bj = 0; bj < 2; ++bj) { const u32x4 x4 = xi[k & 1][bj];
                const f32x4 xv0 = {__uint_as_float(x4.x << 16), __uint_as_float(x4.x & 0xffff0000u), __uint_as_float(x4.y << 16), __uint_as_float(x4.y & 0xffff0000u)};
                const f32x4 xv1 = {__uint_as_float(x4.z << 16), __uint_as_float(x4.z & 0xffff0000u), __uint_as_float(x4.w << 16), __uint_as_float(x4.w & 0xffff0000u)};
                const f32x4 v0 = xv0 + acc[ai][bj][m][0], v1 = xv1 + acc[ai][bj][m][1];
                if (fin) { acc[ai][bj][m][0] = v0; acc[ai][bj][m][1] = v1; }
                else { u32x4 w; w.x = cvt_pk_bf16(v0[0], v0[1]); w.y = cvt_pk_bf16(v0[2], v0[3]); w.z = cvt_pk_bf16(v1[0], v1[1]); w.w = cvt_pk_bf16(v1[2], v1[3]); if (!dry) *(u32x4*)(xb + off + bj * HALF) = w; }
                s += sumsq4(v0) + sumsq4(v1); }
            s += shx<16>(s); s = add_x32(s);
            if (fq == 0) P[r * 4 + wc] = s;
            asm volatile("" ::: "memory"); }
#undef ER_LOAD
        asm volatile("s_waitcnt lgkmcnt(0)" ::: "memory"); __builtin_amdgcn_s_barrier(); asm volatile("" ::: "memory");
        const int t = wid * 64 + lane;
        if (t < 256 && !dry) { const PG8_LAS f32x4* P4 = (const PG8_LAS f32x4*)lds; const f32x4 p = P4[t]; const float tot = (p[0] + p[1]) + (p[2] + p[3]);
            if (fin) __hip_atomic_store(ssq + (size_t)(u.pm * BM + t) * 4 + u.pn, tot, __ATOMIC_RELAXED, __HIP_MEMORY_SCOPE_AGENT);
            else ssq[(size_t)(u.pm * BM + t) * 4 + u.pn] = tot; }
        asm volatile("s_waitcnt lgkmcnt(0)" ::: "memory"); __builtin_amdgcn_s_barrier(); asm volatile("" ::: "memory");
        if (fin) {
            panel_barrier<false>((gu32*)(ws + WS_CTL) + CW_P + (2 * 64 + u.pm) * 64, 4u, (gu32*)(ws + WS_CTL) + CW_TMO);
            f32x4 ps[8];
#pragma unroll
            for (int k = 0; k < 8; ++k) { const int r = (k >> 2) * HALF + wr * 64 + (k & 3) * 16 + fr; ps[k] = *(const f32x4*)(ssq + (size_t)(u.pm * BM + r) * 4); }
            f32x4 gv[2][2];
#pragma unroll
            for (int bj = 0; bj < 2; ++bj)
#pragma unroll
                for (int n = 0; n < 2; ++n) gv[bj][n] = *(const f32x4*)(fnw + col0 + bj * HALF + n * 4);
#pragma unroll
            for (int k = 0; k < 8; ++k) { const int ai = k >> 2, m = k & 3, r = ai * HALF + wr * 64 + m * 16 + fr; const size_t off = (size_t)(u.pm * BM + r) * DMODEL + col0;
                const float rs = 1.0f / sqrtf(((ps[k][0] + ps[k][1]) + (ps[k][2] + ps[k][3])) * (1.0f / 1024.0f) + NORM_EPS);
#pragma unroll
                for (int bj = 0; bj < 2; ++bj)
#pragma unroll
                    for (int n = 0; n < 2; ++n) { const f32x4 o4 = acc[ai][bj][m][n] * rs * gv[bj][n]; if (!dry) *(f32x4*)(outp + off + bj * HALF + n * 4) = o4; } }
        }
    }
};
}
namespace at {
using bf16 = unsigned short;
using bf16x8 = __attribute__((ext_vector_type(8))) short;
using s16x4 = __attribute__((ext_vector_type(4))) short;
using f32x16 = __attribute__((ext_vector_type(16))) float;
using f32x4 = __attribute__((ext_vector_type(4))) float;
using u32x4 = __attribute__((ext_vector_type(4))) unsigned;
#define SBAR() __builtin_amdgcn_sched_barrier(0)
constexpr float THR2 = 8.f;
__device__ __forceinline__ int crow(int r, int hi) { return (r & 3) + 8 * (r >> 2) + 4 * hi; }
__device__ __forceinline__ unsigned cvtpk(float lo, float hi) { unsigned r; asm volatile("v_cvt_pk_bf16_f32 %0, %1, %2" : "=v"(r) : "v"(lo), "v"(hi)); return r; }
__device__ __forceinline__ float bf2f(short b) { return __uint_as_float(((unsigned)(unsigned short)b) << 16); }
template <int NB> __device__ __forceinline__ int v_st(int k, int c) { const int kk = (k & ~0xC) | ((k & 4) << 1) | ((k & 8) >> 1); return ((kk >> 3) * NB + (c >> 5)) * 512 + ((kk & 7) * 32 + (c & 31)) * 2; }
__device__ __forceinline__ int v_rd_base(int lane) { return ((lane & 3) << 3) | (((lane >> 2) & 3) << 6) | (((lane >> 4) & 1) << 5) | (((lane >> 5) & 1) << 8); }
template <int NB> constexpr int v_rd_off(int d0, int ks, int half) { return d0 * 512 + ks * (2 * NB * 512) + half * (NB * 512); }
template <int KRS> __device__ __forceinline__ int k_swz(int row) { return KRS == 128 ? (((row >> 1) & 7) << 4) : ((row & 7) << 4); }
template <int KRS> __device__ __forceinline__ int k_addr(int row, int chunk) { return row * KRS + ((chunk * 16) ^ k_swz<KRS>(row)); }

__device__ __forceinline__ void mask_tile(f32x16& p0, f32x16& p1, int dq) {
    const float NEG = -__builtin_inff();
#pragma unroll
    for (int r = 0; r < 16; ++r) { const int c = (r & 3) + 8 * (r >> 2); if (dq - c < 0) p0[r] = NEG; if (dq - c - 32 < 0) p1[r] = NEG; }
}
__device__ __forceinline__ void partialSM(f32x16& p0, f32x16& p1, float& m_reg, float& alpha) {
    float pmax = p0[0];
#pragma unroll
    for (int r = 1; r < 16; ++r) pmax = fmaxf(pmax, p0[r]);
#pragma unroll
    for (int r = 0; r < 16; ++r) pmax = fmaxf(pmax, p1[r]);
    { auto rr = __builtin_amdgcn_permlane32_swap(__float_as_uint(pmax), __float_as_uint(pmax), false, false); pmax = fmaxf(__uint_as_float(rr[0]), __uint_as_float(rr[1])); }
    float mn;
    if (__builtin_expect(__all(pmax - m_reg <= THR2), 1)) { mn = m_reg; alpha = 1.f; }
    else { mn = fmaxf(m_reg, pmax); alpha = __builtin_amdgcn_exp2f(m_reg - mn); m_reg = mn; }
#pragma unroll
    for (int r = 0; r < 16; ++r) { p0[r] -= mn; p1[r] -= mn; }
#pragma unroll
    for (int r = 0; r < 16; ++r) p0[r] = __builtin_amdgcn_exp2f(p0[r]);
}
#define AT_PK4(P, B_, OUT) do { unsigned a0 = cvtpk(P[B_ + 0], P[B_ + 1]), a1 = cvtpk(P[B_ + 2], P[B_ + 3]); unsigned b0 = cvtpk(P[B_ + 4], P[B_ + 5]), b1 = cvtpk(P[B_ + 6], P[B_ + 7]); \
        auto r0 = __builtin_amdgcn_permlane32_swap(a0, b0, false, false); auto r1 = __builtin_amdgcn_permlane32_swap(a1, b1, false, false); \
        u32x4 w = {r0[0], r1[0], r0[1], r1[1]}; OUT = *reinterpret_cast<bf16x8*>(&w); } while (0)
__device__ __forceinline__ void pack_p(const f32x16& p0, const f32x16& p1, bf16x8& pa0, bf16x8& pa1, bf16x8& pa2, bf16x8& pa3) { AT_PK4(p0, 0, pa0); AT_PK4(p0, 8, pa1); AT_PK4(p1, 0, pa2); AT_PK4(p1, 8, pa3); }
__device__ __forceinline__ void finishSM(f32x16& p0, f32x16& p1, float alpha, float& l_reg, bf16x8& pa0, bf16x8& pa1, bf16x8& pa2, bf16x8& pa3) {
#pragma unroll
    for (int r = 0; r < 16; ++r) p1[r] = __builtin_amdgcn_exp2f(p1[r]);
    float ps = 0;
#pragma unroll
    for (int r = 0; r < 16; ++r) ps += p0[r];
#pragma unroll
    for (int r = 0; r < 16; ++r) ps += p1[r];
    { auto rr = __builtin_amdgcn_permlane32_swap(__float_as_uint(ps), __float_as_uint(ps), false, false); ps = __uint_as_float(rr[0]) + __uint_as_float(rr[1]); }
    l_reg = l_reg * alpha + ps;
    pack_p(p0, p1, pa0, pa1, pa2, pa3);
}
template <int DQK, int KRS> __device__ __forceinline__ void qkt(f32x16& p0, f32x16& p1, const char* Kimg, int r32, int hi, const bf16x8* qr) {
    p0 = f32x16{}; p1 = f32x16{};
    const char* kb[4];
#pragma unroll
    for (int dd = 0; dd < 4; ++dd) kb[dd] = Kimg + k_addr<KRS>(r32, 2 * dd + hi);
#pragma unroll
    for (int d0 = 0; d0 < DQK / 16; ++d0) { const char* a = kb[d0 & 3] + (d0 >> 2) * 128;
        const bf16x8 b0 = *reinterpret_cast<const bf16x8*>(a), b1 = *reinterpret_cast<const bf16x8*>(a + 32 * KRS);
        p0 = __builtin_amdgcn_mfma_f32_32x32x16_bf16(b0, qr[d0], p0, 0, 0, 0);
        p1 = __builtin_amdgcn_mfma_f32_32x32x16_bf16(b1, qr[d0], p1, 0, 0, 0); }
}
struct VFr { s16x4 l0, l1, l2, l3, h0, h1, h2, h3; };
#define AT_TRRD(dst, off) asm volatile("ds_read_b64_tr_b16 %0, %1 offset:%2" : "=&v"(dst) : "v"(vb), "i"(off) : "memory")
template <int NB, int D0> __device__ __forceinline__ void v_reads(VFr& f, int vb) {
    AT_TRRD(f.l0, (v_rd_off<NB>(D0, 0, 0))); AT_TRRD(f.h0, (v_rd_off<NB>(D0, 0, 1))); AT_TRRD(f.l1, (v_rd_off<NB>(D0, 1, 0))); AT_TRRD(f.h1, (v_rd_off<NB>(D0, 1, 1)));
    AT_TRRD(f.l2, (v_rd_off<NB>(D0, 2, 0))); AT_TRRD(f.h2, (v_rd_off<NB>(D0, 2, 1))); AT_TRRD(f.l3, (v_rd_off<NB>(D0, 3, 0))); AT_TRRD(f.h3, (v_rd_off<NB>(D0, 3, 1)));
}
#undef AT_TRRD
#define AT_PK(L, H) (bf16x8){L[0], L[1], L[2], L[3], H[0], H[1], H[2], H[3]}
__device__ __forceinline__ void pv_mma(f32x16& od, const VFr& f, bf16x8 pa0, bf16x8 pa1, bf16x8 pa2, bf16x8 pa3) {
    od = __builtin_amdgcn_mfma_f32_32x32x16_bf16(pa0, AT_PK(f.l0, f.h0), od, 0, 0, 0);
    od = __builtin_amdgcn_mfma_f32_32x32x16_bf16(pa1, AT_PK(f.l1, f.h1), od, 0, 0, 0);
    od = __builtin_amdgcn_mfma_f32_32x32x16_bf16(pa2, AT_PK(f.l2, f.h2), od, 0, 0, 0);
    od = __builtin_amdgcn_mfma_f32_32x32x16_bf16(pa3, AT_PK(f.l3, f.h3), od, 0, 0, 0);
}
#undef AT_PK
#define AT_LW(n) asm volatile("s_waitcnt lgkmcnt(" #n ")" ::: "memory")
template <int NB> __device__ __forceinline__ void pv_all(f32x16* o, int vb, bf16x8 pa0, bf16x8 pa1, bf16x8 pa2, bf16x8 pa3) {
    VFr fa, fb;
    v_reads<NB, 0>(fa, vb); v_reads<NB, 1>(fb, vb);
    AT_LW(8); SBAR(); pv_mma(o[0], fa, pa0, pa1, pa2, pa3); SBAR();
    if constexpr (NB == 4) {
        v_reads<NB, 2>(fa, vb); AT_LW(8); SBAR(); pv_mma(o[1], fb, pa0, pa1, pa2, pa3); SBAR();
        v_reads<NB, 3>(fb, vb); AT_LW(8); SBAR(); pv_mma(o[2], fa, pa0, pa1, pa2, pa3); SBAR();
        AT_LW(0); SBAR(); pv_mma(o[3], fb, pa0, pa1, pa2, pa3);
    } else { AT_LW(0); SBAR(); pv_mma(o[1], fb, pa0, pa1, pa2, pa3); }
}
#undef AT_LW

template <int DQK, int DV, int LDQ, int LDK, int LDV, int LDO>
__device__ __forceinline__ void attn_unit(const bf16* __restrict__ Qb, const bf16* __restrict__ Kh, const bf16* __restrict__ Vh, bf16* __restrict__ Ob, int qb, char* lds, int kvmul = 1) {
    constexpr int KRS = DQK == 64 ? 128 : 256, KB = 64 * KRS, NB = DV / 32, VB = 64 * DV * 2, KCH = DQK / 8, NKP = (64 * KCH + 511) / 512, VCH = DV / 8, NVP = 64 * VCH / 512;
    static_assert(NKP <= 2 && (NVP == 1 || NVP == 2), "staging piece counts");
    int tid_ = threadIdx.x; asm volatile("" : "+v"(tid_));
    const int tid = tid_, wid = __builtin_amdgcn_readfirstlane(tid >> 6), lane = tid & 63, r32 = lane & 31, hi = lane >> 5;
    char* V_lds = lds; char* K_lds = lds + 2 * VB;
    float* ws = (float*)(lds + 2 * VB + 2 * KB) + wid * 64; float* li_l = ws; float* al_l = ws + 32;
    float m_reg = -1e30f, l_reg = 0; f32x16 o[NB];
#pragma unroll
    for (int d = 0; d < NB; ++d) o[d] = f32x16{};
    bf16x8 qr[DQK / 16];
    const bf16* Qw = Qb + (size_t)(wid * 32 + r32) * LDQ + hi * 8;
#pragma unroll
    for (int d0 = 0; d0 < DQK / 16; ++d0) qr[d0] = *reinterpret_cast<const bf16x8*>(Qw + d0 * 16);
    const int kr0 = tid / KCH, kc0 = tid % KCH, kr1 = (tid + 512) / KCH, kc1 = (tid + 512) % KCH; const bool k2 = (NKP == 2) && (tid + 512 < 64 * KCH);
    const int kw0 = k_addr<KRS>(kr0, kc0), kw1 = k_addr<KRS>(kr1 & 63, kc1);
    const int vr = tid / VCH, vc = (tid % VCH) * 8, vst0 = v_st<NB>(vr, vc), vst1 = v_st<NB>((32 + vr) & 63, vc);
    const int vb0 = (int)(uintptr_t)V_lds + v_rd_base(lane);
    bf16x8 sk0, sk1, sv0, sv1;
#define AT_SLOAD(k0_) do { const int k0 = (k0_) * kvmul; sv0 = *reinterpret_cast<const bf16x8*>(Vh + (size_t)((k0) + vr) * LDV + vc); if (NVP == 2) sv1 = *reinterpret_cast<const bf16x8*>(Vh + (size_t)((k0) + 32 + vr) * LDV + vc); \
        sk0 = *reinterpret_cast<const bf16x8*>(Kh + (size_t)((k0) + kr0) * LDK + kc0 * 8); if (k2) sk1 = *reinterpret_cast<const bf16x8*>(Kh + (size_t)((k0) + kr1) * LDK + kc1 * 8); } while (0)
#define AT_SWRITE(b) do { *(bf16x8*)(V_lds + (b) * VB + vst0) = sv0; if (NVP == 2) *(bf16x8*)(V_lds + (b) * VB + vst1) = sv1; \
        *(bf16x8*)(K_lds + (b) * KB + kw0) = sk0; if (k2) *(bf16x8*)(K_lds + (b) * KB + kw1) = sk1; } while (0)
#define AT_VMW() asm volatile("s_waitcnt vmcnt(0)" ::: "memory")
#define AT_RESC(a) do { if (__any((a) < 1.f)) { if (hi == 0) al_l[r32] = (a); asm volatile("s_waitcnt lgkmcnt(0)" ::: "memory"); \
        _Pragma("unroll") for (int d_ = 0; d_ < NB; ++d_) _Pragma("unroll") for (int r = 0; r < 16; ++r) o[d_][r] *= al_l[crow(r, hi)]; } } while (0)
    const int NT = 4 * (qb + 1);
    const int qlo = 256 * qb + wid * 32, qm = qlo + r32 - 4 * hi;
#define AT_MASK(P0_, P1_, t) do { const int kb_ = (t) * 64; if (kb_ + 63 > qlo) mask_tile(P0_, P1_, qm - kb_); } while (0)
    f32x16 pA0, pA1, pB0, pB1; float alA, alB; bf16x8 pa0, pa1, pa2, pa3;
    AT_SLOAD(0); AT_VMW(); AT_SWRITE(0); __syncthreads();
    qkt<DQK, KRS>(pA0, pA1, K_lds, r32, hi, qr); AT_MASK(pA0, pA1, 0); partialSM(pA0, pA1, m_reg, alA);
    AT_SLOAD(64); AT_VMW(); AT_SWRITE(1); __syncthreads();
    for (int j = 1; j + 1 < NT; j += 2) {
        SBAR(); qkt<DQK, KRS>(pB0, pB1, K_lds + KB, r32, hi, qr);
        finishSM(pA0, pA1, alA, l_reg, pa0, pa1, pa2, pa3); SBAR();
        AT_SLOAD((j + 1) * 64); SBAR();
        pv_all<NB>(o, vb0, pa0, pa1, pa2, pa3); AT_MASK(pB0, pB1, j); partialSM(pB0, pB1, m_reg, alB);
        __syncthreads(); AT_VMW(); AT_SWRITE(0);
        AT_RESC(alB); __syncthreads();
        SBAR(); qkt<DQK, KRS>(pA0, pA1, K_lds, r32, hi, qr);
        finishSM(pB0, pB1, alB, l_reg, pa0, pa1, pa2, pa3); SBAR();
        AT_SLOAD((j + 2) * 64); SBAR();
        pv_all<NB>(o, vb0 + VB, pa0, pa1, pa2, pa3); AT_MASK(pA0, pA1, j + 1); partialSM(pA0, pA1, m_reg, alA);
        __syncthreads(); AT_VMW(); AT_SWRITE(1);
        AT_RESC(alA); __syncthreads();
    }
    SBAR(); qkt<DQK, KRS>(pB0, pB1, K_lds + KB, r32, hi, qr);
    finishSM(pA0, pA1, alA, l_reg, pa0, pa1, pa2, pa3); SBAR();
    pv_all<NB>(o, vb0, pa0, pa1, pa2, pa3); AT_MASK(pB0, pB1, NT - 1); partialSM(pB0, pB1, m_reg, alB);
    AT_RESC(alB);
    finishSM(pB0, pB1, alB, l_reg, pa0, pa1, pa2, pa3); SBAR();
    pv_all<NB>(o, vb0 + VB, pa0, pa1, pa2, pa3);
    if (hi == 0) li_l[r32] = l_reg; asm volatile("s_waitcnt lgkmcnt(0)" ::: "memory");
    float rli[16];
#pragma unroll
    for (int r = 0; r < 16; ++r) rli[r] = __builtin_amdgcn_rcpf(li_l[crow(r, hi)]);
    bf16* Ow = Ob + (size_t)(wid * 32) * LDO;
#pragma unroll
    for (int r = 0; r < 16; ++r) { const int orow = crow(r, hi);
#pragma unroll
        for (int d0 = 0; d0 < NB; ++d0) { const float v = o[d0][r] * rli[r]; const float vn = shx<1>(v);
            if ((r32 & 1) == 0 && kvmul) *(unsigned*)(Ow + (size_t)orow * LDO + d0 * 32 + r32) = cvtpk(v, vn); } }
    __syncthreads();
#undef AT_SLOAD
#undef AT_SWRITE
#undef AT_VMW
#undef AT_RESC
#undef AT_MASK
}
}
namespace at2 {
using namespace at;
typedef __attribute__((address_space(3))) const char* lds_cptr;
typedef short v4i16_t __attribute__((ext_vector_type(4)));
__device__ __forceinline__ void glds16(const void* gsrc, unsigned lds_dst) { unsigned keep;
    asm volatile("s_mov_b32 %0, m0\n\ts_mov_b32 m0, %2\n\ts_nop 0\n\tglobal_load_lds_dwordx4 %1, off\n\ts_mov_b32 m0, %0" : "=&s"(keep) : "v"(gsrc), "s"(lds_dst) : "memory"); }
__device__ __forceinline__ s16x4 vtr(lds_cptr p) { return __builtin_bit_cast(s16x4, __builtin_amdgcn_ds_read_tr16_b64_v4i16((__attribute__((address_space(3))) v4i16_t*)p)); }
__device__ __forceinline__ bf16x8 kld(lds_cptr p) { return *(const __attribute__((address_space(3))) bf16x8*)p; }
typedef float f32x2_t __attribute__((ext_vector_type(2))); typedef __bf16 bf16x2_t __attribute__((ext_vector_type(2)));
__device__ __forceinline__ unsigned cvtpk_s(float lo, float hi) { f32x2_t v = {lo, hi}; bf16x2_t b = __builtin_convertvector(v, bf16x2_t); return __builtin_bit_cast(unsigned, b); }
constexpr float THRL = 8.f;

template <int DQK, int DV, int LDQ, int LDK, int LDV, int LDO>
__device__ __forceinline__ void attn_unit(const bf16* __restrict__ Qb, const bf16* __restrict__ Kh, const bf16* __restrict__ Vh, bf16* __restrict__ Ob, int qb, char* shm, int kvmul = 1) {
    constexpr int NKS = DQK / 16, NB = DV / 32, KSL = 64 * DQK * 2, VSL = 64 * DV * 2, NKC = DQK / 8, NVP = DV / 8, LDS_K = 0, LDS_V = 3 * KSL, LDS_WS = 3 * KSL + 3 * VSL;
    static_assert(NKC <= 16 && (NVP == 8 || NVP == 16), "piece counts");
    int tid_ = threadIdx.x; asm volatile("" : "+v"(tid_));
    const int tid = tid_, lane = tid & 63, r32 = lane & 31, hi = lane >> 5, wid = __builtin_amdgcn_readfirstlane(tid >> 6);
    const unsigned lds0 = (unsigned)(uintptr_t)shm;
    float* wsf = (float*)(shm + LDS_WS) + wid * 64;
    const bool k2 = (NKC > 8) && (wid < NKC - 8);
    const bf16* ksrc = Kh + (size_t)lane * LDK + wid * 8;
    const bf16* vsrc = Vh + (size_t)(16 * (wid & 3) + (lane >> 2)) * LDV + (wid >> 2) * 32 + (lane & 3) * 8;
#define A2_DMA_K(t, s) do { glds16(ksrc + (size_t)(t) * 64 * LDK, (unsigned)__builtin_amdgcn_readfirstlane(lds0 + LDS_K + (s) * KSL + wid * 1024)); \
        if (k2) glds16(ksrc + (size_t)(t) * 64 * LDK + 64, (unsigned)__builtin_amdgcn_readfirstlane(lds0 + LDS_K + (s) * KSL + (wid + 8) * 1024)); } while (0)
#define A2_DMA_V(t, s) do { glds16(vsrc + (size_t)(t) * 64 * LDV, (unsigned)__builtin_amdgcn_readfirstlane(lds0 + LDS_V + (s) * VSL + wid * 1024)); \
        if (NVP == 16) glds16(vsrc + (size_t)(t) * 64 * LDV + 64, (unsigned)__builtin_amdgcn_readfirstlane(lds0 + LDS_V + (s) * VSL + (wid + 8) * 1024)); } while (0)
#define A2_WAIT_BAR_K() do { if ((k2 ? 2 : 1) + (NVP == 16 ? 2 : 1) == 3) asm volatile("s_waitcnt vmcnt(3) lgkmcnt(0)\n\ts_barrier" ::: "memory"); else asm volatile("s_waitcnt vmcnt(2) lgkmcnt(0)\n\ts_barrier" ::: "memory"); } while (0)
#define A2_WAIT_BAR_0() asm volatile("s_waitcnt vmcnt(0) lgkmcnt(0)\n\ts_barrier" ::: "memory")
    const lds_cptr shm3 = (lds_cptr)shm;
    const lds_cptr kp0 = shm3 + LDS_K + hi * 1024 + r32 * 16;
    const lds_cptr vp0 = shm3 + LDS_V + ((lane >> 4) & 1) * 32 + (lane & 3) * 8 + (4 * hi + ((lane & 15) >> 2)) * 64;
    const int NT = 4 * (qb + 1);
    A2_DMA_K(0, 0); A2_DMA_V(0, 0); A2_DMA_K(1, 1); A2_DMA_V(1, 1);
    bf16x8 qr[NKS];
    { const bf16* Qw = Qb + (size_t)(wid * 32 + r32) * LDQ + hi * 8;
#pragma unroll
      for (int d0 = 0; d0 < NKS; ++d0) qr[d0] = *reinterpret_cast<const bf16x8*>(Qw + d0 * 16); }
    float mhat = 0.f, l_reg = 0.f; f32x16 o[NB];
#pragma unroll
    for (int d = 0; d < NB; ++d) o[d] = f32x16{};
    f32x16 negm = f32x16{};
    const int qlo = 256 * qb + wid * 32, qm = qlo + r32 - 4 * hi;
    A2_WAIT_BAR_0();
    int sl = 0;
#pragma unroll 1
    for (int t = 0; t < NT; ++t) {
        const int sl2 = sl == 0 ? 2 : sl - 1;
        if (t + 2 < NT) { A2_DMA_K(t + 2, sl2); A2_DMA_V(t + 2, sl2); }
        f32x16 c0, c1;
        { const lds_cptr kp = kp0 + sl * KSL;
#pragma unroll
          for (int d0 = 0; d0 < NKS; ++d0) { const bf16x8 b0 = kld(kp + d0 * 2048), b1 = kld(kp + d0 * 2048 + 512);
              c0 = __builtin_amdgcn_mfma_f32_32x32x16_bf16(b0, qr[d0], d0 == 0 ? negm : c0, 0, 0, 0);
              c1 = __builtin_amdgcn_mfma_f32_32x32x16_bf16(b1, qr[d0], d0 == 0 ? negm : c1, 0, 0, 0); } }
        if (t * 64 + 63 > qlo) mask_tile(c0, c1, qm - t * 64);
        float rm = c0[0];
#pragma unroll
        for (int r = 1; r < 16; ++r) rm = fmaxf(rm, c0[r]);
#pragma unroll
        for (int r = 0; r < 16; ++r) rm = fmaxf(rm, c1[r]);
        { auto rr = __builtin_amdgcn_permlane32_swap(__float_as_uint(rm), __float_as_uint(rm), false, false); rm = fmaxf(__uint_as_float(rr[0]), __uint_as_float(rr[1])); }
        if (t == 0 || __builtin_expect(__any(rm > THRL), 0)) {
            const float dl = t == 0 ? rm : fmaxf(rm, 0.f); mhat += dl;
#pragma unroll
            for (int r = 0; r < 16; ++r) { c0[r] -= dl; c1[r] -= dl; }
#pragma unroll
            for (int r = 0; r < 16; ++r) negm[r] = -mhat;
            if (t != 0) { const float f = __builtin_amdgcn_exp2f(-dl); l_reg *= f; if (hi == 0) wsf[r32] = f; asm volatile("s_waitcnt lgkmcnt(0)" ::: "memory");
#pragma unroll
                for (int d_ = 0; d_ < NB; ++d_)
#pragma unroll
                    for (int r = 0; r < 16; ++r) o[d_][r] *= wsf[crow(r, hi)]; }
        }
        float sacc = 0.f;
#pragma unroll
        for (int r = 0; r < 16; ++r) { c0[r] = __builtin_amdgcn_exp2f(c0[r]); sacc += c0[r]; }
#pragma unroll
        for (int r = 0; r < 16; ++r) { c1[r] = __builtin_amdgcn_exp2f(c1[r]); sacc += c1[r]; }
        l_reg += sacc;
        u32x4 pw[4];
#pragma unroll
        for (int k = 0; k < 2; ++k) { pw[k] = (u32x4){cvtpk_s(c0[8 * k], c0[8 * k + 1]), cvtpk_s(c0[8 * k + 2], c0[8 * k + 3]), cvtpk_s(c0[8 * k + 4], c0[8 * k + 5]), cvtpk_s(c0[8 * k + 6], c0[8 * k + 7])};
                                      pw[2 + k] = (u32x4){cvtpk_s(c1[8 * k], c1[8 * k + 1]), cvtpk_s(c1[8 * k + 2], c1[8 * k + 3]), cvtpk_s(c1[8 * k + 4], c1[8 * k + 5]), cvtpk_s(c1[8 * k + 6], c1[8 * k + 7])}; }
        { const lds_cptr vp = vp0 + sl * VSL;
#pragma unroll
          for (int d0 = 0; d0 < NB; ++d0)
#pragma unroll
              for (int ks = 0; ks < 4; ++ks) { const s16x4 lo = vtr(vp + d0 * 4096 + ks * 1024), hh = vtr(vp + d0 * 4096 + ks * 1024 + 512);
                  o[d0] = __builtin_amdgcn_mfma_f32_32x32x16_bf16(__builtin_bit_cast(bf16x8, pw[ks]), (bf16x8){lo[0], lo[1], lo[2], lo[3], hh[0], hh[1], hh[2], hh[3]}, o[d0], 0, 0, 0); } }
        if (t + 2 < NT) A2_WAIT_BAR_K(); else A2_WAIT_BAR_0();
        sl = sl == 2 ? 0 : sl + 1;
    }
    { auto rr = __builtin_amdgcn_permlane32_swap(__float_as_uint(l_reg), __float_as_uint(l_reg), false, false); l_reg = __uint_as_float(rr[0]) + __uint_as_float(rr[1]); }
    if (hi == 0) wsf[32 + r32] = l_reg; asm volatile("s_waitcnt lgkmcnt(0)" ::: "memory");
    float rli[16];
#pragma unroll
    for (int r = 0; r < 16; ++r) rli[r] = __builtin_amdgcn_rcpf(wsf[32 + crow(r, hi)]);
    bf16* Ow = Ob + (size_t)(wid * 32) * LDO;
#pragma unroll
    for (int r = 0; r < 16; ++r) { const int orow = crow(r, hi);
#pragma unroll
        for (int d0 = 0; d0 < NB; ++d0) { const float v = o[d0][r] * rli[r]; const float vn = shx<1>(v);
            if ((r32 & 1) == 0) *(unsigned*)(Ow + (size_t)orow * LDO + d0 * 32 + r32) = cvtpk(v, vn); } }
    asm volatile("s_waitcnt vmcnt(0) lgkmcnt(0)\n\ts_barrier" ::: "memory");
#undef A2_DMA_K
#undef A2_DMA_V
#undef A2_WAIT_BAR_K
#undef A2_WAIT_BAR_0
}
}
namespace at3 {
using namespace at2;
__device__ __forceinline__ void glds16s(const void* sbase, unsigned voff, unsigned lds_dst) { unsigned keep;
    asm volatile("s_mov_b32 %0, m0\n\ts_mov_b32 m0, %3\n\ts_nop 0\n\tglobal_load_lds_dwordx4 %1, %2\n\ts_mov_b32 m0, %0" : "=&s"(keep) : "v"(voff), "s"(sbase), "s"(lds_dst) : "memory"); }
#ifdef A3_HALFPRIO
#define A3_PRIO(p) do { if (wid >= 4) __builtin_amdgcn_s_setprio((p) + 1); else __builtin_amdgcn_s_setprio(p); } while (0)
#else
#define A3_PRIO(p) __builtin_amdgcn_s_setprio(p)
#endif
#ifndef A3_TWOLV
#define A3_TWOLV 1
#endif
#define A3_PIN(x) asm volatile("" : "+v"(x))
#define A3_PEL(P0, P1, e) ((e) < 16 ? P0[(e) & 15] : P1[(e) & 15])
template <int DQK, int DV, int LDQ, int LDK, int LDV, int LDO, int FIXM = 0>
__device__ __forceinline__ unsigned attn_unit(const bf16* __restrict__ Qb, const bf16* __restrict__ Kh, const bf16* __restrict__ Vh, bf16* __restrict__ Ob, int qb, char* shm, gu32* qp, volatile LAS unsigned* misc, const float* qn = nullptr, float kmax = 0.f, int kvmul = 1) {
    constexpr int NKS = DQK / 16, NQK = DQK / 8, NB = DV / 32, NPV = 4 * NB, KSL = 64 * DQK * 2, VSL = 64 * DV * 2, NKC = DQK / 8, NVP = DV / 8, LDS_K = 0, LDS_V = 3 * KSL, LDS_WS = 3 * KSL + 3 * VSL;
    static_assert(NKC <= 16 && (NVP == 8 || NVP == 16) && 32 % NQK != 1 && 32 % NPV == 0, "shape");
    int tid_ = threadIdx.x; asm volatile("" : "+v"(tid_));
    const int tid = tid_, lane = tid & 63, r32 = lane & 31, hi = lane >> 5, wid = __builtin_amdgcn_readfirstlane(tid >> 6);
    const int rb = wid < 4 ? wid : 11 - wid;
    const unsigned lds0 = (unsigned)(uintptr_t)shm;
    float* wsf = (float*)(shm + LDS_WS) + wid * 64;
    const bool k2 = (NKC > 8) && (wid < NKC - 8);
    const unsigned kvo = (unsigned)(lane * LDK) * 2u, vvo = (unsigned)((lane >> 2) * LDV + (lane & 3) * 8) * 2u;
    const char* kbs = (const char*)(Kh + wid * 8); const char* vbs = (const char*)(Vh + (size_t)(16 * (wid & 3)) * LDV + (wid >> 2) * 32);
#define A3_DMA_K(t, s) do { const char* b_ = kbs + (size_t)((t) * kvmul) * (64 * LDK * 2); glds16s(b_, kvo, (unsigned)__builtin_amdgcn_readfirstlane(lds0 + LDS_K + (s) * KSL + wid * 1024)); \
        if (k2) glds16s(b_ + 128, kvo, (unsigned)__builtin_amdgcn_readfirstlane(lds0 + LDS_K + (s) * KSL + (wid + 8) * 1024)); } while (0)
#define A3_DMA_V(t, s) do { const char* b_ = vbs + (size_t)((t) * kvmul) * (64 * LDV * 2); glds16s(b_, vvo, (unsigned)__builtin_amdgcn_readfirstlane(lds0 + LDS_V + (s) * VSL + wid * 1024)); \
        if (NVP == 16) glds16s(b_ + 128, vvo, (unsigned)__builtin_amdgcn_readfirstlane(lds0 + LDS_V + (s) * VSL + (wid + 8) * 1024)); } while (0)
#define A3_WB(n) asm volatile("s_waitcnt vmcnt(" #n ") lgkmcnt(0)\n\ts_barrier" ::: "memory")
#define A3_WAIT_BAR(gk, gv) do { const int n_ = ((gk) ? (k2 ? 2 : 1) : 0) + ((gv) ? NVP / 8 : 0); \
        if (n_ == 0) A3_WB(0); else if (n_ == 1) A3_WB(1); else if (n_ == 2) A3_WB(2); else if (n_ == 3) A3_WB(3); else A3_WB(4); } while (0)
    const lds_cptr shm3 = (lds_cptr)shm;
    const lds_cptr kp0 = shm3 + LDS_K + hi * 1024 + r32 * 16;
    const lds_cptr vp0 = shm3 + LDS_V + ((lane >> 4) & 1) * 32 + (lane & 3) * 8 + (4 * hi + ((lane & 15) >> 2)) * 64;
    const int NT = 4 * (qb + 1);
    A3_DMA_K(0, 0); A3_DMA_V(0, 0); A3_DMA_K(1, 1);
    bf16x8 qr[NKS];
    { const bf16* Qw = Qb + (size_t)(rb * 32 + r32) * LDQ + hi * 8;
#pragma unroll
      for (int d0 = 0; d0 < NKS; ++d0) qr[d0] = *reinterpret_cast<const bf16x8*>(Qw + d0 * 16); }
    float mhat = 0.f, l_reg = 0.f; f32x16 o[NB];
#pragma unroll
    for (int d = 0; d < NB; ++d) o[d] = f32x16{};
    constexpr bool FIXC = FIXM == 1;
    f32x16 negm = f32x16{}; if (!FIXC) asm volatile("" : "+v"(negm));
    const int qlo = 256 * qb + rb * 32, qm = qlo + r32 - 4 * hi, lastw = 4 * qb + (rb >> 1);
    bool fix = FIXC;
    if (!FIXC && qn != nullptr) { const float bnd = qn[(size_t)(rb * 32 + r32) * 8] * kmax * 1.01f; fix = !__any(!(bnd < 100.f)); }
    u32x4 pw[4]; asm volatile("" : "=v"(pw[0]), "=v"(pw[1]), "=v"(pw[2]), "=v"(pw[3])); bool resc = false;
    int slk = 0, slv = 0;
#define A3_KFRAG(kp_, i) kld((kp_) + ((i) >> 1) * 2048 + ((i) & 1) * 512)
#define A3_VFRAG(vp_, j) ((vp_) + ((j) % NB) * 4096 + ((j) / NB) * 1024)
#define A3_MASK(C0_, C1_, t) do { if ((t) * 64 + 63 > qlo) mask_tile(C0_, C1_, qm - (t) * 64); } while (0)
#define A3_ROWMAX(C0_, C1_, rm_) do { float a_ = fmaxf(fmaxf(C0_[0], C0_[1]), C1_[0]), b_ = fmaxf(fmaxf(C0_[2], C0_[3]), C1_[1]); a_ = fmaxf(fmaxf(a_, C1_[2]), C1_[3]); \
        _Pragma("unroll") for (int r = 4; r < 16; r += 4) { a_ = fmaxf(fmaxf(a_, C0_[r]), C0_[r + 1]); b_ = fmaxf(fmaxf(b_, C0_[r + 2]), C0_[r + 3]); a_ = fmaxf(fmaxf(a_, C1_[r]), C1_[r + 1]); b_ = fmaxf(fmaxf(b_, C1_[r + 2]), C1_[r + 3]); } \
        rm_ = fmaxf(a_, b_); { auto rr_ = __builtin_amdgcn_permlane32_swap(__float_as_uint(rm_), __float_as_uint(rm_), false, false); rm_ = fmaxf(__uint_as_float(rr_[0]), __uint_as_float(rr_[1])); } } while (0)
#define A3_STEP(C0, C1, P0, P1, t, BAND) do { \
        const bool gk_ = !(BAND) || ((t) + 2 < NT), gv_ = !(BAND) || ((t) + 1 < NT); \
        const lds_cptr kp_ = kp0 + slk * KSL; const lds_cptr vp_ = vp0 + slv * VSL; \
        bf16x8 kf_[3]; s16x4 vl_[3], vh_[3]; float sacc_ = 0.f; \
        kf_[0] = A3_KFRAG(kp_, 0); kf_[1] = A3_KFRAG(kp_, 1); SBAR(); A3_PRIO(1); \
        _Pragma("unroll") for (int i = 0; i < NQK; ++i) { \
            if (i + 2 < NQK) kf_[(i + 2) % 3] = A3_KFRAG(kp_, i + 2); \
            if (i == NQK - 2) { vl_[0] = vtr(A3_VFRAG(vp_, 0)); vh_[0] = vtr(A3_VFRAG(vp_, 0) + 512); } \
            if (i == NQK - 1) { vl_[1] = vtr(A3_VFRAG(vp_, 1)); vh_[1] = vtr(A3_VFRAG(vp_, 1) + 512); } \
            SBAR(); \
            if ((i & 1) == 0) C0 = __builtin_amdgcn_mfma_f32_32x32x16_bf16(kf_[i % 3], qr[i >> 1], i < 2 ? negm : C0, 0, 0, 0); \
            else C1 = __builtin_amdgcn_mfma_f32_32x32x16_bf16(kf_[i % 3], qr[i >> 1], i < 2 ? negm : C1, 0, 0, 0); \
            _Pragma("unroll") for (int e = (i * 32) / NQK; e < ((i + 1) * 32) / NQK; ++e) sacc_ += A3_PEL(P0, P1, e); \
            A3_PIN(sacc_); \
            _Pragma("unroll") for (int c = (i * 16) / NQK; c < ((i + 1) * 16) / NQK; ++c) { const int e = 2 * c; pw[c >> 2][c & 3] = cvtpk_s(A3_PEL(P0, P1, e), A3_PEL(P0, P1, e + 1)); } \
            A3_PIN(pw[((i * 16) / NQK) >> 2]); \
            SBAR(); } \
        A3_PRIO(0); l_reg += sacc_; \
        if (gk_) A3_DMA_K((t) + 2, slk == 0 ? 2 : slk - 1); if (gv_) A3_DMA_V((t) + 1, slv == 0 ? 2 : slv - 1); \
        if (BAND) A3_MASK(C0, C1, t); \
        if (!FIXC && !fix) { float rm_; A3_ROWMAX(C0, C1, rm_); resc = false; \
          if (__builtin_expect(__any(rm_ > THRL), 0)) { const float dl = fmaxf(rm_, 0.f); mhat += dl; \
              _Pragma("unroll") for (int r = 0; r < 16; ++r) { C0[r] -= dl; C1[r] -= dl; } \
              _Pragma("unroll") for (int r = 0; r < 16; ++r) negm[r] = -mhat; asm volatile("" : "+v"(negm)); \
              const float f = __builtin_amdgcn_exp2f(-dl); l_reg *= f; if (hi == 0) wsf[r32] = f; resc = true; } } \
        SBAR(); A3_PRIO(1); \
        _Pragma("unroll") for (int j = 0; j < NPV; ++j) { \
            if (j + 2 < NPV) { vl_[(j + 2) % 3] = vtr(A3_VFRAG(vp_, j + 2)); vh_[(j + 2) % 3] = vtr(A3_VFRAG(vp_, j + 2) + 512); } \
            SBAR(); \
            o[j % NB] = __builtin_amdgcn_mfma_f32_32x32x16_bf16(__builtin_bit_cast(bf16x8, pw[j / NB]), \
                (bf16x8){vl_[j % 3][0], vl_[j % 3][1], vl_[j % 3][2], vl_[j % 3][3], vh_[j % 3][0], vh_[j % 3][1], vh_[j % 3][2], vh_[j % 3][3]}, o[j % NB], 0, 0, 0); \
            _Pragma("unroll") for (int e = (j * 32) / NPV; e < ((j + 1) * 32) / NPV; ++e) { if (e < 16) C0[e & 15] = __builtin_amdgcn_exp2f(C0[e & 15]); else C1[e & 15] = __builtin_amdgcn_exp2f(C1[e & 15]); } \
            if (((j * 32) / NPV) < 16) A3_PIN(C0); else A3_PIN(C1); \
            SBAR(); } \
        A3_PRIO(0); A3_WAIT_BAR(gk_, gv_); \
        if (!FIXC && resc) { asm volatile("s_waitcnt lgkmcnt(0)" ::: "memory"); \
            _Pragma("unroll") for (int d_ = 0; d_ < NB; ++d_) _Pragma("unroll") for (int r = 0; r < 16; ++r) o[d_][r] *= wsf[crow(r, hi)]; } \
        slk = slk == 2 ? 0 : slk + 1; slv = (t) == 0 ? 0 : (slv == 2 ? 0 : slv + 1); \
    } while (0)
    f32x16 pA0, pA1, pB0, pB1;
    A3_WB(0);
    { const lds_cptr kp_ = kp0;
#pragma unroll
      for (int i = 0; i < NQK; ++i) { const bf16x8 kf = A3_KFRAG(kp_, i);
          if ((i & 1) == 0) pA0 = __builtin_amdgcn_mfma_f32_32x32x16_bf16(kf, qr[i >> 1], i < 2 ? negm : pA0, 0, 0, 0); else pA1 = __builtin_amdgcn_mfma_f32_32x32x16_bf16(kf, qr[i >> 1], i < 2 ? negm : pA1, 0, 0, 0); }
      A3_DMA_K(2, 2); A3_DMA_V(1, 1);
      A3_MASK(pA0, pA1, 0);
      if (!FIXC && !fix) { float rm; A3_ROWMAX(pA0, pA1, rm); mhat = rm;
#pragma unroll
          for (int r = 0; r < 16; ++r) { pA0[r] -= rm; pA1[r] -= rm; }
#pragma unroll
          for (int r = 0; r < 16; ++r) negm[r] = -mhat;
          asm volatile("" : "+v"(negm)); }
#pragma unroll
      for (int r = 0; r < 16; ++r) { pA0[r] = __builtin_amdgcn_exp2f(pA0[r]); pA1[r] = __builtin_amdgcn_exp2f(pA1[r]); }
      A3_WAIT_BAR(true, true);
      slk = 1; slv = 0; }
    int t = 1;
#pragma unroll 1
    for (; t + 5 < NT; t += 2) { A3_STEP(pB0, pB1, pA0, pA1, t, false); A3_STEP(pA0, pA1, pB0, pB1, t + 1, false); }
#define A3_DRAINP(P0, P1) do { float sacc = 0.f; \
        _Pragma("unroll") for (int r = 0; r < 16; ++r) sacc += P0[r]; \
        _Pragma("unroll") for (int r = 0; r < 16; ++r) sacc += P1[r]; \
        l_reg += sacc; \
        _Pragma("unroll") for (int c = 0; c < 16; ++c) { const int e = 2 * c; pw[c >> 2][c & 3] = cvtpk_s(A3_PEL(P0, P1, e), A3_PEL(P0, P1, e + 1)); } \
        const lds_cptr vq_ = vp0 + slv * VSL; \
        s16x4 vl_[3], vh_[3]; vl_[0] = vtr(A3_VFRAG(vq_, 0)); vh_[0] = vtr(A3_VFRAG(vq_, 0) + 512); vl_[1] = vtr(A3_VFRAG(vq_, 1)); vh_[1] = vtr(A3_VFRAG(vq_, 1) + 512); SBAR(); \
        _Pragma("unroll") for (int j = 0; j < NPV; ++j) { \
            if (j + 2 < NPV) { vl_[(j + 2) % 3] = vtr(A3_VFRAG(vq_, j + 2)); vh_[(j + 2) % 3] = vtr(A3_VFRAG(vq_, j + 2) + 512); } \
            SBAR(); \
            o[j % NB] = __builtin_amdgcn_mfma_f32_32x32x16_bf16(__builtin_bit_cast(bf16x8, pw[j / NB]), \
                (bf16x8){vl_[j % 3][0], vl_[j % 3][1], vl_[j % 3][2], vl_[j % 3][3], vh_[j % 3][0], vh_[j % 3][1], vh_[j % 3][2], vh_[j % 3][3]}, o[j % NB], 0, 0, 0); \
            SBAR(); } } while (0)
#define A3_TAIL(t) do { const bool gk_ = (t) + 2 < NT, gv_ = (t) + 1 < NT; \
        if (gk_) A3_DMA_K((t) + 2, slk == 0 ? 2 : slk - 1); if (gv_) A3_DMA_V((t) + 1, slv == 0 ? 2 : slv - 1); \
        A3_WAIT_BAR(gk_, gv_); slk = slk == 2 ? 0 : slk + 1; slv = slv == 2 ? 0 : slv + 1; } while (0)
    if (FIXC && A3_TWOLV) {
#pragma unroll 1
        for (; t + 3 < NT; t += 2) { A3_STEP(pB0, pB1, pA0, pA1, t, true); A3_STEP(pA0, pA1, pB0, pB1, t + 1, true); }
        A3_STEP(pB0, pB1, pA0, pA1, NT - 3, true);
        const int cls = rb >> 1;
        if (cls >= 2) { A3_STEP(pA0, pA1, pB0, pB1, NT - 2, true);
            if (cls == 3) { A3_STEP(pB0, pB1, pA0, pA1, NT - 1, true); }
            else { pB0 = pA0; pB1 = pA1; A3_WAIT_BAR(false, false); } }
        else { A3_DMA_V(NT - 1, slv == 0 ? 2 : slv - 1); A3_WAIT_BAR(false, true); A3_WAIT_BAR(false, false); }
    } else {
#pragma unroll 1
    for (; t + 1 < NT; t += 2) { A3_STEP(pB0, pB1, pA0, pA1, t, true); A3_STEP(pA0, pA1, pB0, pB1, t + 1, true); }
    if ((rb >> 1) == 3) { A3_STEP(pB0, pB1, pA0, pA1, NT - 1, true); }
    else { pB0 = pA0; pB1 = pA1; A3_WAIT_BAR(false, false); }
    }
    A3_DRAINP(pB0, pB1);
#undef A3_TAIL
#undef A3_DRAINP
    { auto rr = __builtin_amdgcn_permlane32_swap(__float_as_uint(l_reg), __float_as_uint(l_reg), false, false); l_reg = __uint_as_float(rr[0]) + __uint_as_float(rr[1]); }
    if (hi == 0) wsf[32 + r32] = l_reg; asm volatile("s_waitcnt lgkmcnt(0)" ::: "memory");
    float rli[16];
#pragma unroll
    for (int r = 0; r < 16; ++r) rli[r] = __builtin_amdgcn_rcpf(wsf[32 + crow(r, hi)]);
    constexpr int PC = 64, NPASS = DV / PC, BPP = PC / 32;
    unsigned nxt = 0u; if (tid == 0) nxt = __hip_atomic_fetch_add(qp, 1u, __ATOMIC_RELAXED, __HIP_MEMORY_SCOPE_AGENT);
    LAS char* stg = (LAS char*)shm + LDS_WS + 2048 + wid * 4096;
    LAS char* stw = stg + hi * 512 + r32 * 2;
    bf16* Ow = Ob + (size_t)(rb * 32 + (lane >> 3)) * LDO + (lane & 7) * 8;
#pragma unroll
    for (int ps = 0; ps < NPASS; ++ps) {
#pragma unroll
        for (int r = 0; r < 16; r += 2)
#pragma unroll
            for (int b = 0; b < BPP; ++b) { const unsigned pk = cvtpk(o[ps * BPP + b][r] * rli[r], o[ps * BPP + b][r + 1] * rli[r + 1]);
                *(LAS unsigned short*)(stw + crow(r, 0) * 128 + b * 64) = (unsigned short)pk; *(LAS unsigned short*)(stw + crow(r + 1, 0) * 128 + b * 64) = (unsigned short)(pk >> 16); }
        asm volatile("s_waitcnt lgkmcnt(0)" ::: "memory");
        u32x4 ov[4];
#pragma unroll
        for (int i = 0; i < 4; ++i) ov[i] = *(const LAS u32x4*)(stg + i * 1024 + lane * 16);
        asm volatile("s_waitcnt lgkmcnt(0)" ::: "memory");
        if (kvmul) {
#pragma unroll
            for (int i = 0; i < 4; ++i) *(u32x4*)(Ow + (size_t)(i * 8) * LDO + ps * PC) = ov[i]; }
    }
    if (tid == 0) misc[0] = nxt;
    asm volatile("s_waitcnt lgkmcnt(0)\n\ts_barrier" ::: "memory");
    const unsigned nidx = (unsigned)__builtin_amdgcn_readfirstlane((int)misc[0]);
#undef A3_DMA_K
#undef A3_DMA_V
#undef A3_WB
#undef A3_WAIT_BAR
#undef A3_KFRAG
#undef A3_VFRAG
#undef A3_MASK
#undef A3_ROWMAX
#undef A3_STEP
    return nidx;
}
#undef A3_PIN
#undef A3_PEL
}
namespace ret {
using namespace at;
__device__ __forceinline__ float log2_gamma(int h) { return h == 0 ? -0.04580368961312479f : h == 1 ? -0.02272007650008353f : h == 2 ? -0.011315313227834146f : -0.005646563141142063f; }
constexpr int IMG = 8192;
template <int OFF> __device__ __forceinline__ s16x4 trr(int vb) { s16x4 r; asm volatile("ds_read_b64_tr_b16 %0, %1 offset:%2" : "=&v"(r) : "v"(vb), "i"(OFF) : "memory"); return r; }

__device__ __forceinline__ void state_item(const bf16* __restrict__ RK, const bf16* __restrict__ RV, float* __restrict__ AST, int b, int h, int cp, char* lds) {
    int tid_ = threadIdx.x; asm volatile("" : "+v"(tid_));
    const int tid = tid_, wid = __builtin_amdgcn_readfirstlane(tid >> 6), lane = tid & 63, r32 = lane & 31, hi = lane >> 5;
    const float l2g = log2_gamma(h);
    const size_t row0 = (size_t)b * SEQ + 256 * cp;
    const int key = tid >> 3, c = (tid & 7) * 8, vst = v_st<2>(key, c);
    bf16x8 kk[4], vv[4];
#pragma unroll
    for (int t = 0; t < 4; ++t) { kk[t] = *reinterpret_cast<const bf16x8*>(RK + (row0 + 64 * t + key) * 256 + h * 64 + c); vv[t] = *reinterpret_cast<const bf16x8*>(RV + (row0 + 64 * t + key) * 256 + h * 64 + c); }
#pragma unroll
    for (int t = 0; t < 4; ++t) { const int j = (64 * t + key) & 127; const float z = __builtin_amdgcn_exp2f((float)(127 - j) * l2g);
        u32x4 w; w.x = cvtpk(bf2f(kk[t][0]) * z, bf2f(kk[t][1]) * z); w.y = cvtpk(bf2f(kk[t][2]) * z, bf2f(kk[t][3]) * z); w.z = cvtpk(bf2f(kk[t][4]) * z, bf2f(kk[t][5]) * z); w.w = cvtpk(bf2f(kk[t][6]) * z, bf2f(kk[t][7]) * z);
        *(u32x4*)(lds + t * IMG + vst) = w; *(bf16x8*)(lds + (4 + t) * IMG + vst) = vv[t]; }
    __syncthreads();
    const int half = wid >> 2, db = (wid >> 1) & 1, eb = wid & 1;
    const int va = (int)(uintptr_t)lds + v_rd_base(lane) + db * 512, vb = (int)(uintptr_t)lds + 4 * IMG + v_rd_base(lane) + eb * 512;
    f32x16 acc = f32x16{};
#define RT_STEP(T, KS) do { const s16x4 al = trr<(T) * IMG + v_rd_off<2>(0, KS, 0)>(va2), ah = trr<(T) * IMG + v_rd_off<2>(0, KS, 1)>(va2), bl = trr<(T) * IMG + v_rd_off<2>(0, KS, 0)>(vb2), bh = trr<(T) * IMG + v_rd_off<2>(0, KS, 1)>(vb2); \
        asm volatile("s_waitcnt lgkmcnt(0)" ::: "memory"); SBAR(); \
        acc = __builtin_amdgcn_mfma_f32_32x32x16_bf16((bf16x8){al[0], al[1], al[2], al[3], ah[0], ah[1], ah[2], ah[3]}, (bf16x8){bl[0], bl[1], bl[2], bl[3], bh[0], bh[1], bh[2], bh[3]}, acc, 0, 0, 0); } while (0)
    { const int va2 = va + half * 2 * IMG, vb2 = vb + half * 2 * IMG;
      RT_STEP(0, 0); RT_STEP(0, 1); RT_STEP(0, 2); RT_STEP(0, 3); RT_STEP(1, 0); RT_STEP(1, 1); RT_STEP(1, 2); RT_STEP(1, 3); }
#undef RT_STEP
    asm volatile("s_nop 7\n\ts_nop 7\n\ts_nop 7" : "+v"(acc));
    bf16* dst = (bf16*)AST + ((size_t)((b * 4 + h) * 64 + 2 * cp + half)) * 4096 + (size_t)(32 * db) * 64 + 32 * eb + r32;
#pragma unroll
    for (int r = 0; r < 16; r += 2) { const unsigned pk = cvtpk(acc[r], acc[r + 1]); *(unsigned short*)(dst + crow(r, hi) * 64) = (unsigned short)pk; *(unsigned short*)(dst + crow(r + 1, hi) * 64) = (unsigned short)(pk >> 16); }
    __syncthreads();
}

__device__ __forceinline__ void ret_unit(const bf16* __restrict__ RQ, const bf16* __restrict__ RK, const bf16* __restrict__ RV, const bf16* __restrict__ RG, const float* __restrict__ AST,
                                         const float* __restrict__ gnw, const float* __restrict__ gnb, bf16* __restrict__ MIX, int b, int h, int cp, char* lds) {
    int tid_ = threadIdx.x; asm volatile("" : "+v"(tid_));
    const int tid = tid_, wid = __builtin_amdgcn_readfirstlane(tid >> 6), lane = tid & 63, r32 = lane & 31, hi = lane >> 5;
    const float l2g = log2_gamma(h);
    const size_t row0 = (size_t)b * SEQ + 256 * cp;
    char* K_lds = lds; char* V_lds = lds + 4 * IMG; char* R_lds = lds + 8 * IMG; char* S_lds = lds;
    { const int key = tid >> 3, ch = tid & 7, c = ch * 8, vst = v_st<2>(key, c), kst = k_addr<128>(key, ch);
      bf16x8 kk[4], vv[4];
#pragma unroll
      for (int t = 0; t < 4; ++t) { kk[t] = *reinterpret_cast<const bf16x8*>(RK + (row0 + 64 * t + key) * 256 + h * 64 + c); vv[t] = *reinterpret_cast<const bf16x8*>(RV + (row0 + 64 * t + key) * 256 + h * 64 + c); }
      const float gC = __builtin_amdgcn_exp2f(128.f * l2g);
      const bf16* ap = (const bf16*)AST + (size_t)((b * 4 + h) * 64) * 4096 + (size_t)key * 64 + c;
#define RT_LO4(x) ((f32x4){bf2f((x)[0]), bf2f((x)[1]), bf2f((x)[2]), bf2f((x)[3])})
#define RT_HI4(x) ((f32x4){bf2f((x)[4]), bf2f((x)[5]), bf2f((x)[6]), bf2f((x)[7])})
      f32x4 r0 = {0.f, 0.f, 0.f, 0.f}, r1 = {0.f, 0.f, 0.f, 0.f};
      const int nprev = 2 * cp;
      { float w = 1.0f;
        int j = nprev - 1;
        for (; j >= 7; j -= 8) { bf16x8 xs[8];
#pragma unroll
            for (int q = 0; q < 8; ++q) xs[q] = *reinterpret_cast<const bf16x8*>(ap + (size_t)(j - q) * 4096);
#pragma unroll
            for (int q = 0; q < 8; ++q) { r0 += RT_LO4(xs[q]) * w; r1 += RT_HI4(xs[q]) * w; w *= gC; } }
        if (j >= 1) { bf16x8 xs[6];
#pragma unroll
            for (int q = 0; q < 6; ++q) { if (j - q >= 0) xs[q] = *reinterpret_cast<const bf16x8*>(ap + (size_t)(j - q) * 4096); else xs[q] = bf16x8{}; }
#pragma unroll
            for (int q = 0; q < 6; ++q) { r0 += RT_LO4(xs[q]) * w; r1 += RT_HI4(xs[q]) * w; w *= gC; } } }
      *(u32x4*)(R_lds + vst) = (u32x4){cvtpk(r0[0], r0[1]), cvtpk(r0[2], r0[3]), cvtpk(r1[0], r1[1]), cvtpk(r1[2], r1[3])};
      { const bf16x8 an = *reinterpret_cast<const bf16x8*>(ap + (size_t)nprev * 4096); r0 = RT_LO4(an) + r0 * gC; r1 = RT_HI4(an) + r1 * gC; }
#undef RT_LO4
#undef RT_HI4
      *(u32x4*)(R_lds + IMG + vst) = (u32x4){cvtpk(r0[0], r0[1]), cvtpk(r0[2], r0[3]), cvtpk(r1[0], r1[1]), cvtpk(r1[2], r1[3])};
#pragma unroll
      for (int t = 0; t < 4; ++t) { *(bf16x8*)(K_lds + t * IMG + kst) = kk[t]; *(bf16x8*)(V_lds + t * IMG + vst) = vv[t]; }
    }
    __syncthreads();
    const int half = wid >> 2, wq = wid & 3;
    bf16x8 qr[4];
    { const bf16* Qw = RQ + (row0 + 128 * half + 32 * wq + r32) * 256 + h * 64 + hi * 8;
#pragma unroll
      for (int d0 = 0; d0 < 4; ++d0) qr[d0] = *reinterpret_cast<const bf16x8*>(Qw + d0 * 16); }
    f32x16 o[2]; o[0] = f32x16{}; o[1] = f32x16{};
    const int vbase = (int)(uintptr_t)V_lds + v_rd_base(lane);
    const int iq = 32 * wq + r32;
#pragma unroll
    for (int tt = 0; tt < 2; ++tt) {
        if (64 * tt > 32 * wq + 31) continue;
        f32x16 p0, p1; bf16x8 pa0, pa1, pa2, pa3;
        qkt<64, 128>(p0, p1, K_lds + (2 * half + tt) * IMG, r32, hi, qr);
#pragma unroll
        for (int r = 0; r < 16; ++r) { const int d0_ = iq - (64 * tt + crow(r, hi)), d1_ = d0_ - 32;
            p0[r] = d0_ >= 0 ? p0[r] * __builtin_amdgcn_exp2f((float)d0_ * l2g) : 0.f; p1[r] = d1_ >= 0 ? p1[r] * __builtin_amdgcn_exp2f((float)d1_ * l2g) : 0.f; }
        pack_p(p0, p1, pa0, pa1, pa2, pa3);
        pv_all<2>(o, vbase + (2 * half + tt) * IMG, pa0, pa1, pa2, pa3);
    }
    { f32x16 oc[2]; oc[0] = f32x16{}; oc[1] = f32x16{};
      pv_all<2>(oc, (int)(uintptr_t)R_lds + half * IMG + v_rd_base(lane), qr[0], qr[1], qr[2], qr[3]);
#pragma unroll
      for (int r = 0; r < 16; ++r) { const float xi = __builtin_amdgcn_exp2f((float)(32 * wq + crow(r, hi) + 1) * l2g); o[0][r] += oc[0][r] * xi; o[1][r] += oc[1][r] * xi; } }
    __syncthreads();
    float* st = (float*)(S_lds + wid * 8448);
#pragma unroll
    for (int r = 0; r < 16; ++r) { st[crow(r, hi) * 66 + r32] = o[0][r]; st[crow(r, hi) * 66 + 32 + r32] = o[1][r]; }
    asm volatile("s_waitcnt lgkmcnt(0)" ::: "memory");
    { const int rr = lane >> 1, hh = lane & 1; const float* sp = st + rr * 66 + hh * 32; float x[32]; float s = 0.f;
#pragma unroll
      for (int k = 0; k < 32; ++k) { x[k] = sp[k]; s += x[k]; }
      s += shx<1>(s); const float mean = s * (1.0f / 64.0f); float q = 0.f;
#pragma unroll
      for (int k = 0; k < 32; ++k) { x[k] -= mean; q += x[k] * x[k]; }
      q += shx<1>(q); const float rstd = 1.0f / sqrtf(q * (1.0f / 64.0f) + 1e-6f);
      const size_t grow = row0 + 128 * half + 32 * wq + rr; const int cb = h * 64 + hh * 32;
      const bf16* gp = RG + grow * 256 + cb; bf16* op = MIX + grow * 1024 + 768 + cb;
#pragma unroll
      for (int k8 = 0; k8 < 4; ++k8) { const bf16x8 g8 = *reinterpret_cast<const bf16x8*>(gp + 8 * k8); const f32x4 w0 = *(const f32x4*)(gnw + cb + 8 * k8), w1 = *(const f32x4*)(gnw + cb + 8 * k8 + 4), bb0 = *(const f32x4*)(gnb + cb + 8 * k8), bb1 = *(const f32x4*)(gnb + cb + 8 * k8 + 4);
          float y[8];
#pragma unroll
          for (int k = 0; k < 8; ++k) y[k] = (x[8 * k8 + k] * rstd * (k < 4 ? w0[k & 3] : w1[k & 3]) + (k < 4 ? bb0[k & 3] : bb1[k & 3])) * bf2f(g8[k]);
          *(u32x4*)(op + 8 * k8) = (u32x4){cvtpk(y[0], y[1]), cvtpk(y[2], y[3]), cvtpk(y[4], y[5]), cvtpk(y[6], y[7])}; } }
    __syncthreads();
}

__device__ __forceinline__ void combine_row(const bf16* __restrict__ OD, const float* __restrict__ subln, float lam, float oml, bf16* __restrict__ MIX, size_t row, int lane) {
    const int head = lane >> 4, e0 = (lane & 15) * 8;
    const bf16x8 a = *reinterpret_cast<const bf16x8*>(OD + row * 1024 + head * 256 + e0), b2 = *reinterpret_cast<const bf16x8*>(OD + row * 1024 + head * 256 + 128 + e0);
    float o[8]; float s = 0.f;
#pragma unroll
    for (int k = 0; k < 8; ++k) { o[k] = bf2f(a[k]) - lam * bf2f(b2[k]); s += o[k] * o[k]; }
    s += shx<1>(s); s += shx<2>(s); s += shx<4>(s); s += shx<8>(s);
    const float rs = oml / sqrtf(s * (1.0f / 128.0f) + 1e-5f);
    const f32x4 g0 = *(const f32x4*)(subln + e0), g1 = *(const f32x4*)(subln + e0 + 4);
    *(u32x4*)(MIX + row * 1024 + head * 128 + e0) = (u32x4){cvtpk(o[0] * rs * g0[0], o[1] * rs * g0[1]), cvtpk(o[2] * rs * g0[2], o[3] * rs * g0[3]), cvtpk(o[4] * rs * g1[0], o[5] * rs * g1[1]), cvtpk(o[6] * rs * g1[2], o[7] * rs * g1[3])};
}
__device__ __forceinline__ void combine_rows4(const bf16* __restrict__ OD, const float* __restrict__ subln, float lam, float oml, bf16* __restrict__ MIX, size_t row, size_t stride, int lane) {
    const int head = lane >> 4, e0 = (lane & 15) * 8;
    bf16x8 a[4], b2[4];
#pragma unroll
    for (int k = 0; k < 4; ++k) { a[k] = *reinterpret_cast<const bf16x8*>(OD + (row + k * stride) * 1024 + head * 256 + e0); b2[k] = *reinterpret_cast<const bf16x8*>(OD + (row + k * stride) * 1024 + head * 256 + 128 + e0); }
    const f32x4 g0 = *(const f32x4*)(subln + e0), g1 = *(const f32x4*)(subln + e0 + 4);
#pragma unroll
    for (int k = 0; k < 4; ++k) { float o[8]; float s = 0.f;
#pragma unroll
        for (int j = 0; j < 8; ++j) { o[j] = bf2f(a[k][j]) - lam * bf2f(b2[k][j]); s += o[j] * o[j]; }
        s += shx<1>(s); s += shx<2>(s); s += shx<4>(s); s += shx<8>(s);
        const float rs = oml / sqrtf(s * (1.0f / 128.0f) + 1e-5f);
        const u32x4 w = (u32x4){cvtpk(o[0] * rs * g0[0], o[1] * rs * g0[1]), cvtpk(o[2] * rs * g0[2], o[3] * rs * g0[3]), cvtpk(o[4] * rs * g1[0], o[5] * rs * g1[1]), cvtpk(o[6] * rs * g1[2], o[7] * rs * g1[3])};
        asm volatile("global_store_dwordx4 %0, %1, off sc1\n\ts_nop 1" :: "v"(MIX + (row + k * stride) * 1024 + head * 128 + e0), "v"(w) : "memory"); }
}
}
#ifndef MK_N_LAUNCHES
#define MK_N_LAUNCHES 1
#endif
constexpr int N_PHASES = 16;

struct Args { const void* in[21]; float* out; unsigned char* ws; int ph_lo, ph_hi; };
static_assert(sizeof(Args) == 23 * 8 + 8, "no padding");

__device__ __forceinline__ float wave_sum(float v) { v += shx<1>(v); v += shx<2>(v); v += shx<4>(v); v += shx<8>(v); v += shx<16>(v); return add_x32(v); }
__device__ const float INVF[32] = { 1.000000000e+00f, 7.498942018e-01f, 5.623413324e-01f, 4.216965139e-01f, 3.162277639e-01f, 2.371373922e-01f, 1.778279394e-01f, 1.333521456e-01f, 1.000000015e-01f, 7.498941571e-02f, 5.623412877e-02f,
    4.216964915e-02f, 3.162277862e-02f, 2.371373586e-02f, 1.778279431e-02f, 1.333521493e-02f, 9.999999776e-03f, 7.498942316e-03f, 5.623413250e-03f, 4.216964822e-03f, 3.162277862e-03f, 2.371373819e-03f, 1.778279431e-03f,
    1.333521446e-03f, 1.000000047e-03f, 7.498941850e-04f, 5.623413017e-04f, 4.216965463e-04f, 3.162277862e-04f, 2.371373848e-04f, 1.778279402e-04f, 1.333521504e-04f };

struct WSrc { const float *w_in, *attn_norm, *w_uq, *q_norm, *w_ukv, *kv_norm, *w_out, *w_gate, *w_up, *ffn_norm, *w_down; };
__device__ __forceinline__ int ckv_slot(int p) { const int x = p & 127; if (x < 16) return -1; const int s = ((p >> 7) ? 112 : 0) + x - 16; return s < 128 ? s : -1; }
__device__ __forceinline__ bool src_in(const WSrc& w, int n, int k, const float*& p, float& g) {
    const int pn = n >> 8, q = n & 255, bj = q >> 7, x = q & 127, wc = x >> 5, y = x & 31, rp = 64 * wc + 32 * bj + y; int c;
    switch (pn) {
        case 0: case 1: c = 256 * pn + rp; break;
        case 2: case 3: c = 512 + 256 * (pn - 2) + rp; break;
        case 4: case 5: c = 1024 + 256 * (pn - 4) + q; break;
        case 6: c = 1536 + q; break;
        case 7: if (x < 16) c = 1920 + 16 * bj + x; else { const int s = ckv_slot(q); if (s < 0) return false; c = 1792 + s; } break;
        case 8: c = 1952 + rp; break;
        case 9: c = 2208 + rp; break;
        case 10: c = 2464 + q; break;
        default: c = 2720 + q; break;
    }
    p = w.w_in + (size_t)k * IN_COLS + c; g = w.attn_norm[k]; return true;
}
__device__ __forceinline__ bool src_uq(const WSrc& w, int n, int k, const float*& p, float& g) {
    const int pn = n >> 8, q = n & 255, bj = q >> 7, x = q & 127, wc = x >> 5, y = x & 31, head = 2 * pn + (wc >> 1); int c;
    if ((wc & 1) == 0) c = head * 96 + 32 * bj + y; else { if (y >= 16) return false; c = head * 96 + 64 + 16 * bj + y; }
    p = w.w_uq + (size_t)k * 384 + c; g = w.q_norm[k]; return true;
}
__device__ __forceinline__ bool src_ukv(const WSrc& w, int n, int k, const float*& p, float& g) {
    const int pn = n >> 8, q = n & 255, bj = q >> 7, x = q & 127, wc = x >> 5, y = x & 31, head = 2 * pn + (wc >> 1), c = head * 128 + 64 * (wc & 1) + 32 * bj + y;
    const int s = ckv_slot(k); if (s < 0) return false;
    p = w.w_ukv + (size_t)s * 512 + c; g = w.kv_norm[s]; return true;
}
__device__ __forceinline__ bool src_out(const WSrc& w, int n, int k, const float*& p, float& g) { p = w.w_out + (size_t)k * 1024 + n; g = 1.0f; return true; }
__device__ __forceinline__ bool src_gu(const WSrc& w, int n, int k, const float*& p, float& g) { const int c = 128 * (n >> 8) + (n & 127); p = ((n >> 7) & 1 ? w.w_up : w.w_gate) + (size_t)k * FFH + c; g = w.ffn_norm[k]; return true; }
__device__ __forceinline__ bool src_dn(const WSrc& w, int n, int k, const float*& p, float& g) { p = w.w_down + (size_t)k * 1024 + n; g = 1.0f; return true; }

template <int WHICH> __device__ __forceinline__ void wconv_item(const WSrc& w, bf16* WT, int K, int N, LAS float* scr, int item, int lane) {
    const int nblk = N / 32, kb = item / nblk, nb = item % nblk, k0 = 64 * kb, n0 = 32 * nb;
    const int n4 = n0 + 4 * (lane & 7);
    f32x4 vv[8];
#pragma unroll
    for (int i = 0; i < 8; ++i) { const int k = k0 + 8 * i + (lane >> 3); const float* p = nullptr; float g = 0.f; bool ok;
        if (WHICH == 0) ok = src_in(w, n4, k, p, g); else if (WHICH == 1) ok = src_uq(w, n4, k, p, g); else if (WHICH == 2) ok = src_ukv(w, n4, k, p, g); else if (WHICH == 3) ok = src_out(w, n4, k, p, g); else if (WHICH == 4) ok = src_gu(w, n4, k, p, g); else ok = src_dn(w, n4, k, p, g);
        vv[i] = ok ? *(const GAS f32x4*)p * g : (f32x4){0.f, 0.f, 0.f, 0.f}; }
#pragma unroll
    for (int i = 0; i < 8; ++i) { LAS float* d = scr + (8 * i + (lane >> 3)) * 33 + 4 * (lane & 7); d[0] = vv[i].x; d[1] = vv[i].y; d[2] = vv[i].z; d[3] = vv[i].w; }
    LDS_WAIT(); asm volatile("" ::: "memory");
    const int c = lane & 7;
#pragma unroll
    for (int j = 0; j < 4; ++j) { const int n = (lane >> 3) + 8 * j; const LAS float* s = scr + (8 * c) * 33 + n;
        v4u o; o.x = pk2(s[0 * 33], s[1 * 33]); o.y = pk2(s[2 * 33], s[3 * 33]); o.z = pk2(s[4 * 33], s[5 * 33]); o.w = pk2(s[6 * 33], s[7 * 33]);
        *(GAS v4u*)(WT + (size_t)(n0 + n) * K + k0 + 8 * c) = o; }
    LDS_WAIT(); asm volatile("" ::: "memory");
}
struct Args;
__device__ __forceinline__ int cv_next(gu32* ctr, int gw, int prev, int NGW, int lane) {
    if (!ctr) return prev < 0 ? gw : prev + NGW;
    if (prev >= 0 && (prev & 1) == 0) return prev + 1;
    unsigned v = 0; if (lane == 0) v = __hip_atomic_fetch_add(ctr, 2u, __ATOMIC_RELAXED, __HIP_MEMORY_SCOPE_AGENT);
    return (int)__builtin_amdgcn_readfirstlane((int)v);
}
__device__ __forceinline__ void convert_group(const __attribute__((address_space(4))) Args* a, unsigned char* ws, int layer, int grp, LAS unsigned char* lds, int gw, int NGW, int wave, int lane, gu32* ctr = nullptr) {
    WSrc w;
    w.w_in = (const float*)a->in[3] + (size_t)layer * 1024 * IN_COLS; w.attn_norm = (const float*)a->in[2] + layer * 1024;
    w.w_uq = (const float*)a->in[10] + (size_t)layer * 256 * 384; w.q_norm = (const float*)a->in[9] + layer * 256;
    w.w_ukv = (const float*)a->in[12] + (size_t)layer * 128 * 512; w.kv_norm = (const float*)a->in[11] + layer * 128;
    w.w_out = (const float*)a->in[15] + (size_t)layer * 1024 * 1024; w.ffn_norm = (const float*)a->in[16] + layer * 1024;
    w.w_gate = (const float*)a->in[17] + (size_t)layer * 1024 * FFH; w.w_up = (const float*)a->in[18] + (size_t)layer * 1024 * FFH; w.w_down = (const float*)a->in[19] + (size_t)layer * FFH * 1024;
    LAS float* scr = (LAS float*)(lds + wave * 16384);
    if (grp == 0) {
        constexpr int I0 = (1024 / 64) * (NIN / 32), I1 = (256 / 64) * (512 / 32), I2 = I1;
        for (int it = cv_next(ctr, gw, -1, NGW, lane); it < I0 + I1 + I2; it = cv_next(ctr, gw, it, NGW, lane)) {
            if (it < I0) wconv_item<0>(w, (bf16*)(ws + WS_WIN), 1024, NIN, scr, it, lane);
            else if (it < I0 + I1) wconv_item<1>(w, (bf16*)(ws + WS_WUQ), 256, 512, scr, it - I0, lane);
            else wconv_item<2>(w, (bf16*)(ws + WS_WUKV), 256, 512, scr, it - I0 - I1, lane);
        }
    } else {
        constexpr int I0 = (1024 / 64) * (1024 / 32), I1 = (1024 / 64) * (NGU / 32), I2 = (FFH / 64) * (1024 / 32);
        for (int it = cv_next(ctr, gw, -1, NGW, lane); it < I0 + I1 + I2; it = cv_next(ctr, gw, it, NGW, lane)) {
            if (it < I0) wconv_item<3>(w, (bf16*)(ws + WS_WOUT), 1024, 1024, scr, it, lane);
            else if (it < I0 + I1) wconv_item<4>(w, (bf16*)(ws + WS_WGU), 1024, NGU, scr, it - I0, lane);
            else wconv_item<5>(w, (bf16*)(ws + WS_WDN), FFH, 1024, scr, it - I0 - I1, lane);
        }
    }
}

typedef const __attribute__((address_space(4))) Args* KArgs;
#define P_(T, OFF) ((T*)(ws + (OFF)))
#define ENV() KArgs ap = (KArgs)__builtin_amdgcn_kernarg_segment_ptr(); asm volatile("" : "+s"(ap)); unsigned char* const ws = ap->ws; float* const out = ap->out; (void)out; \
    int tid_o = threadIdx.x; asm volatile("" : "+v"(tid_o)); const int lane_o = tid_o & 63, wave = __builtin_amdgcn_readfirstlane(tid_o >> 6); (void)lane_o; \
    const int G = gridDim.x, bx = blockIdx.x, vcu = (G % 8 == 0) ? (bx % 8) * (G / 8) + bx / 8 : bx, gw = vcu * NWAVES + wave, NGW = G * NWAVES; (void)gw; (void)NGW
#ifndef PROBE_DUP
#define PROBE_DUP 0
#endif
#ifdef PROBE_KV0
#define PROBE_KVARG , (rep == 0 ? 1 : 0)
#else
#define PROBE_KVARG
#endif
#ifndef ATT
#define ATT at3
#endif
#ifndef PROBE_M1S
#define PROBE_M1S 1
#endif
#define NREP(j) (((PROBE_DUP >> (j)) & 1) ? 2 : 1)
__device__ __forceinline__ bool ph_in(int k) { KArgs ap = (KArgs)__builtin_amdgcn_kernarg_segment_ptr(); return ap->ph_lo <= k && k < ap->ph_hi; }
__device__ __forceinline__ void grid_bar(int k, LAS unsigned char* L) {
    if (MK_N_LAUNCHES != 1) return;
    if (!(ph_in(k) && ph_in(k + 1))) return;
    KArgs ap = (KArgs)__builtin_amdgcn_kernarg_segment_ptr();
    XcdBarrier b; b.bar = (unsigned*)(ap->ws + WS_CTL) + CW_BAR; b.x = xb_xcc_id(); b.st = (volatile LAS unsigned*)(L + MISC_OFF) + 8;
    xcd_barrier(b);
#ifdef PROBE_XBAR
    xcd_barrier(b);
#endif
}
template <bool RELEASE> __device__ __forceinline__ void panel_barrier(gu32* cnt, unsigned expected, gu32* tmo) {
    asm volatile("s_waitcnt vmcnt(0)" ::: "memory");
    __syncthreads();
    if (threadIdx.x == 0) {
        if (RELEASE) { __builtin_amdgcn_fence(__ATOMIC_RELEASE, "agent"); asm volatile("s_waitcnt vmcnt(0)" ::: "memory"); }
        (void)__hip_atomic_fetch_add(cnt, 1u, __ATOMIC_RELAXED, __HIP_MEMORY_SCOPE_AGENT);
        __builtin_amdgcn_fence(__ATOMIC_ACQUIRE, "agent");
        unsigned sp = 0;
        while (__hip_atomic_load(cnt, __ATOMIC_RELAXED, __HIP_MEMORY_SCOPE_AGENT) < expected) { __builtin_amdgcn_s_sleep(2);
            if ((++sp & 255u) == 0u) { if (__hip_atomic_load(tmo, __ATOMIC_RELAXED, __HIP_MEMORY_SCOPE_AGENT)) break; if (sp > (1u << 20)) { atomicAdd((unsigned*)tmo, 1u); break; } } }
        asm volatile("s_waitcnt vmcnt(0)" ::: "memory");
    }
    __syncthreads();
}
template <class Sched> __device__ __forceinline__ void prep_row_scales(const Sched& S_, const float* ssq, float inv_n, LAS unsigned char* L) {
    Sched S = S_; asm volatile("" : "+s"(S.c));
    LAS float* tab = (LAS float*)(L + RS_OFF); int t = threadIdx.x; asm volatile("" : "+v"(t));
    if (t < 256) {
        f32x4 v[8]; bool ok[8];
#pragma unroll
        for (int i = 0; i < 8; ++i) { pg8::Unit u; ok[i] = S.next(i, u); if (ok[i]) v[i] = *(const GAS f32x4*)(ssq + (size_t)(u.pm * 256 + t) * 4); }
#pragma unroll
        for (int i = 0; i < 8; ++i) if (ok[i]) tab[i * 256 + t] = 1.0f / sqrtf(((v[i].x + v[i].y) + (v[i].z + v[i].w)) * inv_n + NORM_EPS);
    }
    __syncthreads();
}
__global__ void __launch_bounds__(NWAVES * 64, 2) hyb_fwd(Args args) {
    extern __shared__ __attribute__((aligned(16))) unsigned char lds[];
    LAS unsigned char* L = (LAS unsigned char*)lds;
    volatile LAS unsigned* MISC = (volatile LAS unsigned*)(L + MISC_OFF);
    for (int u = threadIdx.x; u < (LDS_BYTES - LDSCTL_OFF) / 4; u += NWAVES * 64) ((LAS unsigned*)(L + LDSCTL_OFF))[u] = 0u;
    __syncthreads();
    if (MK_N_LAUNCHES == 1) { (void)xcd_barrier_post((unsigned*)(args.ws + WS_CTL) + CW_BAR, MISC + 8); }

    if (ph_in(0)) for (int rep = 0; rep < NREP(7); ++rep) {
        { ENV(); convert_group(ap, ws, 0, 0, L, gw, NGW, wave, lane_o); }
        { ENV(); convert_group(ap, ws, 0, 1, L, gw, NGW, wave, lane_o); }
        { ENV(); const float* x_in = (const float*)ap->in[0]; bf16* XB = P_(bf16, WS_XB); float* SSQ = P_(float, WS_SSQ);
          for (int m = gw; m < MTOK; m += 2 * NGW) {
            f32x4 v[2][4]; float s[2];
#pragma unroll
            for (int k = 0; k < 2; ++k) { const GAS f32x4* xr = (const GAS f32x4*)(x_in + (size_t)(m + k * NGW) * DMODEL) + lane_o;
#pragma unroll
                for (int j = 0; j < 4; ++j) v[k][j] = xr[64 * j]; }
#pragma unroll
            for (int k = 0; k < 2; ++k) { GAS unsigned long long* o8 = (GAS unsigned long long*)(XB + (size_t)(m + k * NGW) * DMODEL) + lane_o; s[k] = 0.f;
#pragma unroll
                for (int j = 0; j < 4; ++j) { const f32x4 w = v[k][j]; s[k] += (w.x * w.x + w.y * w.y) + (w.z * w.z + w.w * w.w); o8[64 * j] = (unsigned long long)pk2(w.x, w.y) | ((unsigned long long)pk2(w.z, w.w) << 32); }
                s[k] = wave_sum(s[k]);
                if (lane_o == 0) *(GAS f32x4*)(SSQ + (size_t)(m + k * NGW) * 4) = (f32x4){s[k], 0.f, 0.f, 0.f}; }
          } }
        { ENV(); const int* pos = (const int*)ap->in[1]; float* T64 = P_(float, WS_T64); float* TM = P_(float, WS_TM);
          for (int i = bx * (NWAVES * 64) + tid_o; i < MTOK * 32; i += G * NWAVES * 64) {
            const int row = i >> 5, f = i & 31; const float ang = (float)pos[row] * INVF[f];
            const double ad = (double)ang, kd = __builtin_rint(ad * 0.15915494309189535), rd = __builtin_fma(-kd, 6.283185307179586, ad);
            const float rev = (float)(rd * 0.15915494309189535), sn = __builtin_amdgcn_sinf(rev), cs = __builtin_amdgcn_cosf(rev);
            T64[(size_t)row * 64 + f] = cs; T64[(size_t)row * 64 + 32 + f] = sn;
            if ((f & 1) == 0) { TM[(size_t)row * 32 + (f >> 1)] = cs; TM[(size_t)row * 32 + 16 + (f >> 1)] = sn; }
          } }
    }
    grid_bar(0, L);

#pragma unroll 1
    for (int layer = 0; layer < DEPTH; ++layer) {
        const int P = 1 + 7 * layer;
        if (ph_in(P)) {
            ENV();
            pg8::Gemm g{P_(bf16, WS_XB), P_(const bf16, WS_WIN), MTOK, NIN, DMODEL}; pg8::StaticOrder S; S.init(MTOK, NIN, G, bx);
            prep_row_scales(S, P_(const float, WS_SSQ), 1.0f / 1024.0f, L);
            pg8::EpiG1 E{ws, layer, (const LAS float*)(L + RS_OFF)};
            for (int rep = 0; rep < NREP(0); ++rep) pg8::gemm_phase<pg8::EpiG1, pg8::StaticOrder, true, true>(L, g, S, E);
        }
        grid_bar(P, L);
        if (ph_in(P + 1)) {
            for (int rep = 0; rep < NREP(1); ++rep) {
            { ENV(); int K1 = 256; asm volatile("" : "+s"(K1));
              pg8::Gemm g{P_(bf16, WS_CQ), P_(const bf16, WS_WUQ), MTOK, 512, K1}; pg8::StaticOrder S; S.init(MTOK, 512, G, bx);
              pg8::EpiMQ E{ws}; pg8::gemm_phase<pg8::EpiMQ, pg8::StaticOrder, true, true>(L, g, S, E); }
            { ENV(); int K1 = 256; asm volatile("" : "+s"(K1));
              pg8::Gemm g{P_(bf16, WS_CKV), P_(const bf16, WS_WUKV), MTOK, 512, K1}; pg8::StaticOrder S; S.init(MTOK, 512, G, (bx + G / 2) % G);
              pg8::EpiMKV E{ws}; pg8::gemm_phase<pg8::EpiMKV, pg8::StaticOrder, true, true>(L, g, S, E); }
            for (int rs_ = 0; rs_ < PROBE_M1S; ++rs_) { ENV(); for (int u = bx; u < 256; u += G) ret::state_item(P_(bf16, WS_RK), P_(bf16, WS_RV), P_(float, WS_AST), u >> 7, (u >> 5) & 3, u & 31, (char*)lds); }
            }
        }
        grid_bar(P + 1, L);
        if (ph_in(P + 2)) {
            for (int rep = 0; rep < NREP(2); ++rep) {
            const unsigned myx = xb_xcc_id() & 7u;
            for (unsigned s = 0; s < 8; ++s) { const unsigned xq = (myx + s) & 7u;
                gu32* qp; { ENV(); qp = (gu32*)(ws + WS_CTL) + CW_Q + layer * 1024 + rep * 512 + 64 * xq; }
#define POP_SYNC() do { int t0_ = threadIdx.x; asm volatile("" : "+v"(t0_)); __syncthreads(); if (t0_ == 0) MISC[0] = __hip_atomic_fetch_add(qp, 1u, __ATOMIC_RELAXED, __HIP_MEMORY_SCOPE_AGENT); __syncthreads(); idx = (unsigned)__builtin_amdgcn_readfirstlane((int)MISC[0]); } while (0)
                unsigned idx; POP_SYNC();
                while (idx < 128u) {
                    ENV();
                    if (idx >= 96u) { ret::ret_unit(P_(bf16, WS_RQ), P_(bf16, WS_RK), P_(bf16, WS_RV), P_(bf16, WS_RG), P_(float, WS_AST), (const float*)ap->in[13] + layer * 256, (const float*)ap->in[14] + layer * 256,
                                                    P_(bf16, WS_MIX), (int)(xq >> 2), (int)(xq & 3u), 127 - (int)idx, (char*)lds); POP_SYNC(); continue; }
                    const int qb = 31 - (int)(idx / 3u), kind = (int)(idx % 3u), b = (int)(xq >> 2), head = (int)(xq & 3u);
                    const size_t r0 = (size_t)b * SEQ, rq = r0 + 256 * qb;
                    if (kind < 2) { const float* km = (const float*)((gu32*)(ws + WS_CTL) + CW_KM);
                        const float bnd = __hip_atomic_load(km + 256 + layer * 1024 + (b * 32 + qb) * 8 + head * 2 + kind, __ATOMIC_RELAXED, __HIP_MEMORY_SCOPE_AGENT) * __hip_atomic_load(km + layer * 64 + b * 8 + head * 2 + kind, __ATOMIC_RELAXED, __HIP_MEMORY_SCOPE_AGENT) * 1.01f;
                        const bf16* q_ = P_(bf16, WS_DQ) + rq * 512 + head * 128 + kind * 64; const bf16* k_ = P_(bf16, WS_DK) + r0 * 512 + head * 128 + kind * 64; const bf16* v_ = P_(bf16, WS_DV) + r0 * 512 + head * 128;
                        bf16* o_ = (bf16*)out + rq * 1024 + head * 256 + kind * 128;
                        if (bnd < 100.f) idx = ATT::attn_unit<64, 128, 512, 512, 512, 1024, 1>(q_, k_, v_, o_, qb, (char*)lds, qp, MISC);
                        else idx = ATT::attn_unit<64, 128, 512, 512, 512, 1024, 0>(q_, k_, v_, o_, qb, (char*)lds, qp, MISC); }
                    else idx = ATT::attn_unit<96, 64, 384, 384, 256, 1024>(P_(bf16, WS_MQ) + rq * 384 + head * 96, P_(bf16, WS_MK) + r0 * 384 + head * 96, P_(bf16, WS_MV) + r0 * 256 + head * 64, P_(bf16, WS_MIX) + rq * 1024 + 512 + head * 64, qb, (char*)lds, qp, MISC PROBE_KVARG);
                } }
            { ENV(); if (layer == 1 || G != 256) convert_group(ap, ws, 1, layer == 0 ? 0 : 1, L, gw, NGW, wave, lane_o); }
            }
        }
        grid_bar(P + 2, L);
        if (ph_in(P + 4)) {
            ENV();
            pg8::Gemm g{P_(bf16, WS_MIX), P_(const bf16, WS_WOUT), MTOK, DMODEL, DMODEL}; pg8::StaticOrder S; S.init(MTOK, DMODEL, G, bx);
            if (G == 256) {
                pg8::Unit u0; (void)S.next(0, u0);
                { const float s1 = wave_sum(((const float*)ap->in[4])[layer * 64 + lane_o] * ((const float*)ap->in[5])[layer * 64 + lane_o]), s2 = wave_sum(((const float*)ap->in[6])[layer * 64 + lane_o] * ((const float*)ap->in[7])[layer * 64 + lane_o]);
                  const float lam_init = layer == 0 ? 0.2f : 0.35550906759096934f, lam = __builtin_amdgcn_exp2f(s1 * LOG2E) - __builtin_amdgcn_exp2f(s2 * LOG2E) + lam_init;
                  const float* subln = (const float*)ap->in[8] + layer * 128;
                  const size_t r0 = (size_t)u0.pm * 256 + (size_t)u0.pn * 64 + (size_t)wave * 8;
                  ret::combine_rows4((const bf16*)out, subln, lam, 1.0f - lam_init, P_(bf16, WS_MIX), r0, (size_t)1, lane_o);
                  ret::combine_rows4((const bf16*)out, subln, lam, 1.0f - lam_init, P_(bf16, WS_MIX), r0 + 4, (size_t)1, lane_o); }
                panel_barrier<false>((gu32*)(ws + WS_CTL) + CW_P + (layer * 64 + u0.pm) * 64, 4u, (gu32*)(ws + WS_CTL) + CW_TMO);
                pg8::EpiRes E{ws, 0, 0, nullptr, nullptr};
                for (int rep = 0; rep < NREP(4); ++rep) { E.dry = rep; pg8::gemm_phase<pg8::EpiRes, pg8::StaticOrder, false, true>(L, g, S, E); }
            }
        }
        grid_bar(P + 4, L);
        if (ph_in(P + 5)) {
            ENV();
            pg8::Gemm g{P_(bf16, WS_XB), P_(const bf16, WS_WGU), MTOK, NGU, DMODEL}; pg8::StaticOrder S; S.init(MTOK, NGU, G, bx);
            prep_row_scales(S, P_(const float, WS_SSQ), 1.0f / 1024.0f, L);
            pg8::EpiGU E{ws, (const LAS float*)(L + RS_OFF)};
            for (int rep = 0; rep < NREP(5); ++rep) pg8::gemm_phase<pg8::EpiGU, pg8::StaticOrder, true, true>(L, g, S, E);
            if (layer == 0 && G == 256 && bx >= 128) convert_group(ap, ws, 1, 0, L, (bx - 128) * NWAVES + wave, 128 * NWAVES, wave, lane_o);
        }
        grid_bar(P + 5, L);
        if (ph_in(P + 6)) {
            ENV();
            pg8::Gemm g{P_(bf16, WS_H), P_(const bf16, WS_WDN), MTOK, DMODEL, FFH}; pg8::StaticOrder S; S.init(MTOK, DMODEL, G, bx);
            const bool ffin = layer == 1 && G == 256 && ph_in(15);
            pg8::EpiRes E{ws, 0, ffin ? 1 : 0, (const float*)ap->in[20], out};
            if (G == 256) for (int rep = 0; rep < NREP(6); ++rep) { E.dry = rep; pg8::gemm_phase<pg8::EpiRes, pg8::StaticOrder, false, true>(L, g, S, E); }
        }
        if (!(layer == 1 && gridDim.x == 256 && ph_in(P + 6))) grid_bar(P + 6, L);
    }
    if (ph_in(15) && !(gridDim.x == 256 && ph_in(14))) {
        for (int rep = NREP(8) - 1; rep >= 0; --rep) {
        ENV(); const float* fn = (const float*)ap->in[20]; const float* SSQ = P_(float, WS_SSQ);
        for (int m = gw; m < MTOK; m += 2 * NGW) {
            bf16x8 v[2][2]; f32x4 s4[2];
#pragma unroll
            for (int k = 0; k < 2; ++k) { const bf16* xr = P_(bf16, WS_XB) + (size_t)(m + k * NGW) * DMODEL + 8 * lane_o; s4[k] = *(const f32x4*)(SSQ + (size_t)(m + k * NGW) * 4);
                v[k][0] = *(const bf16x8*)xr; v[k][1] = *(const bf16x8*)(xr + 512); }
#pragma unroll
            for (int k = 0; k < 2; ++k) { float* orow = out + (size_t)(m + k * NGW) * DMODEL + 8 * lane_o;
                const float rs = 1.0f / sqrtf(((s4[k][0] + s4[k][1]) + (s4[k][2] + s4[k][3])) * (1.0f / 1024.0f) + NORM_EPS);
#pragma unroll
                for (int hh = 0; hh < 2; ++hh) { const f32x4 g0 = *(const f32x4*)(fn + hh * 512 + 8 * lane_o), g1 = *(const f32x4*)(fn + hh * 512 + 8 * lane_o + 4); const bf16x8 b = v[k][hh];
                    const f32x4 w0 = {at::bf2f(b[0]) * rs * g0[0], at::bf2f(b[1]) * rs * g0[1], at::bf2f(b[2]) * rs * g0[2], at::bf2f(b[3]) * rs * g0[3]}, w1 = {at::bf2f(b[4]) * rs * g1[0], at::bf2f(b[5]) * rs * g1[1], at::bf2f(b[6]) * rs * g1[2], at::bf2f(b[7]) * rs * g1[3]};
                    if (rep == 0) { *(f32x4*)(orow + hh * 512) = w0; *(f32x4*)(orow + hh * 512 + 4) = w1; } } }
        }
        }
    }
}

extern "C" void kernel_launch(void* const* d_in, const int* in_sizes, int n_in, void* d_out, int out_size, void* d_ws, size_t ws_size, hipStream_t stream) {
    static int grid = 0;
    if (grid == 0) {
        if (n_in != 21 || in_sizes[0] != MTOK * DMODEL || out_size != MTOK * DMODEL || ws_size < WS_END) { fprintf(stderr, "kernel_launch: unexpected shapes (n_in %d, in0 %d, out %d, ws %zu)\n", n_in, n_in > 0 ? in_sizes[0] : -1, out_size, ws_size); grid = -1; return; }
        int dev = 0, cus = 0, per_cu = 0;
        if (hipGetDevice(&dev) != hipSuccess || hipDeviceGetAttribute(&cus, hipDeviceAttributeMultiprocessorCount, dev) != hipSuccess) { grid = -1; return; }
        if (hipFuncSetAttribute((const void*)hyb_fwd, hipFuncAttributeMaxDynamicSharedMemorySize, LDS_BYTES) != hipSuccess) { fprintf(stderr, "kernel_launch: hipFuncSetAttribute failed\n"); grid = -1; return; }
        if (hipOccupancyMaxActiveBlocksPerMultiprocessor(&per_cu, (const void*)hyb_fwd, NWAVES * 64, LDS_BYTES) != hipSuccess) per_cu = 0;
        (void)hipGetLastError();
        if (per_cu < 1 || cus * per_cu < 256) { fprintf(stderr, "kernel_launch: %d CUs x %d resident workgroups cannot hold the 256-workgroup grid\n", cus, per_cu); grid = -1; return; }
        grid = 256;
    }
    if (grid < 0) return;
    (void)hipMemsetAsync((char*)d_ws + WS_CTL, 0, CTL_ZERO_BYTES, stream);
    Args a{};
    for (int i = 0; i < 21; ++i) a.in[i] = d_in[i];
    a.out = (float*)d_out; a.ws = (unsigned char*)d_ws;
    if (MK_N_LAUNCHES == 1) { a.ph_lo = 0; a.ph_hi = N_PHASES; hipLaunchKernelGGL(hyb_fwd, dim3(grid), dim3(NWAVES * 64), LDS_BYTES, stream, a); }
    else for (int p = 0; p < N_PHASES; ++p) { a.ph_lo = p; a.ph_hi = p + 1; hipLaunchKernelGGL(hyb_fwd, dim3(grid), dim3(NWAVES * 64), LDS_BYTES, stream, a); }
}
```

```cpp
#include <hip/hip_runtime.h>
#include <hip/hip_bf16.h>
#include <cstdio>
#include <cstdint>
#include <cmath>
namespace pg8 {
#define PG8_LAS __attribute__((address_space(3)))
typedef unsigned short bf16_t;
typedef short bf16x8 __attribute__((ext_vector_type(8)));
typedef float f32x4 __attribute__((ext_vector_type(4)));
typedef unsigned u32x4 __attribute__((ext_vector_type(4)));
constexpr int BM = 256, BK = 64, HALF = 128, HTB = HALF * BK * 2  , STAGE_BYTES = 8 * HTB, NXCD = 8, WGM = 8;

__host__ __device__ __forceinline__ int lds_byte(int r, int c) { const int st = (r >> 4) * 2 + (c >> 5), rr = r & 15, cc = c & 31, ob = rr * 64 + cc * 2; return st * 1024 + (ob ^ (((ob >> 9) & 1) << 5)); }
__host__ __device__ __forceinline__ void stage_rc(int b, int& R, int& C) { const int st = b / 1024, sb = b % 1024, swz = sb ^ (((sb >> 9) & 1) << 5); R = (st >> 1) * 16 + swz / 64; C = (st & 1) * 32 + (swz % 64) / 2; }
__host__ __device__ __forceinline__ int perm32(int rho) { const int n = rho >> 4, i = rho & 15; return 8 * (i >> 2) + 4 * n + (i & 3); }

struct Unit { int pm, pn, half, ord; };
struct Gemm { const bf16_t* A; const bf16_t* Bt; int M, N, K; };

struct StaticOrder {
    int nM, nN, nwg, G, c;
    __host__ __device__ void init(int M, int N, int G_, int c_) { nM = M / BM; nN = N / BM; nwg = nM * nN; G = G_; c = c_; }
    __host__ __device__ __attribute__((always_inline)) bool next(int i, Unit& u) const {
        const long L = (long)i * G + c; if (L >= nwg) return false;
        int wgid = (int)L; { const int q = nwg / NXCD, r = nwg % NXCD, xcd = wgid % NXCD, off = wgid / NXCD; wgid = (xcd < r ? xcd * (q + 1) : r * (q + 1) + (xcd - r) * q) + off; }
        const int nig = WGM * nN, gid = wgid / nig, fm = gid * WGM, gsz = (nM - fm) < WGM ? (nM - fm) : WGM;
        u.pm = fm + ((wgid % nig) % gsz); u.pn = (wgid % nig) / gsz; u.half = 0; u.ord = i; return true;
    }
    __device__ __forceinline__ void a_ready(const Unit&) const {}
    __device__ __forceinline__ void done(const Unit&) const {}
};
struct StaticOrderSplit {
    StaticOrder so; int nfull, rem, mode;
    __host__ __device__ void init(int M, int N, int G_, int c_, int mode_ = 0) { so.init(M, N, G_, c_); nfull = so.nwg / G_; rem = so.nwg % G_; mode = mode_; }
    __host__ __device__ __attribute__((always_inline)) bool next(int i, Unit& u) const {
        if (mode == 1 && i >= nfull) return false;
        if (mode == 2) { if (i > 0) return false; i = nfull; }
        if (i < nfull || 2 * rem != so.G) return so.next(i, u);
        if (i > nfull) return false;
        StaticOrder t = so; t.c = so.c >> 1; t.G = so.G; const long L = (long)nfull * so.G + (so.c >> 1); if (L >= so.nwg) return false;
        StaticOrder t2 = so; t2.c = (int)(L - (long)nfull * so.G);
        if (!t2.next(nfull, u)) return false; u.half = 1 + (so.c & 1); return true;
    }
    __device__ __forceinline__ void a_ready(const Unit&) const {}
    __device__ __forceinline__ void done(const Unit&) const {}
};

__device__ __forceinline__ unsigned cvt_pk_bf16(float lo, float hi) { unsigned r; asm volatile("v_cvt_pk_bf16_f32 %0, %1, %2" : "=v"(r) : "v"(lo), "v"(hi)); return r; }
typedef float f32x2 __attribute__((ext_vector_type(2)));
template <class Epi, class Sched, bool ALIGN_EPI = false, bool SP2 = false, bool HALF_OK = false>
__device__ __forceinline__ void gemm_phase(PG8_LAS unsigned char* lds, const Gemm g, const Sched& S, const Epi& E) {
    int tid_ = threadIdx.x; asm volatile("" : "+v"(tid_));
    const int tid = tid_, wid = __builtin_amdgcn_readfirstlane(tid >> 6), lane = tid & 63, wr = wid >> 2, wc = wid & 3, fr = lane & 15, fq = lane >> 4;
    const int K = g.K, nt = K / BK;
    unsigned voffA[2], voffB[2];
#pragma unroll
    for (int i = 0; i < 2; ++i) { int R, C; stage_rc(tid * 16 + i * 8192, R, C); const int Rb = Epi::PERM ? ((R & ~31) + perm32(R & 31)) : R;
        voffA[i] = (unsigned)(R * K + C) * 2u; voffB[i] = (unsigned)(Rb * K + C) * 2u; }
    const size_t kstep = (size_t)(BK * 2);
    const size_t hstep = (size_t)HALF * K * 2;
    const size_t tstep = 2 * hstep;
    const unsigned ldsw = (unsigned)wid * 1024u;
    const int aoff = lds_byte(wr * 64 + fr, fq * 8), boff = lds_byte(wc * 32 + fr, fq * 8);
#define PG8_SA(b, h) (((b) * 2 + (h)) * HTB)
#define PG8_SB(b, h) ((4 + (b) * 2 + (h)) * HTB)
#define PG8_STAGE(bufoff, gbase, voff) do { _Pragma("unroll") for (int _i = 0; _i < 2; ++_i) \
        __builtin_amdgcn_global_load_lds((const unsigned*)((const char*)(gbase) + (voff)[_i]), (PG8_LAS unsigned*)(lds + (bufoff) + ldsw + _i * 8192), 16, 0, 0); } while (0)
#define PG8_LDA(dst, b, h) do { _Pragma("unroll") for (int m = 0; m < 4; ++m) _Pragma("unroll") for (int k = 0; k < 2; ++k) dst[m][k] = *(const PG8_LAS bf16x8*)(lds + PG8_SA(b, h) + aoff + m * 2048 + k * 1024); } while (0)
#define PG8_LDB(dst, b, h) do { _Pragma("unroll") for (int n = 0; n < 2; ++n) _Pragma("unroll") for (int k = 0; k < 2; ++k) dst[n][k] = *(const PG8_LAS bf16x8*)(lds + PG8_SB(b, h) + boff + n * 2048 + k * 1024); } while (0)
#define PG8_MMA(ai, bj, At, Bt) do { if (HALF_OK && cur.half != 0 && cur.half != (ai) + 1) break; __builtin_amdgcn_s_setprio(1); _Pragma("unroll") for (int m = 0; m < 4; ++m) _Pragma("unroll") for (int n = 0; n < 2; ++n) _Pragma("unroll") for (int k = 0; k < 2; ++k) \
        acc[ai][bj][m][n] = __builtin_amdgcn_mfma_f32_16x16x32_bf16(Bt[n][k], At[m][k], acc[ai][bj][m][n], 0, 0, 0); __builtin_amdgcn_s_setprio(0); } while (0)
#define PG8_WAIT_V(n) asm volatile("s_waitcnt vmcnt(" #n ")" ::: "memory")
#define PG8_WAIT_L(n) asm volatile("s_waitcnt lgkmcnt(" #n ")" ::: "memory")
#define PG8_BAR __builtin_amdgcn_s_barrier()
#define PG8_SCHED __builtin_amdgcn_sched_barrier(0)
    Unit cur, nxt; int ui = 0;
    if (!S.next(0, cur)) return;
    f32x4 acc[2][2][4][2];
#pragma unroll
    for (int a = 0; a < 2; ++a)
#pragma unroll
        for (int b = 0; b < 2; ++b)
#pragma unroll
            for (int m = 0; m < 4; ++m)
#pragma unroll
                for (int n = 0; n < 2; ++n) acc[a][b][m][n] = (f32x4){0.f, 0.f, 0.f, 0.f};
    bf16x8 At[4][2], B0[2][2], B1[2][2];
    const char* cA = (const char*)g.A + (size_t)cur.pm * tstep; const char* cB = (const char*)g.Bt + (size_t)cur.pn * tstep;
    S.a_ready(cur);
    if constexpr (SP2) {
        PG8_STAGE(PG8_SB(0, 0), cB, voffB); PG8_STAGE(PG8_SB(0, 1), cB + hstep, voffB); PG8_STAGE(PG8_SA(0, 0), cA, voffA); PG8_STAGE(PG8_SA(0, 1), cA + hstep, voffA);
        if (wr == 1) PG8_BAR;
        PG8_WAIT_V(2); PG8_BAR;
        PG8_STAGE(PG8_SB(1, 0), cB + kstep, voffB); PG8_STAGE(PG8_SA(1, 0), cA + kstep, voffA); PG8_STAGE(PG8_SB(1, 1), cB + hstep + kstep, voffB);
        PG8_WAIT_V(6); PG8_BAR;
    } else {
        PG8_STAGE(PG8_SB(0, 0), cB, voffB); PG8_STAGE(PG8_SA(0, 0), cA, voffA); PG8_STAGE(PG8_SB(0, 1), cB + hstep, voffB); PG8_STAGE(PG8_SA(0, 1), cA + hstep, voffA);
        if (wr == 1) PG8_BAR;
        PG8_WAIT_V(4); PG8_BAR;
        PG8_STAGE(PG8_SB(1, 0), cB + kstep, voffB); PG8_STAGE(PG8_SA(1, 0), cA + kstep, voffA); PG8_STAGE(PG8_SB(1, 1), cB + hstep + kstep, voffB);
        PG8_WAIT_V(6); PG8_BAR;
    }
    for (;;) {
        const bool has_next = S.next(ui + 1, nxt);
        const char* nA = has_next ? (const char*)g.A + (size_t)nxt.pm * tstep : cA; const char* nB = has_next ? (const char*)g.Bt + (size_t)nxt.pn * tstep : cB;
        for (int t = 0; t < nt; t += 2) {
            const bool last = (t == nt - 2);
            const char* a1 = cA + (size_t)(t + 1) * kstep;
            const char* a2 = last ? nA : cA + (size_t)(t + 2) * kstep; const char* b2 = last ? nB : cB + (size_t)(t + 2) * kstep;
            const char* a3 = a2 + kstep; const char* b3 = b2 + kstep;
            if (last && has_next) S.a_ready(nxt);
            if constexpr (SP2) {
            PG8_LDB(B0, 0, 0); PG8_LDB(B1, 0, 1); PG8_SCHED; PG8_LDA(At, 0, 0); PG8_STAGE(PG8_SA(1, 1), a1 + hstep, voffA);
            PG8_WAIT_V(8); PG8_WAIT_L(0); PG8_BAR; PG8_MMA(0, 0, At, B0); PG8_MMA(0, 1, At, B1); PG8_BAR; PG8_SCHED;
            PG8_LDA(At, 0, 1); PG8_STAGE(PG8_SB(0, 0), b2, voffB); PG8_STAGE(PG8_SB(0, 1), b2 + hstep, voffB); PG8_STAGE(PG8_SA(0, 0), a2, voffA);
            PG8_WAIT_V(8); PG8_WAIT_L(0); PG8_BAR; PG8_MMA(1, 0, At, B0); PG8_MMA(1, 1, At, B1); PG8_BAR; PG8_SCHED;
            PG8_LDB(B0, 1, 0); PG8_LDB(B1, 1, 1); PG8_SCHED; PG8_LDA(At, 1, 0); PG8_STAGE(PG8_SA(0, 1), a2 + hstep, voffA);
            PG8_WAIT_V(8); PG8_WAIT_L(0); PG8_BAR; PG8_MMA(0, 0, At, B0); PG8_MMA(0, 1, At, B1); PG8_BAR; PG8_SCHED;
            PG8_LDA(At, 1, 1); PG8_STAGE(PG8_SB(1, 0), b3, voffB); PG8_STAGE(PG8_SB(1, 1), b3 + hstep, voffB); PG8_STAGE(PG8_SA(1, 0), a3, voffA);
            PG8_WAIT_V(8); PG8_WAIT_L(0); PG8_BAR; PG8_MMA(1, 0, At, B0); PG8_MMA(1, 1, At, B1); PG8_BAR; PG8_SCHED;
            } else {
            PG8_LDB(B0, 0, 0); PG8_SCHED; PG8_LDA(At, 0, 0); PG8_STAGE(PG8_SA(1, 1), a1 + hstep, voffA);
            PG8_WAIT_L(8); PG8_BAR; PG8_WAIT_L(0); PG8_MMA(0, 0, At, B0); PG8_BAR; PG8_SCHED;
            PG8_LDB(B1, 0, 1); PG8_STAGE(PG8_SB(0, 0), b2, voffB);
            PG8_BAR; PG8_WAIT_L(0); PG8_MMA(0, 1, At, B1); PG8_BAR;
            PG8_LDA(At, 0, 1); PG8_STAGE(PG8_SA(0, 0), a2, voffA);
            PG8_BAR; PG8_WAIT_L(0); PG8_MMA(1, 0, At, B0); PG8_BAR; PG8_SCHED;
            PG8_STAGE(PG8_SB(0, 1), b2 + hstep, voffB);
            PG8_WAIT_V(6); PG8_BAR; PG8_MMA(1, 1, At, B1); PG8_BAR;
            PG8_LDB(B0, 1, 0); PG8_SCHED; PG8_LDA(At, 1, 0); PG8_STAGE(PG8_SA(0, 1), a2 + hstep, voffA);
            PG8_WAIT_L(8); PG8_BAR; PG8_WAIT_L(0); PG8_MMA(0, 0, At, B0); PG8_BAR; PG8_SCHED;
            PG8_LDB(B1, 1, 1); PG8_STAGE(PG8_SB(1, 0), b3, voffB);
            PG8_BAR; PG8_WAIT_L(0); PG8_MMA(0, 1, At, B1); PG8_BAR;
            PG8_LDA(At, 1, 1); PG8_STAGE(PG8_SA(1, 0), a3, voffA);
            PG8_BAR; PG8_WAIT_L(0); PG8_MMA(1, 0, At, B0); PG8_BAR; PG8_SCHED;
            PG8_STAGE(PG8_SB(1, 1), b3 + hstep, voffB);
            PG8_WAIT_V(6); PG8_BAR; PG8_MMA(1, 1, At, B1); PG8_BAR;
            }
        }
        if constexpr (ALIGN_EPI) { if (wr == 0) PG8_BAR; }
        if constexpr (!Epi::AFTER_DRAIN) { E(acc, cur, wr, wc, fr, fq); S.done(cur); }
        if (!has_next) break;
#pragma unroll
        for (int a = 0; a < 2; ++a)
#pragma unroll
            for (int b = 0; b < 2; ++b)
#pragma unroll
                for (int m = 0; m < 4; ++m)
#pragma unroll
                    for (int n = 0; n < 2; ++n) acc[a][b][m][n] = (f32x4){0.f, 0.f, 0.f, 0.f};
        cur = nxt; cA = nA; cB = nB; ++ui;
        if constexpr (ALIGN_EPI) { if (wr == 1) PG8_BAR; }
    }
    PG8_WAIT_V(0);
    if constexpr (!ALIGN_EPI) { if (wr == 0) PG8_BAR; }
    PG8_BAR;
    if constexpr (Epi::AFTER_DRAIN) { E.fused(acc, cur, wr, wc, fr, fq, lds, wid, lane); S.done(cur); }
#undef PG8_SA
#undef PG8_SB
#undef PG8_STAGE
#undef PG8_LDA
#undef PG8_LDB
#undef PG8_MMA
#undef PG8_WAIT_V
#undef PG8_WAIT_L
#undef PG8_BAR
#undef PG8_SCHED
}
}

#ifndef PG8_SP2
#define PG8_SP2 true
#endif
#ifndef PG8_ALIGN
#define PG8_ALIGN true
#endif
#define GAS __attribute__((address_space(1)))
#define LAS __attribute__((address_space(3)))
typedef unsigned short bf16;
typedef unsigned v4u __attribute__((ext_vector_type(4)));
typedef float f32x4 __attribute__((ext_vector_type(4)));
typedef short bf16x8 __attribute__((ext_vector_type(8)));
typedef GAS unsigned gu32;
typedef GAS unsigned long long gu64;
#define RLX_AGENT __ATOMIC_RELAXED, __HIP_MEMORY_SCOPE_AGENT
#define LDS_WAIT() asm volatile("s_waitcnt lgkmcnt(0)" ::: "memory")
#define VM_WAIT() asm volatile("s_waitcnt vmcnt(0)" ::: "memory")
__device__ __forceinline__ unsigned long long rt() { return __builtin_amdgcn_s_memrealtime(); }
__device__ __forceinline__ unsigned f2bf(float f) { unsigned u = __builtin_bit_cast(unsigned, f); return (u + 0x7fffu + ((u >> 16) & 1u)) >> 16; }
__device__ __forceinline__ unsigned pk2(float lo, float hi) { return f2bf(lo) | (f2bf(hi) << 16); }

#define XB_TMO      128
#define XB_XCNT(j)  (256  + 64 * (j))
#define XB_XSUB(j)  (1280 + 64 * (j))
#define XB_XGEN(j)  (2304 + 64 * (j))
#define XB_TOP      3328
#define XB_TOPGEN   3392
#define XCD_BAR_WORDS 3456
#define XB_SPIN_CAP (1u << 18)

__device__ __forceinline__ unsigned xb_ld(unsigned* p)              { return __hip_atomic_load(p, __ATOMIC_RELAXED, __HIP_MEMORY_SCOPE_AGENT); }
__device__ __forceinline__ unsigned xb_add(unsigned* p, unsigned v) { return __hip_atomic_fetch_add(p, v, __ATOMIC_RELAXED, __HIP_MEMORY_SCOPE_AGENT); }
__device__ __forceinline__ unsigned xb_xcc_id() { return (unsigned)__builtin_amdgcn_s_getreg((3 << 11) | 20) & 0xFu; }
#define XB_SPIN(cond, bar) do { unsigned _sp = 0; while (cond) { __builtin_amdgcn_s_sleep(1); \
    if ((++_sp & 255u) == 0u) { if (xb_ld(&(bar)[XB_TMO])) break; if (_sp > XB_SPIN_CAP) { atomicAdd(&(bar)[XB_TMO], 1u); break; } } } } while (0)

struct XcdBarrier {
    unsigned* bar; unsigned x;
    volatile LAS unsigned* st;
};

__device__ __forceinline__ XcdBarrier xcd_barrier_post(unsigned* bar, volatile LAS unsigned* st) {
    XcdBarrier b; b.bar = bar; b.x = xb_xcc_id(); b.st = st;
    if (threadIdx.x == 0) (void)xb_add(&bar[XB_XCNT(b.x)], 1u);
    return b;
}
__device__ __forceinline__ void xcd_barrier_complete(unsigned* bar, unsigned x, unsigned& nloc, unsigned& nx, unsigned& xmask) {
    const unsigned G = gridDim.x * gridDim.y * gridDim.z;
    unsigned sum, cnt, mine, msk, sp = 0u;
    for (;;) {
        sum = 0u; cnt = 0u; mine = 0u; msk = 0u;
#pragma unroll
        for (unsigned j = 0; j < 16; ++j) { const unsigned c = xb_ld(&bar[XB_XCNT(j)]); sum += c; cnt += (c > 0u) ? 1u : 0u; msk |= (c > 0u) ? (1u << j) : 0u; mine = (j == x) ? c : mine; }
        if (sum == G) break;
        __builtin_amdgcn_s_sleep(1);
        if ((++sp & 255u) == 0u) { if (xb_ld(&bar[XB_TMO])) break; if (sp > XB_SPIN_CAP) { atomicAdd(&bar[XB_TMO], 1u); break; } }
    }
    nloc = mine > 0u ? mine : 1u; nx = cnt > 0u ? cnt : 1u; xmask = msk | (1u << x);
}

__device__ __forceinline__ void xcd_barrier(const XcdBarrier& b) {
    asm volatile("s_waitcnt vmcnt(0)" ::: "memory");
    __syncthreads();
    if (threadIdx.x == 0) {
        unsigned* bar = b.bar;
        __builtin_amdgcn_s_waitcnt(0);
        unsigned nloc = b.st[0], nx = b.st[1];
        if (nloc == 0u) { unsigned xm; xcd_barrier_complete(bar, b.x, nloc, nx, xm); b.st[0] = nloc; b.st[1] = nx; b.st[2] = xm; }
        const unsigned old = xb_add(&bar[XB_XSUB(b.x)], 1u);
        const unsigned gen = old / nloc;
        __builtin_amdgcn_fence(__ATOMIC_ACQUIRE, "agent");
        if (old + 1u == (gen + 1u) * nloc) {
            __builtin_amdgcn_fence(__ATOMIC_RELEASE, "agent");
            asm volatile("s_waitcnt vmcnt(0)" ::: "memory");
            const unsigned og = xb_add(&bar[XB_TOP], 1u);
            const unsigned tg = og / nx;
            if (og + 1u == (tg + 1u) * nx) {
                const unsigned xm = b.st[2];
#pragma unroll
                for (unsigned j = 0; j < 16; ++j) if ((xm >> j) & 1u) (void)xb_add(&bar[XB_XGEN(j)], 1u);
            } else XB_SPIN(xb_ld(&bar[XB_XGEN(b.x)]) == gen, bar);
            asm volatile("s_waitcnt vmcnt(0)" ::: "memory");
        } else {
            XB_SPIN(xb_ld(&bar[XB_XGEN(b.x)]) == gen, bar);
            asm volatile("s_waitcnt vmcnt(0)" ::: "memory");
        }
    }
    __syncthreads();
}
constexpr int BATCH = 2, SEQ = 8192, DMODEL = 1024, MTOK = BATCH * SEQ, DEPTH = 2;
constexpr int IN_COLS = 2976, NIN = 3072, FFH = 2816, NGU = 2 * FFH;
constexpr float NORM_EPS = 1e-6f;
constexpr float LOG2E = 1.4426950408889634f;
constexpr float C2_DIFF = 0.125f * LOG2E;
constexpr float C2_MLA = 0.10206207261596575f * LOG2E;


template <int K> __device__ __forceinline__ float shx(float v) {
    static_assert(K == 1 || K == 2 || K == 4 || K == 8 || K == 16, "xor distance");
    if constexpr (K == 1) return __builtin_bit_cast(float, __builtin_amdgcn_mov_dpp(__builtin_bit_cast(int, v), 0xB1, 0xF, 0xF, true));
    else if constexpr (K == 2) return __builtin_bit_cast(float, __builtin_amdgcn_mov_dpp(__builtin_bit_cast(int, v), 0x4E, 0xF, 0xF, true));
    else return __builtin_bit_cast(float, __builtin_amdgcn_ds_swizzle(__builtin_bit_cast(int, v), (K << 10) | 0x1F));
}
__device__ __forceinline__ float add_x32(float v) { auto rr = __builtin_amdgcn_permlane32_swap(__float_as_uint(v), __float_as_uint(v), false, false); return __uint_as_float(rr[0]) + __uint_as_float(rr[1]); }
constexpr size_t MiB = 1u << 20;
constexpr size_t WS_CTL = 0, CTL_ZERO_BYTES = 256 * 1024;
constexpr size_t WS_WIN = 1 * MiB, WS_WUQ = 7 * MiB, WS_WUKV = WS_WUQ + 256 * 1024, WS_WOUT = WS_WUKV + 256 * 1024, WS_WGU = WS_WOUT + 2 * MiB, WS_WDN = WS_WGU + 11 * MiB;
constexpr size_t WS_XB = 26 * MiB;
constexpr size_t WS_T64 = 58 * MiB, WS_TM = 62 * MiB;
constexpr size_t WS_QN = 68 * MiB;
constexpr size_t WS_AST = 64 * MiB;
constexpr size_t WS_SSQ = 72 * MiB, WS_CQS = WS_SSQ + 256 * 1024, WS_CKVS = WS_CQS + 256 * 1024;
constexpr size_t WS_A = 73 * MiB;
constexpr size_t WS_DQ = WS_A, WS_DK = WS_DQ + 16 * MiB, WS_DV = WS_DK + 16 * MiB, WS_CQ = WS_DV + 16 * MiB, WS_CKV = WS_CQ + 8 * MiB, WS_MQ = WS_CKV + 8 * MiB, WS_MK = WS_MQ + 12 * MiB,
                 WS_MV = WS_MK + 12 * MiB, WS_RQ = WS_MV + 8 * MiB, WS_RK = WS_RQ + 8 * MiB, WS_RV = WS_RK + 8 * MiB, WS_RG = WS_RV + 8 * MiB, WS_MIX = WS_RG + 8 * MiB, WS_END = WS_MIX + 32 * MiB;
constexpr size_t WS_H = WS_A;
#ifndef W1_EARLY
#define W1_EARLY 0
#endif
constexpr size_t WS_W1D = 234 * MiB - WS_WOUT;
static_assert(WS_END <= 234 * MiB && WS_WDN + WS_W1D + (size_t)1024 * FFH * 2 <= 256 * MiB, "second weight buffer");
static_assert(WS_WDN + (size_t)1024 * FFH * 2 <= WS_XB && WS_H + (size_t)MTOK * FFH * 2 <= WS_MV && WS_END <= 256 * MiB, "d_ws map");
constexpr int CW_TMO = 0, CW_BAR = 4096, CW_Q = 8192, CW_P = 16384, CW_KM = 49152  ;
static_assert((size_t)(CW_KM + 256 + 2 * 1024) * 4 <= CTL_ZERO_BYTES && CW_P + 3 * 64 * 64 <= CW_KM && CW_Q + 2 * 1024 <= CW_P, "control words inside the zeroed block");
constexpr int RING_BYTES = 131072, LDSCTL_OFF = RING_BYTES, MISC_OFF = LDSCTL_OFF + 320, RS_OFF = LDSCTL_OFF + 1024  , LDS_BYTES = 147456;
constexpr int NWAVES = 8;

template <bool RELEASE = true> __device__ __forceinline__ void panel_barrier(gu32* cnt, unsigned expected, gu32* tmo);
namespace pg8 {
typedef float f32x2v __attribute__((ext_vector_type(2)));
__device__ __forceinline__ u32x4 pack8(const f32x4 a, const f32x4 b) { u32x4 w; w.x = cvt_pk_bf16(a[0], a[1]); w.y = cvt_pk_bf16(a[2], a[3]); w.z = cvt_pk_bf16(b[0], b[1]); w.w = cvt_pk_bf16(b[2], b[3]); return w; }
#ifdef WT_STORES
__device__ __forceinline__ void st16(void* p, const u32x4 v) { asm volatile("global_store_dwordx4 %0, %1, off sc1\n\ts_nop 1" :: "v"(p), "v"(v) : "memory"); }
#else
__device__ __forceinline__ void st16(void* p, const u32x4 v) { *(u32x4*)p = v; }
#endif
__device__ __forceinline__ float rstd4(const float* p, float inv_n, float eps) { const f32x4 s = *(const f32x4*)p; return 1.0f / sqrtf(((s[0] + s[1]) + (s[2] + s[3])) * inv_n + eps); }
__device__ __forceinline__ float sumsq4(const f32x4 v) { return (v[0] * v[0] + v[1] * v[1]) + (v[2] * v[2] + v[3] * v[3]); }
__device__ __forceinline__ f32x4 silu4(const f32x4 v) { f32x4 r;
#pragma unroll
    for (int i = 0; i < 4; ++i) r[i] = v[i] * __builtin_amdgcn_rcpf(1.0f + __builtin_amdgcn_exp2f(-v[i] * 1.4426950408889634f)); return r; }

__device__ __forceinline__ void rstd8(float (&rs)[2][4], const float* p, int row0, float inv_n, float eps) {
    f32x4 s[2][4];
#pragma unroll
    for (int ai = 0; ai < 2; ++ai)
#pragma unroll
        for (int m = 0; m < 4; ++m) s[ai][m] = *(const f32x4*)(p + (size_t)(row0 + ai * HALF + m * 16) * 4);
#pragma unroll
    for (int ai = 0; ai < 2; ++ai)
#pragma unroll
        for (int m = 0; m < 4; ++m) rs[ai][m] = 1.0f / sqrtf(((s[ai][m][0] + s[ai][m][1]) + (s[ai][m][2] + s[ai][m][3])) * inv_n + eps);
}
struct EpiG1 {
    static constexpr bool PERM = true, AFTER_DRAIN = false;
    unsigned char* ws;
    int layer;
    const PG8_LAS float* rs_tab;
    __device__ __forceinline__ void scales(float (&rsv)[4], const PG8_LAS float* tab, int lrow0) const {
#pragma unroll
        for (int m = 0; m < 4; ++m) rsv[m] = tab[lrow0 + m * 16];
    }
    __device__ __forceinline__ void operator()(const f32x4 (&acc)[2][2][4][2], const Unit& u, int wr, int wc, int fr, int fq) const {
        { int t_ = threadIdx.x; asm volatile("" : "+v"(t_)); fr = t_ & 15; fq = (t_ >> 4) & 3; }
        const int pn = u.pn; const PG8_LAS float* tab = rs_tab + u.ord * 256;
        if (pn < 4 || pn == 8 || pn == 9) {
            const float* t64 = (const float*)(ws + WS_T64);
            const float sc = pn < 2 ? C2_DIFF : (pn == 9 ? 0.125f : 1.0f);
            bf16_t* dbase; int ld; if (pn < 2) { dbase = (bf16_t*)(ws + WS_DQ) + 256 * pn; ld = 512; } else if (pn < 4) { dbase = (bf16_t*)(ws + WS_DK) + 256 * (pn - 2); ld = 512; } else { dbase = (bf16_t*)(ws + (pn == 8 ? WS_RQ : WS_RK)); ld = 256; }
            dbase += 64 * wc + 8 * fq;
#pragma unroll
            for (int ai = 0; ai < 2; ++ai) {
                const int row0 = u.pm * BM + ai * HALF + wr * 64 + fr; float rsv[4]; scales(rsv, tab, ai * HALF + wr * 64 + fr);
#pragma unroll
                for (int mp = 0; mp < 2; ++mp) {
                    f32x4 tc[2][4];
#pragma unroll
                    for (int k = 0; k < 2; ++k) { const float* tr = t64 + (size_t)(row0 + (2 * mp + k) * 16) * 64 + 8 * fq;
                        tc[k][0] = *(const f32x4*)tr; tc[k][1] = *(const f32x4*)(tr + 4); tc[k][2] = *(const f32x4*)(tr + 32); tc[k][3] = *(const f32x4*)(tr + 36); }
                    asm volatile("" ::: "memory");
#pragma unroll
                    for (int k = 0; k < 2; ++k) { const int m = 2 * mp + k; const float rs = rsv[m];
                        const f32x4 l0 = acc[ai][0][m][0] * rs, l1 = acc[ai][0][m][1] * rs, h0 = acc[ai][1][m][0] * rs, h1 = acc[ai][1][m][1] * rs;
                        const f32x4 c0 = tc[k][0], c1 = tc[k][1], s0 = tc[k][2], s1 = tc[k][3];
                        const f32x4 ol0 = (l0 * c0 - h0 * s0) * sc, ol1 = (l1 * c1 - h1 * s1) * sc, oh0 = (h0 * c0 + l0 * s0) * sc, oh1 = (h1 * c1 + l1 * s1) * sc;
                        bf16_t* dst = dbase + (size_t)(row0 + m * 16) * ld;
                        st16(dst, pack8(ol0, ol1)); st16(dst + 32, pack8(oh0, oh1)); }
                }
            }
        } else if (pn == 4 || pn == 5 || pn == 10 || pn == 11) {
            bf16_t* dbase; int ld; if (pn < 6) { dbase = (bf16_t*)(ws + WS_DV) + 256 * (pn - 4); ld = 512; } else { dbase = (bf16_t*)(ws + (pn == 10 ? WS_RV : WS_RG)); ld = 256; }
            dbase += 32 * wc + 8 * fq;
#pragma unroll
            for (int ai = 0; ai < 2; ++ai) {
                const int row0 = u.pm * BM + ai * HALF + wr * 64 + fr; float rsv[4]; scales(rsv, tab, ai * HALF + wr * 64 + fr);
#pragma unroll
                for (int m = 0; m < 4; ++m) { const float rs = rsv[m];
                    f32x4 l0 = acc[ai][0][m][0] * rs, l1 = acc[ai][0][m][1] * rs, h0 = acc[ai][1][m][0] * rs, h1 = acc[ai][1][m][1] * rs;
                    if (pn == 11) { l0 = silu4(l0); l1 = silu4(l1); h0 = silu4(h0); h1 = silu4(h1); }
                    bf16_t* dst = dbase + (size_t)(row0 + m * 16) * ld;
                    st16(dst, pack8(l0, l1)); st16(dst + HALF, pack8(h0, h1)); }
            }
        } else if (pn == 6) {
            bf16_t* dbase = (bf16_t*)(ws + WS_CQ) + 32 * wc + 8 * fq; float* CQS = (float*)(ws + WS_CQS);
#pragma unroll
            for (int ai = 0; ai < 2; ++ai) {
                const int row0 = u.pm * BM + ai * HALF + wr * 64 + fr; float rsv[4]; scales(rsv, tab, ai * HALF + wr * 64 + fr);
#pragma unroll
                for (int m = 0; m < 4; ++m) { const float rs = rsv[m]; const int row = row0 + m * 16;
                    const f32x4 l0 = acc[ai][0][m][0] * rs, l1 = acc[ai][0][m][1] * rs, h0 = acc[ai][1][m][0] * rs, h1 = acc[ai][1][m][1] * rs;
                    bf16_t* dst = dbase + (size_t)row * 256;
                    st16(dst, pack8(l0, l1)); st16(dst + HALF, pack8(h0, h1));
                    float s = (sumsq4(l0) + sumsq4(l1)) + (sumsq4(h0) + sumsq4(h1));
                    s += shx<16>(s); s = add_x32(s);
                    if (fq == 0) CQS[(size_t)row * 4 + wc] = s; }
            }
        } else {
            bf16_t* dbase = (bf16_t*)(ws + WS_CKV) + 32 * wc + 8 * fq; float* CKVS = (float*)(ws + WS_CKVS); const float* tm = (const float*)(ws + WS_TM); bf16_t* MK = (bf16_t*)(ws + WS_MK);
            const bool kr = (wc == 0) && (fq < 2);
#pragma unroll
            for (int ai = 0; ai < 2; ++ai) {
                const int row0 = u.pm * BM + ai * HALF + wr * 64 + fr; float rsv[4]; scales(rsv, tab, ai * HALF + wr * 64 + fr);
#pragma unroll
                for (int m = 0; m < 4; ++m) { const float rs = rsv[m]; const int row = row0 + m * 16;
                    const f32x4 l0 = acc[ai][0][m][0] * rs, l1 = acc[ai][0][m][1] * rs, h0 = acc[ai][1][m][0] * rs, h1 = acc[ai][1][m][1] * rs;
                    bf16_t* dst = dbase + (size_t)row * 256;
                    st16(dst, pack8(l0, l1)); st16(dst + HALF, pack8(h0, h1));
                    float s = kr ? 0.f : (sumsq4(l0) + sumsq4(l1)) + (sumsq4(h0) + sumsq4(h1));
                    s += shx<16>(s); s = add_x32(s);
                    if (fq == 0) CKVS[(size_t)row * 4 + wc] = s;
                    if (kr) {
                        const float* tr = tm + (size_t)row * 32 + 8 * fq;
                        const f32x4 c0 = *(const f32x4*)tr, c1 = *(const f32x4*)(tr + 4), s0 = *(const f32x4*)(tr + 16), s1 = *(const f32x4*)(tr + 20);
                        const u32x4 olo = pack8(l0 * c0 - h0 * s0, l1 * c1 - h1 * s1), ohi = pack8(h0 * c0 + l0 * s0, h1 * c1 + l1 * s1);
                        bf16_t* kd = MK + (size_t)row * 384 + 64 + 8 * fq;
#pragma unroll
                        for (int hh = 0; hh < 4; ++hh) { st16(kd + hh * 96, olo); st16(kd + hh * 96 + 16, ohi); }
                    } }
            }
        }
    }
};

struct EpiMQ {
    static constexpr bool PERM = true, AFTER_DRAIN = false;
    unsigned char* ws;
    __device__ __forceinline__ void operator()(const f32x4 (&acc)[2][2][4][2], const Unit& u, int wr, int wc, int fr, int fq) const {
        { int t_ = threadIdx.x; asm volatile("" : "+v"(t_)); fr = t_ & 15; fq = (t_ >> 4) & 3; }
        const int head = 2 * u.pn + (wc >> 1);
        const float* cqs = (const float*)(ws + WS_CQS); const float* tm = (const float*)(ws + WS_TM); bf16_t* MQ = (bf16_t*)(ws + WS_MQ);
        float rsv[2][4]; rstd8(rsv, cqs, u.pm * BM + wr * 64 + fr, 1.0f / 256.0f, NORM_EPS);
#pragma unroll
        for (int ai = 0; ai < 2; ++ai)
#pragma unroll
            for (int m = 0; m < 4; ++m) {
                const int row = u.pm * BM + ai * HALF + wr * 64 + m * 16 + fr;
                const float rs = rsv[ai][m] * C2_MLA;
                const f32x4 l0 = acc[ai][0][m][0] * rs, l1 = acc[ai][0][m][1] * rs, h0 = acc[ai][1][m][0] * rs, h1 = acc[ai][1][m][1] * rs;
                bf16_t* dst = MQ + (size_t)row * 384 + head * 96;
                if ((wc & 1) == 0) { st16(dst + 8 * fq, pack8(l0, l1)); st16(dst + 32 + 8 * fq, pack8(h0, h1)); }
                else if (fq < 2) {
                    const float* tr = tm + (size_t)row * 32 + 8 * fq;
                    const f32x4 c0 = *(const f32x4*)tr, c1 = *(const f32x4*)(tr + 4), s0 = *(const f32x4*)(tr + 16), s1 = *(const f32x4*)(tr + 20);
                    st16(dst + 64 + 8 * fq, pack8(l0 * c0 - h0 * s0, l1 * c1 - h1 * s1)); st16(dst + 80 + 8 * fq, pack8(h0 * c0 + l0 * s0, h1 * c1 + l1 * s1));
                }
            }
    }
};
struct EpiMKV {
    static constexpr bool PERM = true, AFTER_DRAIN = false;
    unsigned char* ws;
    __device__ __forceinline__ void operator()(const f32x4 (&acc)[2][2][4][2], const Unit& u, int wr, int wc, int fr, int fq) const {
        { int t_ = threadIdx.x; asm volatile("" : "+v"(t_)); fr = t_ & 15; fq = (t_ >> 4) & 3; }
        const int head = 2 * u.pn + (wc >> 1);
        const float* ckvs = (const float*)(ws + WS_CKVS); bf16_t* MK = (bf16_t*)(ws + WS_MK); bf16_t* MV = (bf16_t*)(ws + WS_MV);
        float rsv[2][4]; rstd8(rsv, ckvs, u.pm * BM + wr * 64 + fr, 1.0f / 128.0f, NORM_EPS);
#pragma unroll
        for (int ai = 0; ai < 2; ++ai)
#pragma unroll
            for (int m = 0; m < 4; ++m) {
                const int row = u.pm * BM + ai * HALF + wr * 64 + m * 16 + fr;
                const float rs = rsv[ai][m];
                const f32x4 l0 = acc[ai][0][m][0] * rs, l1 = acc[ai][0][m][1] * rs, h0 = acc[ai][1][m][0] * rs, h1 = acc[ai][1][m][1] * rs;
                bf16_t* dst = (wc & 1) ? MV + (size_t)row * 256 + head * 64 : MK + (size_t)row * 384 + head * 96;
                st16(dst + 8 * fq, pack8(l0, l1)); st16(dst + 32 + 8 * fq, pack8(h0, h1));
            }
    }
};

struct EpiGU {
    static constexpr bool PERM = true, AFTER_DRAIN = false;
    unsigned char* ws; const PG8_LAS float* rs_tab;
    __device__ __forceinline__ void operator()(const f32x4 (&acc)[2][2][4][2], const Unit& u, int wr, int wc, int fr, int fq) const {
        { int t_ = threadIdx.x; asm volatile("" : "+v"(t_)); fr = t_ & 15; fq = (t_ >> 4) & 3; }
        bf16_t* H = (bf16_t*)(ws + WS_H);
        float rsv[2][4];
#pragma unroll
        for (int ai = 0; ai < 2; ++ai)
#pragma unroll
            for (int m = 0; m < 4; ++m) rsv[ai][m] = rs_tab[u.ord * 256 + ai * HALF + wr * 64 + m * 16 + fr];
#pragma unroll
        for (int ai = 0; ai < 2; ++ai)
#pragma unroll
            for (int m = 0; m < 4; ++m) {
                if (u.half != 0 && u.half != ai + 1) continue;
                const int row = u.pm * BM + ai * HALF + wr * 64 + m * 16 + fr;
                const float rs = rsv[ai][m];
                const f32x4 g0 = acc[ai][0][m][0] * rs, g1 = acc[ai][0][m][1] * rs, u0 = acc[ai][1][m][0] * rs, u1 = acc[ai][1][m][1] * rs;
                st16(H + (size_t)row * FFH + u.pn * HALF + 32 * wc + 8 * fq, pack8(silu4(g0) * u0, silu4(g1) * u1));
            }
    }
};

struct EpiRes {
    static constexpr bool PERM = true, AFTER_DRAIN = true;
    unsigned char* ws; int dry;
    int fin; const float* fnw; float* outp;
    __device__ __forceinline__ void fused(f32x4 (&acc)[2][2][4][2], const Unit& u, int wr, int wc, int fr, int fq, PG8_LAS unsigned char* lds, int wid, int lane) const {
        { int t_ = threadIdx.x; asm volatile("" : "+v"(t_)); fr = t_ & 15; fq = (t_ >> 4) & 3; }
        PG8_LAS float* P = (PG8_LAS float*)lds;
        bf16_t* xb = (bf16_t*)(ws + WS_XB); float* ssq = (float*)(ws + WS_SSQ);
        const int col0 = u.pn * BM + wc * 32 + 8 * fq;
        u32x4 xi[2][2];
#define ER_LOAD(k) do { const size_t off_ = (size_t)(u.pm * BM + ((k) >> 2) * HALF + wr * 64 + ((k) & 3) * 16 + fr) * DMODEL + col0; \
        _Pragma("unroll") for (int q_ = 0; q_ < 2; ++q_) xi[(k) & 1][q_] = *(const u32x4*)(xb + off_ + q_ * HALF); } while (0)
        ER_LOAD(0);
#pragma unroll
        for (int k = 0; k < 8; ++k) { const int ai = k >> 2, m = k & 3, r = ai * HALF + wr * 64 + m * 16 + fr; const size_t off = (size_t)(u.pm * BM + r) * DMODEL + col0; float s = 0.f;
            if (k < 7) ER_LOAD(k + 1);
            asm volatile("" ::: "memory");
#pragma unroll
            for (int bj = 0; bj < 2; ++bj) { const u32x4 x4 = xi[k & 1][bj];
                const f32x4 xv0 = {__uint_as_float(x4.x << 16), __uint_as_float(x4.x & 0xffff0000u), __uint_as_float(x4.y << 16), __uint_as_float(x4.y & 0xffff0000u)};
                const f32x4 xv1 = {__uint_as_float(x4.z << 16), __uint_as_float(x4.z & 0xffff0000u), __uint_as_float(x4.w << 16), __uint_as_float(x4.w & 0xffff0000u)};
                const f32x4 v0 = xv0 + acc[ai][bj][m][0], v1 = xv1 + acc[ai][bj][m][1];
                if (fin) { acc[ai][bj][m][0] = v0; acc[ai][bj][m][1] = v1; }
                else { u32x4 w; w.x = cvt_pk_bf16(v0[0], v0[1]); w.y = cvt_pk_bf16(v0[2], v0[3]); w.z = cvt_pk_bf16(v1[0], v1[1]); w.w = cvt_pk_bf16(v1[2], v1[3]); if (!dry) *(u32x4*)(xb + off + bj * HALF) = w; }
                s += sumsq4(v0) + sumsq4(v1); }
            s += shx<16>(s); s = add_x32(s);
            if (fq == 0) P[r * 4 + wc] = s;
            asm volatile("" ::: "memory"); }
#undef ER_LOAD
        asm volatile("s_waitcnt lgkmcnt(0)" ::: "memory"); __builtin_amdgcn_s_barrier(); asm volatile("" ::: "memory");
        const int t = wid * 64 + lane;
        if (t < 256 && !dry) { const PG8_LAS f32x4* P4 = (const PG8_LAS f32x4*)lds; const f32x4 p = P4[t]; const float tot = (p[0] + p[1]) + (p[2] + p[3]);
            if (fin) __hip_atomic_store(ssq + (size_t)(u.pm * BM + t) * 4 + u.pn, tot, __ATOMIC_RELAXED, __HIP_MEMORY_SCOPE_AGENT);
            else ssq[(size_t)(u.pm * BM + t) * 4 + u.pn] = tot; }
        asm volatile("s_waitcnt lgkmcnt(0)" ::: "memory"); __builtin_amdgcn_s_barrier(); asm volatile("" ::: "memory");
        if (fin) {
            panel_barrier<false>((gu32*)(ws + WS_CTL) + CW_P + (2 * 64 + u.pm) * 64, 4u, (gu32*)(ws + WS_CTL) + CW_TMO);
            f32x4 ps[8];
#pragma unroll
            for (int k = 0; k < 8; ++k) { const int r = (k >> 2) * HALF + wr * 64 + (k & 3) * 16 + fr; ps[k] = *(const f32x4*)(ssq + (size_t)(u.pm * BM + r) * 4); }
            f32x4 gv[2][2];
#pragma unroll
            for (int bj = 0; bj < 2; ++bj)
#pragma unroll
                for (int n = 0; n < 2; ++n) gv[bj][n] = *(const f32x4*)(fnw + col0 + bj * HALF + n * 4);
#pragma unroll
            for (int k = 0; k < 8; ++k) { const int ai = k >> 2, m = k & 3, r = ai * HALF + wr * 64 + m * 16 + fr; const size_t off = (size_t)(u.pm * BM + r) * DMODEL + col0;
                const float rs = 1.0f / sqrtf(((ps[k][0] + ps[k][1]) + (ps[k][2] + ps[k][3])) * (1.0f / 1024.0f) + NORM_EPS);
#pragma unroll
                for (int bj = 0; bj < 2; ++bj)
#pragma unroll
                    for (int n = 0; n < 2; ++n) { const f32x4 o4 = acc[ai][bj][m][n] * rs * gv[bj][n]; if (!dry) *(f32x4*)(outp + off + bj * HALF + n * 4) = o4; } }
        }
    }
};
}
namespace at {
using bf16 = unsigned short;
using bf16x8 = __attribute__((ext_vector_type(8))) short;
using s16x4 = __attribute__((ext_vector_type(4))) short;
using f32x16 = __attribute__((ext_vector_type(16))) float;
using f32x4 = __attribute__((ext_vector_type(4))) float;
using u32x4 = __attribute__((ext_vector_type(4))) unsigned;
#define SBAR() __builtin_amdgcn_sched_barrier(0)
constexpr float THR2 = 8.f;
__device__ __forceinline__ int crow(int r, int hi) { return (r & 3) + 8 * (r >> 2) + 4 * hi; }
__device__ __forceinline__ unsigned cvtpk(float lo, float hi) { unsigned r; asm volatile("v_cvt_pk_bf16_f32 %0, %1, %2" : "=v"(r) : "v"(lo), "v"(hi)); return r; }
__device__ __forceinline__ float bf2f(short b) { return __uint_as_float(((unsigned)(unsigned short)b) << 16); }
template <int NB> __device__ __forceinline__ int v_st(int k, int c) { const int kk = (k & ~0xC) | ((k & 4) << 1) | ((k & 8) >> 1); return ((kk >> 3) * NB + (c >> 5)) * 512 + ((kk & 7) * 32 + (c & 31)) * 2; }
__device__ __forceinline__ int v_rd_base(int lane) { return ((lane & 3) << 3) | (((lane >> 2) & 3) << 6) | (((lane >> 4) & 1) << 5) | (((lane >> 5) & 1) << 8); }
template <int NB> constexpr int v_rd_off(int d0, int ks, int half) { return d0 * 512 + ks * (2 * NB * 512) + half * (NB * 512); }
template <int KRS> __device__ __forceinline__ int k_swz(int row) { return KRS == 128 ? (((row >> 1) & 7) << 4) : ((row & 7) << 4); }
template <int KRS> __device__ __forceinline__ int k_addr(int row, int chunk) { return row * KRS + ((chunk * 16) ^ k_swz<KRS>(row)); }

__device__ __forceinline__ void mask_tile(f32x16& p0, f32x16& p1, int dq) {
    const float NEG = -__builtin_inff();
#pragma unroll
    for (int r = 0; r < 16; ++r) { const int c = (r & 3) + 8 * (r >> 2); if (dq - c < 0) p0[r] = NEG; if (dq - c - 32 < 0) p1[r] = NEG; }
}
__device__ __forceinline__ void partialSM(f32x16& p0, f32x16& p1, float& m_reg, float& alpha) {
    float pmax = p0[0];
#pragma unroll
    for (int r = 1; r < 16; ++r) pmax = fmaxf(pmax, p0[r]);
#pragma unroll
    for (int r = 0; r < 16; ++r) pmax = fmaxf(pmax, p1[r]);
    { auto rr = __builtin_amdgcn_permlane32_swap(__float_as_uint(pmax), __float_as_uint(pmax), false, false); pmax = fmaxf(__uint_as_float(rr[0]), __uint_as_float(rr[1])); }
    float mn;
    if (__builtin_expect(__all(pmax - m_reg <= THR2), 1)) { mn = m_reg; alpha = 1.f; }
    else { mn = fmaxf(m_reg, pmax); alpha = __builtin_amdgcn_exp2f(m_reg - mn); m_reg = mn; }
#pragma unroll
    for (int r = 0; r < 16; ++r) { p0[r] -= mn; p1[r] -= mn; }
#pragma unroll
    for (int r = 0; r < 16; ++r) p0[r] = __builtin_amdgcn_exp2f(p0[r]);
}
#define AT_PK4(P, B_, OUT) do { unsigned a0 = cvtpk(P[B_ + 0], P[B_ + 1]), a1 = cvtpk(P[B_ + 2], P[B_ + 3]); unsigned b0 = cvtpk(P[B_ + 4], P[B_ + 5]), b1 = cvtpk(P[B_ + 6], P[B_ + 7]); \
        auto r0 = __builtin_amdgcn_permlane32_swap(a0, b0, false, false); auto r1 = __builtin_amdgcn_permlane32_swap(a1, b1, false, false); \
        u32x4 w = {r0[0], r1[0], r0[1], r1[1]}; OUT = *reinterpret_cast<bf16x8*>(&w); } while (0)
__device__ __forceinline__ void pack_p(const f32x16& p0, const f32x16& p1, bf16x8& pa0, bf16x8& pa1, bf16x8& pa2, bf16x8& pa3) { AT_PK4(p0, 0, pa0); AT_PK4(p0, 8, pa1); AT_PK4(p1, 0, pa2); AT_PK4(p1, 8, pa3); }
__device__ __forceinline__ void finishSM(f32x16& p0, f32x16& p1, float alpha, float& l_reg, bf16x8& pa0, bf16x8& pa1, bf16x8& pa2, bf16x8& pa3) {
#pragma unroll
    for (int r = 0; r < 16; ++r) p1[r] = __builtin_amdgcn_exp2f(p1[r]);
    float ps = 0;
#pragma unroll
    for (int r = 0; r < 16; ++r) ps += p0[r];
#pragma unroll
    for (int r = 0; r < 16; ++r) ps += p1[r];
    { auto rr = __builtin_amdgcn_permlane32_swap(__float_as_uint(ps), __float_as_uint(ps), false, false); ps = __uint_as_float(rr[0]) + __uint_as_float(rr[1]); }
    l_reg = l_reg * alpha + ps;
    pack_p(p0, p1, pa0, pa1, pa2, pa3);
}
template <int DQK, int KRS> __device__ __forceinline__ void qkt(f32x16& p0, f32x16& p1, const char* Kimg, int r32, int hi, const bf16x8* qr) {
    p0 = f32x16{}; p1 = f32x16{};
    const char* kb[4];
#pragma unroll
    for (int dd = 0; dd < 4; ++dd) kb[dd] = Kimg + k_addr<KRS>(r32, 2 * dd + hi);
#pragma unroll
    for (int d0 = 0; d0 < DQK / 16; ++d0) { const char* a = kb[d0 & 3] + (d0 >> 2) * 128;
        const bf16x8 b0 = *reinterpret_cast<const bf16x8*>(a), b1 = *reinterpret_cast<const bf16x8*>(a + 32 * KRS);
        p0 = __builtin_amdgcn_mfma_f32_32x32x16_bf16(b0, qr[d0], p0, 0, 0, 0);
        p1 = __builtin_amdgcn_mfma_f32_32x32x16_bf16(b1, qr[d0], p1, 0, 0, 0); }
}
struct VFr { s16x4 l0, l1, l2, l3, h0, h1, h2, h3; };
#define AT_TRRD(dst, off) asm volatile("ds_read_b64_tr_b16 %0, %1 offset:%2" : "=&v"(dst) : "v"(vb), "i"(off) : "memory")
template <int NB, int D0> __device__ __forceinline__ void v_reads(VFr& f, int vb) {
    AT_TRRD(f.l0, (v_rd_off<NB>(D0, 0, 0))); AT_TRRD(f.h0, (v_rd_off<NB>(D0, 0, 1))); AT_TRRD(f.l1, (v_rd_off<NB>(D0, 1, 0))); AT_TRRD(f.h1, (v_rd_off<NB>(D0, 1, 1)));
    AT_TRRD(f.l2, (v_rd_off<NB>(D0, 2, 0))); AT_TRRD(f.h2, (v_rd_off<NB>(D0, 2, 1))); AT_TRRD(f.l3, (v_rd_off<NB>(D0, 3, 0))); AT_TRRD(f.h3, (v_rd_off<NB>(D0, 3, 1)));
}
#undef AT_TRRD
#define AT_PK(L, H) (bf16x8){L[0], L[1], L[2], L[3], H[0], H[1], H[2], H[3]}
__device__ __forceinline__ void pv_mma(f32x16& od, const VFr& f, bf16x8 pa0, bf16x8 pa1, bf16x8 pa2, bf16x8 pa3) {
    od = __builtin_amdgcn_mfma_f32_32x32x16_bf16(pa0, AT_PK(f.l0, f.h0), od, 0, 0, 0);
    od = __builtin_amdgcn_mfma_f32_32x32x16_bf16(pa1, AT_PK(f.l1, f.h1), od, 0, 0, 0);
    od = __builtin_amdgcn_mfma_f32_32x32x16_bf16(pa2, AT_PK(f.l2, f.h2), od, 0, 0, 0);
    od = __builtin_amdgcn_mfma_f32_32x32x16_bf16(pa3, AT_PK(f.l3, f.h3), od, 0, 0, 0);
}
#undef AT_PK
#define AT_LW(n) asm volatile("s_waitcnt lgkmcnt(" #n ")" ::: "memory")
template <int NB> __device__ __forceinline__ void pv_all(f32x16* o, int vb, bf16x8 pa0, bf16x8 pa1, bf16x8 pa2, bf16x8 pa3) {
    VFr fa, fb;
    v_reads<NB, 0>(fa, vb); v_reads<NB, 1>(fb, vb);
    AT_LW(8); SBAR(); pv_mma(o[0], fa, pa0, pa1, pa2, pa3); SBAR();
    if constexpr (NB == 4) {
        v_reads<NB, 2>(fa, vb); AT_LW(8); SBAR(); pv_mma(o[1], fb, pa0, pa1, pa2, pa3); SBAR();
        v_reads<NB, 3>(fb, vb); AT_LW(8); SBAR(); pv_mma(o[2], fa, pa0, pa1, pa2, pa3); SBAR();
        AT_LW(0); SBAR(); pv_mma(o[3], fb, pa0, pa1, pa2, pa3);
    } else { AT_LW(0); SBAR(); pv_mma(o[1], fb, pa0, pa1, pa2, pa3); }
}
#undef AT_LW

template <int DQK, int DV, int LDQ, int LDK, int LDV, int LDO>
__device__ __forceinline__ void attn_unit(const bf16* __restrict__ Qb, const bf16* __restrict__ Kh, const bf16* __restrict__ Vh, bf16* __restrict__ Ob, int qb, char* lds, int kvmul = 1) {
    constexpr int KRS = DQK == 64 ? 128 : 256, KB = 64 * KRS, NB = DV / 32, VB = 64 * DV * 2, KCH = DQK / 8, NKP = (64 * KCH + 511) / 512, VCH = DV / 8, NVP = 64 * VCH / 512;
    static_assert(NKP <= 2 && (NVP == 1 || NVP == 2), "staging piece counts");
    int tid_ = threadIdx.x; asm volatile("" : "+v"(tid_));
    const int tid = tid_, wid = __builtin_amdgcn_readfirstlane(tid >> 6), lane = tid & 63, r32 = lane & 31, hi = lane >> 5;
    char* V_lds = lds; char* K_lds = lds + 2 * VB;
    float* ws = (float*)(lds + 2 * VB + 2 * KB) + wid * 64; float* li_l = ws; float* al_l = ws + 32;
    float m_reg = -1e30f, l_reg = 0; f32x16 o[NB];
#pragma unroll
    for (int d = 0; d < NB; ++d) o[d] = f32x16{};
    bf16x8 qr[DQK / 16];
    const bf16* Qw = Qb + (size_t)(wid * 32 + r32) * LDQ + hi * 8;
#pragma unroll
    for (int d0 = 0; d0 < DQK / 16; ++d0) qr[d0] = *reinterpret_cast<const bf16x8*>(Qw + d0 * 16);
    const int kr0 = tid / KCH, kc0 = tid % KCH, kr1 = (tid + 512) / KCH, kc1 = (tid + 512) % KCH; const bool k2 = (NKP == 2) && (tid + 512 < 64 * KCH);
    const int kw0 = k_addr<KRS>(kr0, kc0), kw1 = k_addr<KRS>(kr1 & 63, kc1);
    const int vr = tid / VCH, vc = (tid % VCH) * 8, vst0 = v_st<NB>(vr, vc), vst1 = v_st<NB>((32 + vr) & 63, vc);
    const int vb0 = (int)(uintptr_t)V_lds + v_rd_base(lane);
    bf16x8 sk0, sk1, sv0, sv1;
#define AT_SLOAD(k0_) do { const int k0 = (k0_) * kvmul; sv0 = *reinterpret_cast<const bf16x8*>(Vh + (size_t)((k0) + vr) * LDV + vc); if (NVP == 2) sv1 = *reinterpret_cast<const bf16x8*>(Vh + (size_t)((k0) + 32 + vr) * LDV + vc); \
        sk0 = *reinterpret_cast<const bf16x8*>(Kh + (size_t)((k0) + kr0) * LDK + kc0 * 8); if (k2) sk1 = *reinterpret_cast<const bf16x8*>(Kh + (size_t)((k0) + kr1) * LDK + kc1 * 8); } while (0)
#define AT_SWRITE(b) do { *(bf16x8*)(V_lds + (b) * VB + vst0) = sv0; if (NVP == 2) *(bf16x8*)(V_lds + (b) * VB + vst1) = sv1; \
        *(bf16x8*)(K_lds + (b) * KB + kw0) = sk0; if (k2) *(bf16x8*)(K_lds + (b) * KB + kw1) = sk1; } while (0)
#define AT_VMW() asm volatile("s_waitcnt vmcnt(0)" ::: "memory")
#define AT_RESC(a) do { if (__any((a) < 1.f)) { if (hi == 0) al_l[r32] = (a); asm volatile("s_waitcnt lgkmcnt(0)" ::: "memory"); \
        _Pragma("unroll") for (int d_ = 0; d_ < NB; ++d_) _Pragma("unroll") for (int r = 0; r < 16; ++r) o[d_][r] *= al_l[crow(r, hi)]; } } while (0)
    const int NT = 4 * (qb + 1);
    const int qlo = 256 * qb + wid * 32, qm = qlo + r32 - 4 * hi;
#define AT_MASK(P0_, P1_, t) do { const int kb_ = (t) * 64; if (kb_ + 63 > qlo) mask_tile(P0_, P1_, qm - kb_); } while (0)
    f32x16 pA0, pA1, pB0, pB1; float alA, alB; bf16x8 pa0, pa1, pa2, pa3;
    AT_SLOAD(0); AT_VMW(); AT_SWRITE(0); __syncthreads();
    qkt<DQK, KRS>(pA0, pA1, K_lds, r32, hi, qr); AT_MASK(pA0, pA1, 0); partialSM(pA0, pA1, m_reg, alA);
    AT_SLOAD(64); AT_VMW(); AT_SWRITE(1); __syncthreads();
    for (int j = 1; j + 1 < NT; j += 2) {
        SBAR(); qkt<DQK, KRS>(pB0, pB1, K_lds + KB, r32, hi, qr);
        finishSM(pA0, pA1, alA, l_reg, pa0, pa1, pa2, pa3); SBAR();
        AT_SLOAD((j + 1) * 64); SBAR();
        pv_all<NB>(o, vb0, pa0, pa1, pa2, pa3); AT_MASK(pB0, pB1, j); partialSM(pB0, pB1, m_reg, alB);
        __syncthreads(); AT_VMW(); AT_SWRITE(0);
        AT_RESC(alB); __syncthreads();
        SBAR(); qkt<DQK, KRS>(pA0, pA1, K_lds, r32, hi, qr);
        finishSM(pB0, pB1, alB, l_reg, pa0, pa1, pa2, pa3); SBAR();
        AT_SLOAD((j + 2) * 64); SBAR();
        pv_all<NB>(o, vb0 + VB, pa0, pa1, pa2, pa3); AT_MASK(pA0, pA1, j + 1); partialSM(pA0, pA1, m_reg, alA);
        __syncthreads(); AT_VMW(); AT_SWRITE(1);
        AT_RESC(alA); __syncthreads();
    }
    SBAR(); qkt<DQK, KRS>(pB0, pB1, K_lds + KB, r32, hi, qr);
    finishSM(pA0, pA1, alA, l_reg, pa0, pa1, pa2, pa3); SBAR();
    pv_all<NB>(o, vb0, pa0, pa1, pa2, pa3); AT_MASK(pB0, pB1, NT - 1); partialSM(pB0, pB1, m_reg, alB);
    AT_RESC(alB);
    finishSM(pB0, pB1, alB, l_reg, pa0, pa1, pa2, pa3); SBAR();
    pv_all<NB>(o, vb0 + VB, pa0, pa1, pa2, pa3);
    if (hi == 0) li_l[r32] = l_reg; asm volatile("s_waitcnt lgkmcnt(0)" ::: "memory");
    float rli[16];
#pragma unroll
    for (int r = 0; r < 16; ++r) rli[r] = __builtin_amdgcn_rcpf(li_l[crow(r, hi)]);
    bf16* Ow = Ob + (size_t)(wid * 32) * LDO;
#pragma unroll
    for (int r = 0; r < 16; ++r) { const int orow = crow(r, hi);
#pragma unroll
        for (int d0 = 0; d0 < NB; ++d0) { const float v = o[d0][r] * rli[r]; const float vn = shx<1>(v);
            if ((r32 & 1) == 0 && kvmul) *(unsigned*)(Ow + (size_t)orow * LDO + d0 * 32 + r32) = cvtpk(v, vn); } }
    __syncthreads();
#undef AT_SLOAD
#undef AT_SWRITE
#undef AT_VMW
#undef AT_RESC
#undef AT_MASK
}
}
namespace at2 {
using namespace at;
typedef __attribute__((address_space(3))) const char* lds_cptr;
typedef short v4i16_t __attribute__((ext_vector_type(4)));
__device__ __forceinline__ void glds16(const void* gsrc, unsigned lds_dst) { unsigned keep;
    asm volatile("s_mov_b32 %0, m0\n\ts_mov_b32 m0, %2\n\ts_nop 0\n\tglobal_load_lds_dwordx4 %1, off\n\ts_mov_b32 m0, %0" : "=&s"(keep) : "v"(gsrc), "s"(lds_dst) : "memory"); }
__device__ __forceinline__ s16x4 vtr(lds_cptr p) { return __builtin_bit_cast(s16x4, __builtin_amdgcn_ds_read_tr16_b64_v4i16((__attribute__((address_space(3))) v4i16_t*)p)); }
__device__ __forceinline__ bf16x8 kld(lds_cptr p) { return *(const __attribute__((address_space(3))) bf16x8*)p; }
typedef float f32x2_t __attribute__((ext_vector_type(2))); typedef __bf16 bf16x2_t __attribute__((ext_vector_type(2)));
__device__ __forceinline__ unsigned cvtpk_s(float lo, float hi) { f32x2_t v = {lo, hi}; bf16x2_t b = __builtin_convertvector(v, bf16x2_t); return __builtin_bit_cast(unsigned, b); }
constexpr float THRL = 8.f;

template <int DQK, int DV, int LDQ, int LDK, int LDV, int LDO>
__device__ __forceinline__ void attn_unit(const bf16* __restrict__ Qb, const bf16* __restrict__ Kh, const bf16* __restrict__ Vh, bf16* __restrict__ Ob, int qb, char* shm, int kvmul = 1) {
    constexpr int NKS = DQK / 16, NB = DV / 32, KSL = 64 * DQK * 2, VSL = 64 * DV * 2, NKC = DQK / 8, NVP = DV / 8, LDS_K = 0, LDS_V = 3 * KSL, LDS_WS = 3 * KSL + 3 * VSL;
    static_assert(NKC <= 16 && (NVP == 8 || NVP == 16), "piece counts");
    int tid_ = threadIdx.x; asm volatile("" : "+v"(tid_));
    const int tid = tid_, lane = tid & 63, r32 = lane & 31, hi = lane >> 5, wid = __builtin_amdgcn_readfirstlane(tid >> 6);
    const unsigned lds0 = (unsigned)(uintptr_t)shm;
    float* wsf = (float*)(shm + LDS_WS) + wid * 64;
    const bool k2 = (NKC > 8) && (wid < NKC - 8);
    const bf16* ksrc = Kh + (size_t)lane * LDK + wid * 8;
    const bf16* vsrc = Vh + (size_t)(16 * (wid & 3) + (lane >> 2)) * LDV + (wid >> 2) * 32 + (lane & 3) * 8;
#define A2_DMA_K(t, s) do { glds16(ksrc + (size_t)(t) * 64 * LDK, (unsigned)__builtin_amdgcn_readfirstlane(lds0 + LDS_K + (s) * KSL + wid * 1024)); \
        if (k2) glds16(ksrc + (size_t)(t) * 64 * LDK + 64, (unsigned)__builtin_amdgcn_readfirstlane(lds0 + LDS_K + (s) * KSL + (wid + 8) * 1024)); } while (0)
#define A2_DMA_V(t, s) do { glds16(vsrc + (size_t)(t) * 64 * LDV, (unsigned)__builtin_amdgcn_readfirstlane(lds0 + LDS_V + (s) * VSL + wid * 1024)); \
        if (NVP == 16) glds16(vsrc + (size_t)(t) * 64 * LDV + 64, (unsigned)__builtin_amdgcn_readfirstlane(lds0 + LDS_V + (s) * VSL + (wid + 8) * 1024)); } while (0)
#define A2_WAIT_BAR_K() do { if ((k2 ? 2 : 1) + (NVP == 16 ? 2 : 1) == 3) asm volatile("s_waitcnt vmcnt(3) lgkmcnt(0)\n\ts_barrier" ::: "memory"); else asm volatile("s_waitcnt vmcnt(2) lgkmcnt(0)\n\ts_barrier" ::: "memory"); } while (0)
#define A2_WAIT_BAR_0() asm volatile("s_waitcnt vmcnt(0) lgkmcnt(0)\n\ts_barrier" ::: "memory")
    const lds_cptr shm3 = (lds_cptr)shm;
    const lds_cptr kp0 = shm3 + LDS_K + hi * 1024 + r32 * 16;
    const lds_cptr vp0 = shm3 + LDS_V + ((lane >> 4) & 1) * 32 + (lane & 3) * 8 + (4 * hi + ((lane & 15) >> 2)) * 64;
    const int NT = 4 * (qb + 1);
    A2_DMA_K(0, 0); A2_DMA_V(0, 0); A2_DMA_K(1, 1); A2_DMA_V(1, 1);
    bf16x8 qr[NKS];
    { const bf16* Qw = Qb + (size_t)(wid * 32 + r32) * LDQ + hi * 8;
#pragma unroll
      for (int d0 = 0; d0 < NKS; ++d0) qr[d0] = *reinterpret_cast<const bf16x8*>(Qw + d0 * 16); }
    float mhat = 0.f, l_reg = 0.f; f32x16 o[NB];
#pragma unroll
    for (int d = 0; d < NB; ++d) o[d] = f32x16{};
    f32x16 negm = f32x16{};
    const int qlo = 256 * qb + wid * 32, qm = qlo + r32 - 4 * hi;
    A2_WAIT_BAR_0();
    int sl = 0;
#pragma unroll 1
    for (int t = 0; t < NT; ++t) {
        const int sl2 = sl == 0 ? 2 : sl - 1;
        if (t + 2 < NT) { A2_DMA_K(t + 2, sl2); A2_DMA_V(t + 2, sl2); }
        f32x16 c0, c1;
        { const lds_cptr kp = kp0 + sl * KSL;
#pragma unroll
          for (int d0 = 0; d0 < NKS; ++d0) { const bf16x8 b0 = kld(kp + d0 * 2048), b1 = kld(kp + d0 * 2048 + 512);
              c0 = __builtin_amdgcn_mfma_f32_32x32x16_bf16(b0, qr[d0], d0 == 0 ? negm : c0, 0, 0, 0);
              c1 = __builtin_amdgcn_mfma_f32_32x32x16_bf16(b1, qr[d0], d0 == 0 ? negm : c1, 0, 0, 0); } }
        if (t * 64 + 63 > qlo) mask_tile(c0, c1, qm - t * 64);
        float rm = c0[0];
#pragma unroll
        for (int r = 1; r < 16; ++r) rm = fmaxf(rm, c0[r]);
#pragma unroll
        for (int r = 0; r < 16; ++r) rm = fmaxf(rm, c1[r]);
        { auto rr = __builtin_amdgcn_permlane32_swap(__float_as_uint(rm), __float_as_uint(rm), false, false); rm = fmaxf(__uint_as_float(rr[0]), __uint_as_float(rr[1])); }
        if (t == 0 || __builtin_expect(__any(rm > THRL), 0)) {
            const float dl = t == 0 ? rm : fmaxf(rm, 0.f); mhat += dl;
#pragma unroll
            for (int r = 0; r < 16; ++r) { c0[r] -= dl; c1[r] -= dl; }
#pragma unroll
            for (int r = 0; r < 16; ++r) negm[r] = -mhat;
            if (t != 0) { const float f = __builtin_amdgcn_exp2f(-dl); l_reg *= f; if (hi == 0) wsf[r32] = f; asm volatile("s_waitcnt lgkmcnt(0)" ::: "memory");
#pragma unroll
                for (int d_ = 0; d_ < NB; ++d_)
#pragma unroll
                    for (int r = 0; r < 16; ++r) o[d_][r] *= wsf[crow(r, hi)]; }
        }
        float sacc = 0.f;
#pragma unroll
        for (int r = 0; r < 16; ++r) { c0[r] = __builtin_amdgcn_exp2f(c0[r]); sacc += c0[r]; }
#pragma unroll
        for (int r = 0; r < 16; ++r) { c1[r] = __builtin_amdgcn_exp2f(c1[r]); sacc += c1[r]; }
        l_reg += sacc;
        u32x4 pw[4];
#pragma unroll
        for (int k = 0; k < 2; ++k) { pw[k] = (u32x4){cvtpk_s(c0[8 * k], c0[8 * k + 1]), cvtpk_s(c0[8 * k + 2], c0[8 * k + 3]), cvtpk_s(c0[8 * k + 4], c0[8 * k + 5]), cvtpk_s(c0[8 * k + 6], c0[8 * k + 7])};
                                      pw[2 + k] = (u32x4){cvtpk_s(c1[8 * k], c1[8 * k + 1]), cvtpk_s(c1[8 * k + 2], c1[8 * k + 3]), cvtpk_s(c1[8 * k + 4], c1[8 * k + 5]), cvtpk_s(c1[8 * k + 6], c1[8 * k + 7])}; }
        { const lds_cptr vp = vp0 + sl * VSL;
#pragma unroll
          for (int d0 = 0; d0 < NB; ++d0)
#pragma unroll
              for (int ks = 0; ks < 4; ++ks) { const s16x4 lo = vtr(vp + d0 * 4096 + ks * 1024), hh = vtr(vp + d0 * 4096 + ks * 1024 + 512);
                  o[d0] = __builtin_amdgcn_mfma_f32_32x32x16_bf16(__builtin_bit_cast(bf16x8, pw[ks]), (bf16x8){lo[0], lo[1], lo[2], lo[3], hh[0], hh[1], hh[2], hh[3]}, o[d0], 0, 0, 0); } }
        if (t + 2 < NT) A2_WAIT_BAR_K(); else A2_WAIT_BAR_0();
        sl = sl == 2 ? 0 : sl + 1;
    }
    { auto rr = __builtin_amdgcn_permlane32_swap(__float_as_uint(l_reg), __float_as_uint(l_reg), false, false); l_reg = __uint_as_float(rr[0]) + __uint_as_float(rr[1]); }
    if (hi == 0) wsf[32 + r32] = l_reg; asm volatile("s_waitcnt lgkmcnt(0)" ::: "memory");
    float rli[16];
#pragma unroll
    for (int r = 0; r < 16; ++r) rli[r] = __builtin_amdgcn_rcpf(wsf[32 + crow(r, hi)]);
    bf16* Ow = Ob + (size_t)(wid * 32) * LDO;
#pragma unroll
    for (int r = 0; r < 16; ++r) { const int orow = crow(r, hi);
#pragma unroll
        for (int d0 = 0; d0 < NB; ++d0) { const float v = o[d0][r] * rli[r]; const float vn = shx<1>(v);
            if ((r32 & 1) == 0) *(unsigned*)(Ow + (size_t)orow * LDO + d0 * 32 + r32) = cvtpk(v, vn); } }
    asm volatile("s_waitcnt vmcnt(0) lgkmcnt(0)\n\ts_barrier" ::: "memory");
#undef A2_DMA_K
#undef A2_DMA_V
#undef A2_WAIT_BAR_K
#undef A2_WAIT_BAR_0
}
}
namespace at3 {
using namespace at2;
__device__ __forceinline__ void glds16s(const void* sbase, unsigned voff, unsigned lds_dst) { unsigned keep;
    asm volatile("s_mov_b32 %0, m0\n\ts_mov_b32 m0, %3\n\ts_nop 0\n\tglobal_load_lds_dwordx4 %1, %2\n\ts_mov_b32 m0, %0" : "=&s"(keep) : "v"(voff), "s"(sbase), "s"(lds_dst) : "memory"); }
#ifdef A3_HALFPRIO
#define A3_PRIO(p) do { if (wid >= 4) __builtin_amdgcn_s_setprio((p) + 1); else __builtin_amdgcn_s_setprio(p); } while (0)
#elif defined(A3_NOPRIO)
#define A3_PRIO(p) do { } while (0)
#else
#define A3_PRIO(p) __builtin_amdgcn_s_setprio(p)
#endif
#ifndef A3_TWOLV
#define A3_TWOLV 1
#endif
#ifndef A3_BADALL
#define A3_BADALL false
#endif
#ifndef A3_EB_M
#define A3_EB_M 24
#endif
#ifndef A3_DMA_EARLY
#define A3_DMA_EARLY 0
#endif
#ifndef A3_DMA_VB
#define A3_DMA_VB (-1)
#endif
#ifndef A3_DMA_KB
#define A3_DMA_KB (-1)
#endif
#ifndef A3_PS_M
#define A3_PS_M 0
#endif
#ifndef A3_PS_D
#define A3_PS_D 0
#endif
#ifndef A3_LPRE_M
#define A3_LPRE_M 0
#endif
#ifndef A3_SB_D
#define A3_SB_D 0
#endif
#ifndef A3_LPG
#define A3_LPG 2
#endif
#ifndef A3_EB_D
#define A3_EB_D 32
#endif
#define A3_PIN(x) asm volatile("" : "+v"(x))
#define A3_PEL(P0, P1, e) ((e) < 16 ? P0[(e) & 15] : P1[(e) & 15])
template <int DQK, int DV, int LDQ, int LDK, int LDV, int LDO, int FIXM = 0>
__device__ __forceinline__ unsigned attn_unit(const bf16* __restrict__ Qb, const bf16* __restrict__ Kh, const bf16* __restrict__ Vh, bf16* __restrict__ Ob, int qb, char* shm, gu32* qp, volatile LAS unsigned* misc, const float* qn = nullptr, float kmax = 0.f, unsigned utag = 0u, int kvmul = 1) {
    constexpr int NKS = DQK / 16, NQK = DQK / 8, NB = DV / 32, NPV = 4 * NB, KSL = 64 * DQK * 2, VSL = 64 * DV * 2, NKC = DQK / 8, NVP = DV / 8, LDS_K = 0, LDS_V = 3 * KSL, LDS_WS = 3 * KSL + 3 * VSL;
    constexpr int EB = FIXM == 1 ? (NPV == 8 ? A3_EB_M : A3_EB_D) : 32, NL = 32 - EB;
    constexpr int PS = FIXM == 1 ? (NPV == 8 ? A3_PS_M : A3_PS_D) : 0;
    constexpr int SB = (FIXM == 1 && NPV == 16) ? A3_SB_D : 0;
    constexpr bool LPRE = FIXM == 1 && NPV == 8 && A3_LPRE_M;
    static_assert(PS <= (LPRE ? 32 : EB), "pre sums");
    static_assert(EB % 2 == 0 && NL % A3_LPG == 0 && NL / A3_LPG <= NQK - 2, "late exps");
    static_assert(NKC <= 16 && (NVP == 8 || NVP == 16) && 32 % NQK != 1 && 32 % NPV == 0, "shape");
    int tid_ = threadIdx.x; asm volatile("" : "+v"(tid_));
    const int tid = tid_, lane = tid & 63, r32 = lane & 31, hi = lane >> 5, wid = __builtin_amdgcn_readfirstlane(tid >> 6);
    const int rb = wid < 4 ? wid : 11 - wid;
    const unsigned lds0 = (unsigned)(uintptr_t)shm;
    float* wsf = (float*)(shm + LDS_WS) + wid * 64;
    const bool k2 = (NKC > 8) && (wid < NKC - 8);
    const unsigned kvo = (unsigned)(lane * LDK) * 2u, vvo = (unsigned)((lane >> 2) * LDV + (lane & 3) * 8) * 2u;
    const char* kbs = (const char*)(Kh + wid * 8); const char* vbs = (const char*)(Vh + (size_t)(16 * (wid & 3)) * LDV + (wid >> 2) * 32);
#define A3_DMA_K(t, s) do { const char* b_ = kbs + (size_t)((t) * kvmul) * (64 * LDK * 2); glds16s(b_, kvo, (unsigned)__builtin_amdgcn_readfirstlane(lds0 + LDS_K + (s) * KSL + wid * 1024)); \
        if (k2) glds16s(b_ + 128, kvo, (unsigned)__builtin_amdgcn_readfirstlane(lds0 + LDS_K + (s) * KSL + (wid + 8) * 1024)); } while (0)
#define A3_DMA_V(t, s) do { const char* b_ = vbs + (size_t)((t) * kvmul) * (64 * LDV * 2); glds16s(b_, vvo, (unsigned)__builtin_amdgcn_readfirstlane(lds0 + LDS_V + (s) * VSL + wid * 1024)); \
        if (NVP == 16) glds16s(b_ + 128, vvo, (unsigned)__builtin_amdgcn_readfirstlane(lds0 + LDS_V + (s) * VSL + (wid + 8) * 1024)); } while (0)
#define A3_WB(n) asm volatile("s_waitcnt vmcnt(" #n ") lgkmcnt(0)\n\ts_barrier" ::: "memory")
#define A3_WAIT_BAR(gk, gv) do { const int n_ = ((gk) ? (k2 ? 2 : 1) : 0) + ((gv) ? NVP / 8 : 0); \
        if (n_ == 0) A3_WB(0); else if (n_ == 1) A3_WB(1); else if (n_ == 2) A3_WB(2); else if (n_ == 3) A3_WB(3); else A3_WB(4); } while (0)
    const lds_cptr shm3 = (lds_cptr)shm;
    const lds_cptr kp0 = shm3 + LDS_K + hi * 1024 + r32 * 16;
    const lds_cptr vp0 = shm3 + LDS_V + ((lane >> 4) & 1) * 32 + (lane & 3) * 8 + (4 * hi + ((lane & 15) >> 2)) * 64;
    const int NT = 4 * (qb + 1);
    A3_DMA_K(0, 0); A3_DMA_V(0, 0); A3_DMA_K(1, 1);
    bf16x8 qr[NKS];
    { const bf16* Qw = Qb + (size_t)(rb * 32 + r32) * LDQ + hi * 8;
#pragma unroll
      for (int d0 = 0; d0 < NKS; ++d0) qr[d0] = __builtin_nontemporal_load(reinterpret_cast<const bf16x8*>(Qw + d0 * 16)); }
    float mhat = 0.f, l_reg = 0.f; f32x16 o[NB];
#pragma unroll
    for (int d = 0; d < NB; ++d) o[d] = f32x16{};
    constexpr bool FIXC = FIXM == 1;
    f32x16 negm = f32x16{}; if (!FIXC) asm volatile("" : "+v"(negm));
    const int qlo = 256 * qb + rb * 32, qm = qlo + r32 - 4 * hi, lastw = 4 * qb + (rb >> 1);
    bool fix = FIXC;
    if (!FIXC && qn != nullptr) { const float bnd = qn[(size_t)(rb * 32 + r32) * 8] * kmax * 1.01f; fix = !__any(!(bnd < 100.f)); }
    u32x4 pw[4]; asm volatile("" : "=v"(pw[0]), "=v"(pw[1]), "=v"(pw[2]), "=v"(pw[3])); bool resc = false;
    int slk = 0, slv = 0;
#define A3_KFRAG(kp_, i) kld((kp_) + ((i) >> 1) * 2048 + ((i) & 1) * 512)
#define A3_VFRAG(vp_, j) ((vp_) + ((j) % NB) * 4096 + ((j) / NB) * 1024)
#define A3_MASK(C0_, C1_, t) do { if ((t) * 64 + 63 > qlo) mask_tile(C0_, C1_, qm - (t) * 64); } while (0)
#define A3_ROWMAX(C0_, C1_, rm_) do { float a_ = fmaxf(fmaxf(C0_[0], C0_[1]), C1_[0]), b_ = fmaxf(fmaxf(C0_[2], C0_[3]), C1_[1]); a_ = fmaxf(fmaxf(a_, C1_[2]), C1_[3]); \
        _Pragma("unroll") for (int r = 4; r < 16; r += 4) { a_ = fmaxf(fmaxf(a_, C0_[r]), C0_[r + 1]); b_ = fmaxf(fmaxf(b_, C0_[r + 2]), C0_[r + 3]); a_ = fmaxf(fmaxf(a_, C1_[r]), C1_[r + 1]); b_ = fmaxf(fmaxf(b_, C1_[r + 2]), C1_[r + 3]); } \
        rm_ = fmaxf(a_, b_); { auto rr_ = __builtin_amdgcn_permlane32_swap(__float_as_uint(rm_), __float_as_uint(rm_), false, false); rm_ = fmaxf(__uint_as_float(rr_[0]), __uint_as_float(rr_[1])); } } while (0)
#define A3_STEP(C0, C1, P0, P1, t, BAND) do { \
        const bool gk_ = !(BAND) || ((t) + 2 < NT), gv_ = !(BAND) || ((t) + 1 < NT); \
        const lds_cptr kp_ = kp0 + slk * KSL; const lds_cptr vp_ = vp0 + slv * VSL; \
        bf16x8 kf_[3]; s16x4 vl_[3], vh_[3]; float sacc_ = 0.f; \
        if (A3_DMA_EARLY) { if (gk_) A3_DMA_K((t) + 2, slk == 0 ? 2 : slk - 1); if (gv_) A3_DMA_V((t) + 1, slv == 0 ? 2 : slv - 1); SBAR(); } \
        kf_[0] = A3_KFRAG(kp_, 0); kf_[1] = A3_KFRAG(kp_, 1); SBAR(); \
        if (LPRE) { _Pragma("unroll") for (int e = EB; e < 32; ++e) { if (e < 16) P0[e & 15] = __builtin_amdgcn_exp2f(P0[e & 15]); else P1[e & 15] = __builtin_amdgcn_exp2f(P1[e & 15]); } if (EB < 16) A3_PIN(P0); A3_PIN(P1); } \
        if (PS > 0) { _Pragma("unroll") for (int e = 0; e < PS; ++e) sacc_ += A3_PEL(P0, P1, e); A3_PIN(sacc_); } \
        SBAR(); A3_PRIO(1); \
        _Pragma("unroll") for (int i = 0; i < NQK; ++i) { \
            if (i + 2 < NQK) kf_[(i + 2) % 3] = A3_KFRAG(kp_, i + 2); \
            if (i == NQK - 2) { vl_[0] = vtr(A3_VFRAG(vp_, 0)); vh_[0] = vtr(A3_VFRAG(vp_, 0) + 512); } \
            if (i == NQK - 1) { vl_[1] = vtr(A3_VFRAG(vp_, 1)); vh_[1] = vtr(A3_VFRAG(vp_, 1) + 512); } \
            SBAR(); \
            if ((i & 1) == 0) C0 = __builtin_amdgcn_mfma_f32_32x32x16_bf16(kf_[i % 3], qr[i >> 1], i < 2 ? negm : C0, 0, 0, 0); \
            else C1 = __builtin_amdgcn_mfma_f32_32x32x16_bf16(kf_[i % 3], qr[i >> 1], i < 2 ? negm : C1, 0, 0, 0); \
            if (!LPRE && A3_LPG * i < NL) { _Pragma("unroll") for (int e = EB + A3_LPG * i; e < EB + A3_LPG * i + A3_LPG; ++e) { if (e < 16) P0[e & 15] = __builtin_amdgcn_exp2f(P0[e & 15]); else P1[e & 15] = __builtin_amdgcn_exp2f(P1[e & 15]); } \
                if (EB + A3_LPG * i < 16) A3_PIN(P0); else A3_PIN(P1); } \
            _Pragma("unroll") for (int e = PS + (i * (32 - PS - SB)) / NQK; e < PS + ((i + 1) * (32 - PS - SB)) / NQK; ++e) sacc_ += A3_PEL(P0, P1, e); \
            A3_PIN(sacc_); \
            _Pragma("unroll") for (int c = (i * 16) / NQK; c < ((i + 1) * 16) / NQK; ++c) { const int e = 2 * c; pw[c >> 2][c & 3] = cvtpk_s(A3_PEL(P0, P1, e), A3_PEL(P0, P1, e + 1)); } \
            A3_PIN(pw[((i * 16) / NQK) >> 2]); \
            SBAR(); } \
        A3_PRIO(0); if (SB == 0) l_reg += sacc_; \
        if (!A3_DMA_EARLY) { if (gk_ && A3_DMA_KB < 0) A3_DMA_K((t) + 2, slk == 0 ? 2 : slk - 1); if (gv_ && A3_DMA_VB < 0) A3_DMA_V((t) + 1, slv == 0 ? 2 : slv - 1); } \
        if (BAND) A3_MASK(C0, C1, t); \
        if (!FIXC && !fix) { float rm_; A3_ROWMAX(C0, C1, rm_); resc = false; \
          if (__builtin_expect(__any(rm_ > THRL), 0)) { const float dl = fmaxf(rm_, 0.f); mhat += dl; \
              _Pragma("unroll") for (int r = 0; r < 16; ++r) { C0[r] -= dl; C1[r] -= dl; } \
              _Pragma("unroll") for (int r = 0; r < 16; ++r) negm[r] = -mhat; asm volatile("" : "+v"(negm)); \
              const float f = __builtin_amdgcn_exp2f(-dl); l_reg *= f; if (hi == 0) wsf[r32] = f; resc = true; } } \
        SBAR(); A3_PRIO(1); \
        _Pragma("unroll") for (int j = 0; j < NPV; ++j) { \
            if (j + 2 < NPV) { vl_[(j + 2) % 3] = vtr(A3_VFRAG(vp_, j + 2)); vh_[(j + 2) % 3] = vtr(A3_VFRAG(vp_, j + 2) + 512); } \
            SBAR(); \
            o[j % NB] = __builtin_amdgcn_mfma_f32_32x32x16_bf16(__builtin_bit_cast(bf16x8, pw[j / NB]), \
                (bf16x8){vl_[j % 3][0], vl_[j % 3][1], vl_[j % 3][2], vl_[j % 3][3], vh_[j % 3][0], vh_[j % 3][1], vh_[j % 3][2], vh_[j % 3][3]}, o[j % NB], 0, 0, 0); \
            _Pragma("unroll") for (int e = (j * EB) / NPV; e < ((j + 1) * EB) / NPV; ++e) { if (e < 16) C0[e & 15] = __builtin_amdgcn_exp2f(C0[e & 15]); else C1[e & 15] = __builtin_amdgcn_exp2f(C1[e & 15]); } \
            if (((j * EB) / NPV) < 16) A3_PIN(C0); if ((((j + 1) * EB) / NPV) > 16) A3_PIN(C1); \
            if (SB > 0) { _Pragma("unroll") for (int e = 32 - SB + (j * SB) / NPV; e < 32 - SB + ((j + 1) * SB) / NPV; ++e) sacc_ += A3_PEL(P0, P1, e); A3_PIN(sacc_); } \
            if (A3_DMA_KB >= 0 && j == A3_DMA_KB) { if (gk_) A3_DMA_K((t) + 2, slk == 0 ? 2 : slk - 1); } \
            if (A3_DMA_VB >= 0 && j == A3_DMA_VB) { if (gv_) A3_DMA_V((t) + 1, slv == 0 ? 2 : slv - 1); } \
            SBAR(); } \
        A3_PRIO(0); if (SB > 0) l_reg += sacc_; A3_WAIT_BAR(gk_, gv_); \
        if (!FIXC && resc) { asm volatile("s_waitcnt lgkmcnt(0)" ::: "memory"); \
            _Pragma("unroll") for (int d_ = 0; d_ < NB; ++d_) _Pragma("unroll") for (int r = 0; r < 16; ++r) o[d_][r] *= wsf[crow(r, hi)]; } \
        slk = slk == 2 ? 0 : slk + 1; slv = (t) == 0 ? 0 : (slv == 2 ? 0 : slv + 1); \
    } while (0)
    f32x16 pA0, pA1, pB0, pB1;
    A3_WB(0);
    { const lds_cptr kp_ = kp0;
#pragma unroll
      for (int i = 0; i < NQK; ++i) { const bf16x8 kf = A3_KFRAG(kp_, i);
          if ((i & 1) == 0) pA0 = __builtin_amdgcn_mfma_f32_32x32x16_bf16(kf, qr[i >> 1], i < 2 ? negm : pA0, 0, 0, 0); else pA1 = __builtin_amdgcn_mfma_f32_32x32x16_bf16(kf, qr[i >> 1], i < 2 ? negm : pA1, 0, 0, 0); }
      A3_DMA_K(2, 2); A3_DMA_V(1, 1);
      A3_MASK(pA0, pA1, 0);
      if (!FIXC && !fix) { float rm; A3_ROWMAX(pA0, pA1, rm); mhat = rm;
#pragma unroll
          for (int r = 0; r < 16; ++r) { pA0[r] -= rm; pA1[r] -= rm; }
#pragma unroll
          for (int r = 0; r < 16; ++r) negm[r] = -mhat;
          asm volatile("" : "+v"(negm)); }
#pragma unroll
      for (int e = 0; e < EB; ++e) { if (e < 16) pA0[e & 15] = __builtin_amdgcn_exp2f(pA0[e & 15]); else pA1[e & 15] = __builtin_amdgcn_exp2f(pA1[e & 15]); }
      A3_WAIT_BAR(true, true);
      slk = 1; slv = 0; }
    int t = 1;
#pragma unroll 1
    for (; t + 5 < NT; t += 2) { A3_STEP(pB0, pB1, pA0, pA1, t, false); A3_STEP(pA0, pA1, pB0, pB1, t + 1, false); }
#define A3_DRAINP(P0, P1) do { float sacc = 0.f; \
        _Pragma("unroll") for (int e = EB; e < 32; ++e) { if (e < 16) P0[e & 15] = __builtin_amdgcn_exp2f(P0[e & 15]); else P1[e & 15] = __builtin_amdgcn_exp2f(P1[e & 15]); } \
        _Pragma("unroll") for (int r = 0; r < 16; ++r) sacc += P0[r]; \
        _Pragma("unroll") for (int r = 0; r < 16; ++r) sacc += P1[r]; \
        l_reg += sacc; \
        _Pragma("unroll") for (int c = 0; c < 16; ++c) { const int e = 2 * c; pw[c >> 2][c & 3] = cvtpk_s(A3_PEL(P0, P1, e), A3_PEL(P0, P1, e + 1)); } \
        const lds_cptr vq_ = vp0 + slv * VSL; \
        s16x4 vl_[3], vh_[3]; vl_[0] = vtr(A3_VFRAG(vq_, 0)); vh_[0] = vtr(A3_VFRAG(vq_, 0) + 512); vl_[1] = vtr(A3_VFRAG(vq_, 1)); vh_[1] = vtr(A3_VFRAG(vq_, 1) + 512); SBAR(); \
        _Pragma("unroll") for (int j = 0; j < NPV; ++j) { \
            if (j + 2 < NPV) { vl_[(j + 2) % 3] = vtr(A3_VFRAG(vq_, j + 2)); vh_[(j + 2) % 3] = vtr(A3_VFRAG(vq_, j + 2) + 512); } \
            SBAR(); \
            o[j % NB] = __builtin_amdgcn_mfma_f32_32x32x16_bf16(__builtin_bit_cast(bf16x8, pw[j / NB]), \
                (bf16x8){vl_[j % 3][0], vl_[j % 3][1], vl_[j % 3][2], vl_[j % 3][3], vh_[j % 3][0], vh_[j % 3][1], vh_[j % 3][2], vh_[j % 3][3]}, o[j % NB], 0, 0, 0); \
            SBAR(); } } while (0)
#define A3_TAIL(t) do { const bool gk_ = (t) + 2 < NT, gv_ = (t) + 1 < NT; \
        if (gk_) A3_DMA_K((t) + 2, slk == 0 ? 2 : slk - 1); if (gv_) A3_DMA_V((t) + 1, slv == 0 ? 2 : slv - 1); \
        A3_WAIT_BAR(gk_, gv_); slk = slk == 2 ? 0 : slk + 1; slv = slv == 2 ? 0 : slv + 1; } while (0)
    if (FIXC && A3_TWOLV) {
#pragma unroll 1
        for (; t + 3 < NT; t += 2) { A3_STEP(pB0, pB1, pA0, pA1, t, true); A3_STEP(pA0, pA1, pB0, pB1, t + 1, true); }
        A3_STEP(pB0, pB1, pA0, pA1, NT - 3, true);
        const int cls = rb >> 1;
        if (cls >= 2) { A3_STEP(pA0, pA1, pB0, pB1, NT - 2, true);
            if (cls == 3) { A3_STEP(pB0, pB1, pA0, pA1, NT - 1, true); }
            else { pB0 = pA0; pB1 = pA1; A3_WAIT_BAR(false, false); } }
        else { A3_DMA_V(NT - 1, slv == 0 ? 2 : slv - 1); A3_WAIT_BAR(false, true); A3_WAIT_BAR(false, false); }
    } else {
#pragma unroll 1
    for (; t + 1 < NT; t += 2) { A3_STEP(pB0, pB1, pA0, pA1, t, true); A3_STEP(pA0, pA1, pB0, pB1, t + 1, true); }
    if ((rb >> 1) == 3) { A3_STEP(pB0, pB1, pA0, pA1, NT - 1, true); }
    else { pB0 = pA0; pB1 = pA1; A3_WAIT_BAR(false, false); }
    }
    A3_DRAINP(pB0, pB1);
#undef A3_TAIL
#undef A3_DRAINP
    { auto rr = __builtin_amdgcn_permlane32_swap(__float_as_uint(l_reg), __float_as_uint(l_reg), false, false); l_reg = __uint_as_float(rr[0]) + __uint_as_float(rr[1]); }
    if (FIXC && utag != 0u) { const bool bad_ = !(l_reg >= 0x1p-60f && l_reg <= 0x1p60f) || A3_BADALL; if (__any(bad_)) { if (lane == 0) misc[1] = utag; } }
    if (hi == 0) wsf[32 + r32] = l_reg; asm volatile("s_waitcnt lgkmcnt(0)" ::: "memory");
    float rli[16];
#pragma unroll
    for (int r = 0; r < 16; ++r) rli[r] = __builtin_amdgcn_rcpf(wsf[32 + crow(r, hi)]);
    constexpr int PC = 64, NPASS = DV / PC, BPP = PC / 32;
    unsigned nxt = 0u; if (tid == 0 && qp != nullptr) nxt = __hip_atomic_fetch_add(qp, 1u, __ATOMIC_RELAXED, __HIP_MEMORY_SCOPE_AGENT);
    LAS char* stg = (LAS char*)shm + LDS_WS + 2048 + wid * 4096;
    LAS char* stw = stg + hi * 512 + r32 * 2;
    bf16* Ow = Ob + (size_t)(rb * 32 + (lane >> 3)) * LDO + (lane & 7) * 8;
#pragma unroll
    for (int ps = 0; ps < NPASS; ++ps) {
#pragma unroll
        for (int r = 0; r < 16; r += 2)
#pragma unroll
            for (int b = 0; b < BPP; ++b) { const unsigned pk = cvtpk(o[ps * BPP + b][r] * rli[r], o[ps * BPP + b][r + 1] * rli[r + 1]);
                *(LAS unsigned short*)(stw + crow(r, 0) * 128 + b * 64) = (unsigned short)pk; *(LAS unsigned short*)(stw + crow(r + 1, 0) * 128 + b * 64) = (unsigned short)(pk >> 16); }
        asm volatile("s_waitcnt lgkmcnt(0)" ::: "memory");
        u32x4 ov[4];
#pragma unroll
        for (int i = 0; i < 4; ++i) ov[i] = *(const LAS u32x4*)(stg + i * 1024 + lane * 16);
        asm volatile("s_waitcnt lgkmcnt(0)" ::: "memory");
        if (kvmul) {
#pragma unroll
            for (int i = 0; i < 4; ++i) *(u32x4*)(Ow + (size_t)(i * 8) * LDO + ps * PC) = ov[i]; }
    }
    if (tid == 0 && qp != nullptr) misc[0] = nxt;
    asm volatile("s_waitcnt lgkmcnt(0)\n\ts_barrier" ::: "memory");
    unsigned nidx = (unsigned)__builtin_amdgcn_readfirstlane((int)misc[0]);
    if (FIXC && utag != 0u) { if ((unsigned)__builtin_amdgcn_readfirstlane((int)misc[1]) == utag) nidx |= 0x80000000u; }
#undef A3_DMA_K
#undef A3_DMA_V
#undef A3_WB
#undef A3_WAIT_BAR
#undef A3_KFRAG
#undef A3_VFRAG
#undef A3_MASK
#undef A3_ROWMAX
#undef A3_STEP
    return nidx;
}
#undef A3_PIN
#undef A3_PEL
}
namespace ret {
using namespace at;
__device__ __forceinline__ float log2_gamma(int h) { return h == 0 ? -0.04580368961312479f : h == 1 ? -0.02272007650008353f : h == 2 ? -0.011315313227834146f : -0.005646563141142063f; }
constexpr int IMG = 8192;
template <int OFF> __device__ __forceinline__ s16x4 trr(int vb) { s16x4 r; asm volatile("ds_read_b64_tr_b16 %0, %1 offset:%2" : "=&v"(r) : "v"(vb), "i"(OFF) : "memory"); return r; }

__device__ __forceinline__ void state_item(const bf16* __restrict__ RK, const bf16* __restrict__ RV, float* __restrict__ AST, int b, int h, int cp, char* lds) {
    int tid_ = threadIdx.x; asm volatile("" : "+v"(tid_));
    const int tid = tid_, wid = __builtin_amdgcn_readfirstlane(tid >> 6), lane = tid & 63, r32 = lane & 31, hi = lane >> 5;
    const float l2g = log2_gamma(h);
    const size_t row0 = (size_t)b * SEQ + 256 * cp;
    const int key = tid >> 3, c = (tid & 7) * 8, vst = v_st<2>(key, c);
    bf16x8 kk[4], vv[4];
#pragma unroll
    for (int t = 0; t < 4; ++t) { kk[t] = *reinterpret_cast<const bf16x8*>(RK + (row0 + 64 * t + key) * 256 + h * 64 + c); vv[t] = *reinterpret_cast<const bf16x8*>(RV + (row0 + 64 * t + key) * 256 + h * 64 + c); }
#pragma unroll
    for (int t = 0; t < 4; ++t) { const int j = (64 * t + key) & 127; const float z = __builtin_amdgcn_exp2f((float)(127 - j) * l2g);
        u32x4 w; w.x = cvtpk(bf2f(kk[t][0]) * z, bf2f(kk[t][1]) * z); w.y = cvtpk(bf2f(kk[t][2]) * z, bf2f(kk[t][3]) * z); w.z = cvtpk(bf2f(kk[t][4]) * z, bf2f(kk[t][5]) * z); w.w = cvtpk(bf2f(kk[t][6]) * z, bf2f(kk[t][7]) * z);
        *(u32x4*)(lds + t * IMG + vst) = w; *(bf16x8*)(lds + (4 + t) * IMG + vst) = vv[t]; }
    __syncthreads();
    const int half = wid >> 2, db = (wid >> 1) & 1, eb = wid & 1;
    const int va = (int)(uintptr_t)lds + v_rd_base(lane) + db * 512, vb = (int)(uintptr_t)lds + 4 * IMG + v_rd_base(lane) + eb * 512;
    f32x16 acc = f32x16{};
#define RT_STEP(T, KS) do { const s16x4 al = trr<(T) * IMG + v_rd_off<2>(0, KS, 0)>(va2), ah = trr<(T) * IMG + v_rd_off<2>(0, KS, 1)>(va2), bl = trr<(T) * IMG + v_rd_off<2>(0, KS, 0)>(vb2), bh = trr<(T) * IMG + v_rd_off<2>(0, KS, 1)>(vb2); \
        asm volatile("s_waitcnt lgkmcnt(0)" ::: "memory"); SBAR(); \
        acc = __builtin_amdgcn_mfma_f32_32x32x16_bf16((bf16x8){al[0], al[1], al[2], al[3], ah[0], ah[1], ah[2], ah[3]}, (bf16x8){bl[0], bl[1], bl[2], bl[3], bh[0], bh[1], bh[2], bh[3]}, acc, 0, 0, 0); } while (0)
    { const int va2 = va + half * 2 * IMG, vb2 = vb + half * 2 * IMG;
      RT_STEP(0, 0); RT_STEP(0, 1); RT_STEP(0, 2); RT_STEP(0, 3); RT_STEP(1, 0); RT_STEP(1, 1); RT_STEP(1, 2); RT_STEP(1, 3); }
#undef RT_STEP
    asm volatile("s_nop 7\n\ts_nop 7\n\ts_nop 7" : "+v"(acc));
    bf16* dst = (bf16*)AST + ((size_t)((b * 4 + h) * 64 + 2 * cp + half)) * 4096 + (size_t)(32 * db) * 64 + 32 * eb + r32;
#pragma unroll
    for (int r = 0; r < 16; r += 2) { const unsigned pk = cvtpk(acc[r], acc[r + 1]); *(unsigned short*)(dst + crow(r, hi) * 64) = (unsigned short)pk; *(unsigned short*)(dst + crow(r + 1, hi) * 64) = (unsigned short)(pk >> 16); }
    __syncthreads();
}

__device__ __forceinline__ void ret_unit(const bf16* __restrict__ RQ, const bf16* __restrict__ RK, const bf16* __restrict__ RV, const bf16* __restrict__ RG, const float* __restrict__ AST,
                                         const float* __restrict__ gnw, const float* __restrict__ gnb, bf16* __restrict__ MIX, int b, int h, int cp, char* lds) {
    int tid_ = threadIdx.x; asm volatile("" : "+v"(tid_));
    const int tid = tid_, wid = __builtin_amdgcn_readfirstlane(tid >> 6), lane = tid & 63, r32 = lane & 31, hi = lane >> 5;
    const float l2g = log2_gamma(h);
    const size_t row0 = (size_t)b * SEQ + 256 * cp;
    char* K_lds = lds; char* V_lds = lds + 4 * IMG; char* R_lds = lds + 8 * IMG; char* S_lds = lds;
    { const int key = tid >> 3, ch = tid & 7, c = ch * 8, vst = v_st<2>(key, c), kst = k_addr<128>(key, ch);
      bf16x8 kk[4], vv[4];
#pragma unroll
      for (int t = 0; t < 4; ++t) { kk[t] = *reinterpret_cast<const bf16x8*>(RK + (row0 + 64 * t + key) * 256 + h * 64 + c); vv[t] = *reinterpret_cast<const bf16x8*>(RV + (row0 + 64 * t + key) * 256 + h * 64 + c); }
      const float gC = __builtin_amdgcn_exp2f(128.f * l2g);
      const bf16* ap = (const bf16*)AST + (size_t)((b * 4 + h) * 64) * 4096 + (size_t)key * 64 + c;
#define RT_LO4(x) ((f32x4){bf2f((x)[0]), bf2f((x)[1]), bf2f((x)[2]), bf2f((x)[3])})
#define RT_HI4(x) ((f32x4){bf2f((x)[4]), bf2f((x)[5]), bf2f((x)[6]), bf2f((x)[7])})
      f32x4 r0 = {0.f, 0.f, 0.f, 0.f}, r1 = {0.f, 0.f, 0.f, 0.f};
      const int nprev = 2 * cp;
      { float w = 1.0f;
        int j = nprev - 1;
        for (; j >= 7; j -= 8) { bf16x8 xs[8];
#pragma unroll
            for (int q = 0; q < 8; ++q) xs[q] = *reinterpret_cast<const bf16x8*>(ap + (size_t)(j - q) * 4096);
#pragma unroll
            for (int q = 0; q < 8; ++q) { r0 += RT_LO4(xs[q]) * w; r1 += RT_HI4(xs[q]) * w; w *= gC; } }
        if (j >= 1) { bf16x8 xs[6];
#pragma unroll
            for (int q = 0; q < 6; ++q) { if (j - q >= 0) xs[q] = *reinterpret_cast<const bf16x8*>(ap + (size_t)(j - q) * 4096); else xs[q] = bf16x8{}; }
#pragma unroll
            for (int q = 0; q < 6; ++q) { r0 += RT_LO4(xs[q]) * w; r1 += RT_HI4(xs[q]) * w; w *= gC; } } }
      *(u32x4*)(R_lds + vst) = (u32x4){cvtpk(r0[0], r0[1]), cvtpk(r0[2], r0[3]), cvtpk(r1[0], r1[1]), cvtpk(r1[2], r1[3])};
      { const bf16x8 an = *reinterpret_cast<const bf16x8*>(ap + (size_t)nprev * 4096); r0 = RT_LO4(an) + r0 * gC; r1 = RT_HI4(an) + r1 * gC; }
#undef RT_LO4
#undef RT_HI4
      *(u32x4*)(R_lds + IMG + vst) = (u32x4){cvtpk(r0[0], r0[1]), cvtpk(r0[2], r0[3]), cvtpk(r1[0], r1[1]), cvtpk(r1[2], r1[3])};
#pragma unroll
      for (int t = 0; t < 4; ++t) { *(bf16x8*)(K_lds + t * IMG + kst) = kk[t]; *(bf16x8*)(V_lds + t * IMG + vst) = vv[t]; }
    }
    __syncthreads();
    const int half = wid >> 2, wq = wid & 3;
    bf16x8 qr[4];
    { const bf16* Qw = RQ + (row0 + 128 * half + 32 * wq + r32) * 256 + h * 64 + hi * 8;
#pragma unroll
      for (int d0 = 0; d0 < 4; ++d0) qr[d0] = *reinterpret_cast<const bf16x8*>(Qw + d0 * 16); }
    f32x16 o[2]; o[0] = f32x16{}; o[1] = f32x16{};
    const int vbase = (int)(uintptr_t)V_lds + v_rd_base(lane);
    const int iq = 32 * wq + r32;
#pragma unroll
    for (int tt = 0; tt < 2; ++tt) {
        if (64 * tt > 32 * wq + 31) continue;
        f32x16 p0, p1; bf16x8 pa0, pa1, pa2, pa3;
        qkt<64, 128>(p0, p1, K_lds + (2 * half + tt) * IMG, r32, hi, qr);
#pragma unroll
        for (int r = 0; r < 16; ++r) { const int d0_ = iq - (64 * tt + crow(r, hi)), d1_ = d0_ - 32;
            p0[r] = d0_ >= 0 ? p0[r] * __builtin_amdgcn_exp2f((float)d0_ * l2g) : 0.f; p1[r] = d1_ >= 0 ? p1[r] * __builtin_amdgcn_exp2f((float)d1_ * l2g) : 0.f; }
        pack_p(p0, p1, pa0, pa1, pa2, pa3);
        pv_all<2>(o, vbase + (2 * half + tt) * IMG, pa0, pa1, pa2, pa3);
    }
    { f32x16 oc[2]; oc[0] = f32x16{}; oc[1] = f32x16{};
      pv_all<2>(oc, (int)(uintptr_t)R_lds + half * IMG + v_rd_base(lane), qr[0], qr[1], qr[2], qr[3]);
#pragma unroll
      for (int r = 0; r < 16; ++r) { const float xi = __builtin_amdgcn_exp2f((float)(32 * wq + crow(r, hi) + 1) * l2g); o[0][r] += oc[0][r] * xi; o[1][r] += oc[1][r] * xi; } }
    __syncthreads();
    float* st = (float*)(S_lds + wid * 8448);
#pragma unroll
    for (int r = 0; r < 16; ++r) { st[crow(r, hi) * 66 + r32] = o[0][r]; st[crow(r, hi) * 66 + 32 + r32] = o[1][r]; }
    asm volatile("s_waitcnt lgkmcnt(0)" ::: "memory");
    { const int rr = lane >> 1, hh = lane & 1; const float* sp = st + rr * 66 + hh * 32; float x[32]; float s = 0.f;
#pragma unroll
      for (int k = 0; k < 32; ++k) { x[k] = sp[k]; s += x[k]; }
      s += shx<1>(s); const float mean = s * (1.0f / 64.0f); float q = 0.f;
#pragma unroll
      for (int k = 0; k < 32; ++k) { x[k] -= mean; q += x[k] * x[k]; }
      q += shx<1>(q); const float rstd = 1.0f / sqrtf(q * (1.0f / 64.0f) + 1e-6f);
      const size_t grow = row0 + 128 * half + 32 * wq + rr; const int cb = h * 64 + hh * 32;
      const bf16* gp = RG + grow * 256 + cb; bf16* op = MIX + grow * 1024 + 768 + cb;
#pragma unroll
      for (int k8 = 0; k8 < 4; ++k8) { const bf16x8 g8 = *reinterpret_cast<const bf16x8*>(gp + 8 * k8); const f32x4 w0 = *(const f32x4*)(gnw + cb + 8 * k8), w1 = *(const f32x4*)(gnw + cb + 8 * k8 + 4), bb0 = *(const f32x4*)(gnb + cb + 8 * k8), bb1 = *(const f32x4*)(gnb + cb + 8 * k8 + 4);
          float y[8];
#pragma unroll
          for (int k = 0; k < 8; ++k) y[k] = (x[8 * k8 + k] * rstd * (k < 4 ? w0[k & 3] : w1[k & 3]) + (k < 4 ? bb0[k & 3] : bb1[k & 3])) * bf2f(g8[k]);
          *(u32x4*)(op + 8 * k8) = (u32x4){cvtpk(y[0], y[1]), cvtpk(y[2], y[3]), cvtpk(y[4], y[5]), cvtpk(y[6], y[7])}; } }
    __syncthreads();
}

__device__ __forceinline__ void combine_row(const bf16* __restrict__ OD, const float* __restrict__ subln, float lam, float oml, bf16* __restrict__ MIX, size_t row, int lane) {
    const int head = lane >> 4, e0 = (lane & 15) * 8;
    const bf16x8 a = *reinterpret_cast<const bf16x8*>(OD + row * 1024 + head * 256 + e0), b2 = *reinterpret_cast<const bf16x8*>(OD + row * 1024 + head * 256 + 128 + e0);
    float o[8]; float s = 0.f;
#pragma unroll
    for (int k = 0; k < 8; ++k) { o[k] = bf2f(a[k]) - lam * bf2f(b2[k]); s += o[k] * o[k]; }
    s += shx<1>(s); s += shx<2>(s); s += shx<4>(s); s += shx<8>(s);
    const float rs = oml / sqrtf(s * (1.0f / 128.0f) + 1e-5f);
    const f32x4 g0 = *(const f32x4*)(subln + e0), g1 = *(const f32x4*)(subln + e0 + 4);
    *(u32x4*)(MIX + row * 1024 + head * 128 + e0) = (u32x4){cvtpk(o[0] * rs * g0[0], o[1] * rs * g0[1]), cvtpk(o[2] * rs * g0[2], o[3] * rs * g0[3]), cvtpk(o[4] * rs * g1[0], o[5] * rs * g1[1]), cvtpk(o[6] * rs * g1[2], o[7] * rs * g1[3])};
}
__device__ __forceinline__ void combine_rows4(const bf16* __restrict__ OD, const float* __restrict__ subln, float lam, float oml, bf16* __restrict__ MIX, size_t row, size_t stride, int lane) {
    const int head = lane >> 4, e0 = (lane & 15) * 8;
    bf16x8 a[4], b2[4];
#pragma unroll
    for (int k = 0; k < 4; ++k) { a[k] = __builtin_nontemporal_load(reinterpret_cast<const bf16x8*>(OD + (row + k * stride) * 1024 + head * 256 + e0)); b2[k] = __builtin_nontemporal_load(reinterpret_cast<const bf16x8*>(OD + (row + k * stride) * 1024 + head * 256 + 128 + e0)); }
    const f32x4 g0 = *(const f32x4*)(subln + e0), g1 = *(const f32x4*)(subln + e0 + 4);
#pragma unroll
    for (int k = 0; k < 4; ++k) { float o[8]; float s = 0.f;
#pragma unroll
        for (int j = 0; j < 8; ++j) { o[j] = bf2f(a[k][j]) - lam * bf2f(b2[k][j]); s += o[j] * o[j]; }
        s += shx<1>(s); s += shx<2>(s); s += shx<4>(s); s += shx<8>(s);
        const float rs = oml / sqrtf(s * (1.0f / 128.0f) + 1e-5f);
        const u32x4 w = (u32x4){cvtpk(o[0] * rs * g0[0], o[1] * rs * g0[1]), cvtpk(o[2] * rs * g0[2], o[3] * rs * g0[3]), cvtpk(o[4] * rs * g1[0], o[5] * rs * g1[1]), cvtpk(o[6] * rs * g1[2], o[7] * rs * g1[3])};
        asm volatile("global_store_dwordx4 %0, %1, off sc1\n\ts_nop 1" :: "v"(MIX + (row + k * stride) * 1024 + head * 128 + e0), "v"(w) : "memory"); }
}
}
#ifndef MK_N_LAUNCHES
#define MK_N_LAUNCHES 1
#endif
constexpr int N_PHASES = 16;

struct Args { const void* in[21]; float* out; unsigned char* ws; int ph_lo, ph_hi; };
static_assert(sizeof(Args) == 23 * 8 + 8, "no padding");

__device__ __forceinline__ float wave_sum(float v) { v += shx<1>(v); v += shx<2>(v); v += shx<4>(v); v += shx<8>(v); v += shx<16>(v); return add_x32(v); }
__device__ const float INVF[32] = { 1.000000000e+00f, 7.498942018e-01f, 5.623413324e-01f, 4.216965139e-01f, 3.162277639e-01f, 2.371373922e-01f, 1.778279394e-01f, 1.333521456e-01f, 1.000000015e-01f, 7.498941571e-02f, 5.623412877e-02f,
    4.216964915e-02f, 3.162277862e-02f, 2.371373586e-02f, 1.778279431e-02f, 1.333521493e-02f, 9.999999776e-03f, 7.498942316e-03f, 5.623413250e-03f, 4.216964822e-03f, 3.162277862e-03f, 2.371373819e-03f, 1.778279431e-03f,
    1.333521446e-03f, 1.000000047e-03f, 7.498941850e-04f, 5.623413017e-04f, 4.216965463e-04f, 3.162277862e-04f, 2.371373848e-04f, 1.778279402e-04f, 1.333521504e-04f };

#ifndef CV_NT
#define CV_NT 1
#endif
struct WSrc { const float *w_in, *attn_norm, *w_uq, *q_norm, *w_ukv, *kv_norm, *w_out, *w_gate, *w_up, *ffn_norm, *w_down; };
__device__ __forceinline__ int ckv_slot(int p) { const int x = p & 127; if (x < 16) return -1; const int s = ((p >> 7) ? 112 : 0) + x - 16; return s < 128 ? s : -1; }
__device__ __forceinline__ bool src_in(const WSrc& w, int n, int k, const float*& p, float& g) {
    const int pn = n >> 8, q = n & 255, bj = q >> 7, x = q & 127, wc = x >> 5, y = x & 31, rp = 64 * wc + 32 * bj + y; int c;
    switch (pn) {
        case 0: case 1: c = 256 * pn + rp; break;
        case 2: case 3: c = 512 + 256 * (pn - 2) + rp; break;
        case 4: case 5: c = 1024 + 256 * (pn - 4) + q; break;
        case 6: c = 1536 + q; break;
        case 7: if (x < 16) c = 1920 + 16 * bj + x; else { const int s = ckv_slot(q); if (s < 0) return false; c = 1792 + s; } break;
        case 8: c = 1952 + rp; break;
        case 9: c = 2208 + rp; break;
        case 10: c = 2464 + q; break;
        default: c = 2720 + q; break;
    }
    p = w.w_in + (size_t)k * IN_COLS + c; g = w.attn_norm[k]; return true;
}
__device__ __forceinline__ bool src_uq(const WSrc& w, int n, int k, const float*& p, float& g) {
    const int pn = n >> 8, q = n & 255, bj = q >> 7, x = q & 127, wc = x >> 5, y = x & 31, head = 2 * pn + (wc >> 1); int c;
    if ((wc & 1) == 0) c = head * 96 + 32 * bj + y; else { if (y >= 16) return false; c = head * 96 + 64 + 16 * bj + y; }
    p = w.w_uq + (size_t)k * 384 + c; g = w.q_norm[k]; return true;
}
__device__ __forceinline__ bool src_ukv(const WSrc& w, int n, int k, const float*& p, float& g) {
    const int pn = n >> 8, q = n & 255, bj = q >> 7, x = q & 127, wc = x >> 5, y = x & 31, head = 2 * pn + (wc >> 1), c = head * 128 + 64 * (wc & 1) + 32 * bj + y;
    const int s = ckv_slot(k); if (s < 0) return false;
    p = w.w_ukv + (size_t)s * 512 + c; g = w.kv_norm[s]; return true;
}
__device__ __forceinline__ bool src_out(const WSrc& w, int n, int k, const float*& p, float& g) { p = w.w_out + (size_t)k * 1024 + n; g = 1.0f; return true; }
__device__ __forceinline__ bool src_gu(const WSrc& w, int n, int k, const float*& p, float& g) { const int c = 128 * (n >> 8) + (n & 127); p = ((n >> 7) & 1 ? w.w_up : w.w_gate) + (size_t)k * FFH + c; g = w.ffn_norm[k]; return true; }
__device__ __forceinline__ bool src_dn(const WSrc& w, int n, int k, const float*& p, float& g) { p = w.w_down + (size_t)k * 1024 + n; g = 1.0f; return true; }

template <int WHICH> __device__ __forceinline__ void wconv_item(const WSrc& w, bf16* WT, int K, int N, LAS float* scr, int item, int lane) {
    const int nblk = N / 32, kb = item / nblk, nb = item % nblk, k0 = 64 * kb, n0 = 32 * nb;
    const int n4 = n0 + 4 * (lane & 7);
    f32x4 vv[8];
#pragma unroll
    for (int i = 0; i < 8; ++i) { const int k = k0 + 8 * i + (lane >> 3); const float* p = nullptr; float g = 0.f; bool ok;
        if (WHICH == 0) ok = src_in(w, n4, k, p, g); else if (WHICH == 1) ok = src_uq(w, n4, k, p, g); else if (WHICH == 2) ok = src_ukv(w, n4, k, p, g); else if (WHICH == 3) ok = src_out(w, n4, k, p, g); else if (WHICH == 4) ok = src_gu(w, n4, k, p, g); else ok = src_dn(w, n4, k, p, g);
        vv[i] = ok ? (CV_NT ? __builtin_nontemporal_load((const GAS f32x4*)p) : *(const GAS f32x4*)p) * g : (f32x4){0.f, 0.f, 0.f, 0.f}; }
#pragma unroll
    for (int i = 0; i < 8; ++i) { LAS float* d = scr + (8 * i + (lane >> 3)) * 33 + 4 * (lane & 7); d[0] = vv[i].x; d[1] = vv[i].y; d[2] = vv[i].z; d[3] = vv[i].w; }
    LDS_WAIT(); asm volatile("" ::: "memory");
    const int c = lane & 7;
#pragma unroll
    for (int j = 0; j < 4; ++j) { const int n = (lane >> 3) + 8 * j; const LAS float* s = scr + (8 * c) * 33 + n;
        v4u o; o.x = pk2(s[0 * 33], s[1 * 33]); o.y = pk2(s[2 * 33], s[3 * 33]); o.z = pk2(s[4 * 33], s[5 * 33]); o.w = pk2(s[6 * 33], s[7 * 33]);
        *(GAS v4u*)(WT + (size_t)(n0 + n) * K + k0 + 8 * c) = o; }
    LDS_WAIT(); asm volatile("" ::: "memory");
}
struct Args;
__device__ __forceinline__ int cv_next(gu32* ctr, int gw, int prev, int NGW, int lane) {
    if (!ctr) return prev < 0 ? gw : prev + NGW;
    if (prev >= 0 && (prev & 1) == 0) return prev + 1;
    unsigned v = 0; if (lane == 0) v = __hip_atomic_fetch_add(ctr, 2u, __ATOMIC_RELAXED, __HIP_MEMORY_SCOPE_AGENT);
    return (int)__builtin_amdgcn_readfirstlane((int)v);
}
__device__ __forceinline__ void convert_group(const __attribute__((address_space(4))) Args* a, unsigned char* ws, int layer, int grp, LAS unsigned char* lds, int gw, int NGW, int wave, int lane, gu32* ctr = nullptr) {
    WSrc w;
    w.w_in = (const float*)a->in[3] + (size_t)layer * 1024 * IN_COLS; w.attn_norm = (const float*)a->in[2] + layer * 1024;
    w.w_uq = (const float*)a->in[10] + (size_t)layer * 256 * 384; w.q_norm = (const float*)a->in[9] + layer * 256;
    w.w_ukv = (const float*)a->in[12] + (size_t)layer * 128 * 512; w.kv_norm = (const float*)a->in[11] + layer * 128;
    w.w_out = (const float*)a->in[15] + (size_t)layer * 1024 * 1024; w.ffn_norm = (const float*)a->in[16] + layer * 1024;
    w.w_gate = (const float*)a->in[17] + (size_t)layer * 1024 * FFH; w.w_up = (const float*)a->in[18] + (size_t)layer * 1024 * FFH; w.w_down = (const float*)a->in[19] + (size_t)layer * FFH * 1024;
    LAS float* scr = (LAS float*)(lds + wave * 16384);
    if (grp == 0) {
        constexpr int I0 = (1024 / 64) * (NIN / 32), I1 = (256 / 64) * (512 / 32), I2 = I1;
        for (int it = cv_next(ctr, gw, -1, NGW, lane); it < I0 + I1 + I2; it = cv_next(ctr, gw, it, NGW, lane)) {
            if (it < I0) wconv_item<0>(w, (bf16*)(ws + WS_WIN), 1024, NIN, scr, it, lane);
            else if (it < I0 + I1) wconv_item<1>(w, (bf16*)(ws + WS_WUQ), 256, 512, scr, it - I0, lane);
            else wconv_item<2>(w, (bf16*)(ws + WS_WUKV), 256, 512, scr, it - I0 - I1, lane);
        }
    } else {
        constexpr int I0 = (1024 / 64) * (1024 / 32), I1 = (1024 / 64) * (NGU / 32), I2 = (FFH / 64) * (1024 / 32);
        for (int it = cv_next(ctr, gw, -1, NGW, lane); it < I0 + I1 + I2; it = cv_next(ctr, gw, it, NGW, lane)) {
            unsigned char* const wd = ws + (W1_EARLY && layer ? WS_W1D : 0);
            if (it < I0) wconv_item<3>(w, (bf16*)(wd + WS_WOUT), 1024, 1024, scr, it, lane);
            else if (it < I0 + I1) wconv_item<4>(w, (bf16*)(wd + WS_WGU), 1024, NGU, scr, it - I0, lane);
            else wconv_item<5>(w, (bf16*)(wd + WS_WDN), FFH, 1024, scr, it - I0 - I1, lane);
        }
    }
}

struct CvItem { const float* base; const float* gv; const float* gp; bf16* WT; int ld, K, k0, n0, c; };
__device__ __forceinline__ void cv1_setup(const WSrc& w, unsigned char* ws, int it, int lane, CvItem& q) {
    constexpr int I0 = (1024 / 64) * (1024 / 32), I1 = (1024 / 64) * (NGU / 32);
    int N, local;
    if (it < I0) { local = it; N = 1024; q.K = 1024; q.WT = (bf16*)(ws + WS_WOUT); q.ld = 1024; q.gv = nullptr; }
    else if (it < I0 + I1) { local = it - I0; N = NGU; q.K = 1024; q.WT = (bf16*)(ws + WS_WGU); q.ld = FFH; q.gv = w.ffn_norm; }
    else { local = it - I0 - I1; N = 1024; q.K = FFH; q.WT = (bf16*)(ws + WS_WDN); q.ld = 1024; q.gv = nullptr; }
    q.gp = w.ffn_norm;
    const int nblk = N / 32, kb = local / nblk, nb = local % nblk; q.k0 = 64 * kb; q.n0 = 32 * nb;
    const int n4 = q.n0 + 4 * (lane & 7);
    if (it < I0) { q.base = w.w_out; q.c = n4; }
    else if (it < I0 + I1) { q.base = ((n4 >> 7) & 1) ? w.w_up : w.w_gate; q.c = 128 * (n4 >> 8) + (n4 & 127); }
    else { q.base = w.w_down; q.c = n4; }
}
__device__ __forceinline__ void cv1_load(const CvItem& q, int lane, f32x4 (&vv)[8], float (&g)[8]) {
#pragma unroll
    for (int i = 0; i < 8; ++i) { const int k = q.k0 + 8 * i + (lane >> 3); vv[i] = __builtin_nontemporal_load((const GAS f32x4*)(q.base + (size_t)k * q.ld + q.c)); const float t_ = q.gp[k & 1023]; g[i] = q.gv ? t_ : 1.0f; }
}
__device__ __forceinline__ void cv1_tile(const CvItem& q, int lane, LAS float* scr, const f32x4 (&vv)[8], const float (&g)[8]) {
#pragma unroll
    for (int i = 0; i < 8; ++i) { LAS float* d = scr + (8 * i + (lane >> 3)) * 33 + 4 * (lane & 7); const f32x4 v = vv[i] * g[i]; d[0] = v.x; d[1] = v.y; d[2] = v.z; d[3] = v.w; }
    LDS_WAIT(); asm volatile("" ::: "memory");
    const int c = lane & 7;
#pragma unroll
    for (int j = 0; j < 4; ++j) { const int n = (lane >> 3) + 8 * j; const LAS float* s_ = scr + (8 * c) * 33 + n;
        v4u o; o.x = pk2(s_[0 * 33], s_[1 * 33]); o.y = pk2(s_[2 * 33], s_[3 * 33]); o.z = pk2(s_[4 * 33], s_[5 * 33]); o.w = pk2(s_[6 * 33], s_[7 * 33]);
        *(GAS v4u*)(q.WT + (size_t)(q.n0 + n) * q.K + q.k0 + 8 * c) = o; }
    LDS_WAIT(); asm volatile("" ::: "memory");
}
__device__ __forceinline__ void convert_grp1_pipe(const __attribute__((address_space(4))) Args* a, unsigned char* ws, int layer, LAS unsigned char* lds, int gw, int NGW, int wave, int lane) {
    WSrc w;
    w.w_out = (const float*)a->in[15] + (size_t)layer * 1024 * 1024; w.ffn_norm = (const float*)a->in[16] + layer * 1024;
    w.w_gate = (const float*)a->in[17] + (size_t)layer * 1024 * FFH; w.w_up = (const float*)a->in[18] + (size_t)layer * 1024 * FFH; w.w_down = (const float*)a->in[19] + (size_t)layer * FFH * 1024;
    LAS float* scr = (LAS float*)(lds + wave * 16384);
    constexpr int TOT = (1024 / 64) * (1024 / 32) + (1024 / 64) * (NGU / 32) + (FFH / 64) * (1024 / 32);
    for (int it = gw; it < TOT; it += 3 * NGW) {
        const bool h1 = it + NGW < TOT, h2 = it + 2 * NGW < TOT;
        CvItem q0, q1, q2; f32x4 v0[8], v1[8], v2[8]; float g0[8], g1[8], g2[8];
        cv1_setup(w, ws, it, lane, q0); cv1_load(q0, lane, v0, g0);
        cv1_setup(w, ws, h1 ? it + NGW : it, lane, q1); cv1_load(q1, lane, v1, g1);
        if (h2) { cv1_setup(w, ws, it + 2 * NGW, lane, q2); cv1_load(q2, lane, v2, g2); }
        cv1_tile(q0, lane, scr, v0, g0);
        cv1_tile(q1, lane, scr, v1, g1);
        if (h2) cv1_tile(q2, lane, scr, v2, g2);
    }
}

typedef const __attribute__((address_space(4))) Args* KArgs;
#define P_(T, OFF) ((T*)(ws + (OFF)))
#ifndef CV_MID_L1
#define CV_MID_L1 1
#endif
#ifndef CV_G0_MID
#define CV_G0_MID 0
#endif
#ifndef CV_PIPE
#define CV_PIPE 1
#endif
#ifndef CV_MID
#define CV_MID 1
#endif
#ifndef M1_DEP
#define M1_DEP 0
#endif
#define ENV() KArgs ap = (KArgs)__builtin_amdgcn_kernarg_segment_ptr(); asm volatile("" : "+s"(ap)); unsigned char* const ws = ap->ws; float* const out = ap->out; (void)out; \
    int tid_o = threadIdx.x; asm volatile("" : "+v"(tid_o)); const int lane_o = tid_o & 63, wave = __builtin_amdgcn_readfirstlane(tid_o >> 6); (void)lane_o; \
    const int G = gridDim.x, bx = blockIdx.x, vcu = (G % 8 == 0) ? (bx % 8) * (G / 8) + bx / 8 : bx, gw = vcu * NWAVES + wave, NGW = G * NWAVES; (void)gw; (void)NGW
#ifndef PROBE_DUP
#define PROBE_DUP 0
#endif
#ifdef PROBE_KV0
#define PROBE_KVARG , (rep == 0 ? 1 : 0)
#else
#define PROBE_KVARG
#endif
#ifndef ATT
#define ATT at3
#endif
#ifndef PROBE_M1S
#define PROBE_M1S 1
#endif
#define NREP(j) (((PROBE_DUP >> (j)) & 1) ? 2 : 1)
__device__ __forceinline__ bool ph_in(int k) { KArgs ap = (KArgs)__builtin_amdgcn_kernarg_segment_ptr(); return ap->ph_lo <= k && k < ap->ph_hi; }
__device__ __forceinline__ void grid_bar(int k, LAS unsigned char* L) {
    if (MK_N_LAUNCHES != 1) return;
    if (!(ph_in(k) && ph_in(k + 1))) return;
    KArgs ap = (KArgs)__builtin_amdgcn_kernarg_segment_ptr();
    XcdBarrier b; b.bar = (unsigned*)(ap->ws + WS_CTL) + CW_BAR; b.x = xb_xcc_id(); b.st = (volatile LAS unsigned*)(L + MISC_OFF) + 8;
    xcd_barrier(b);
#ifdef PROBE_XBAR
    xcd_barrier(b);
#endif
}
template <bool RELEASE> __device__ __forceinline__ void panel_barrier(gu32* cnt, unsigned expected, gu32* tmo) {
    asm volatile("s_waitcnt vmcnt(0)" ::: "memory");
    __syncthreads();
    if (threadIdx.x == 0) {
        if (RELEASE) { __builtin_amdgcn_fence(__ATOMIC_RELEASE, "agent"); asm volatile("s_waitcnt vmcnt(0)" ::: "memory"); }
        (void)__hip_atomic_fetch_add(cnt, 1u, __ATOMIC_RELAXED, __HIP_MEMORY_SCOPE_AGENT);
        __builtin_amdgcn_fence(__ATOMIC_ACQUIRE, "agent");
        unsigned sp = 0;
        while (__hip_atomic_load(cnt, __ATOMIC_RELAXED, __HIP_MEMORY_SCOPE_AGENT) < expected) { __builtin_amdgcn_s_sleep(2);
            if ((++sp & 255u) == 0u) { if (__hip_atomic_load(tmo, __ATOMIC_RELAXED, __HIP_MEMORY_SCOPE_AGENT)) break; if (sp > (1u << 20)) { atomicAdd((unsigned*)tmo, 1u); break; } } }
        asm volatile("s_waitcnt vmcnt(0)" ::: "memory");
    }
    __syncthreads();
}
__device__ __forceinline__ void dep_arrive(gu32* cnt) {
    asm volatile("s_waitcnt vmcnt(0)" ::: "memory");
    __syncthreads();
    if (threadIdx.x == 0) { __builtin_amdgcn_fence(__ATOMIC_RELEASE, "agent"); asm volatile("s_waitcnt vmcnt(0)" ::: "memory"); (void)__hip_atomic_fetch_add(cnt, 1u, __ATOMIC_RELAXED, __HIP_MEMORY_SCOPE_AGENT); }
}
__device__ __forceinline__ void dep_wait(gu32* cnt, unsigned expected, gu32* tmo) {
    asm volatile("s_waitcnt vmcnt(0)" ::: "memory");
    __syncthreads();
    if (threadIdx.x == 0) {
        unsigned sp = 0;
        while (__hip_atomic_load(cnt, __ATOMIC_RELAXED, __HIP_MEMORY_SCOPE_AGENT) < expected) { __builtin_amdgcn_s_sleep(2);
            if ((++sp & 255u) == 0u) { if (__hip_atomic_load(tmo, __ATOMIC_RELAXED, __HIP_MEMORY_SCOPE_AGENT)) break; if (sp > (1u << 20)) { atomicAdd((unsigned*)tmo, 1u); break; } } }
        __builtin_amdgcn_fence(__ATOMIC_ACQUIRE, "agent");
        asm volatile("s_waitcnt vmcnt(0)" ::: "memory");
    }
    __syncthreads();
}
template <class Sched> __device__ __forceinline__ void prep_row_scales(const Sched& S_, const float* ssq, float inv_n, LAS unsigned char* L) {
    Sched S = S_; asm volatile("" : "+s"(S.c));
    LAS float* tab = (LAS float*)(L + RS_OFF); int t = threadIdx.x; asm volatile("" : "+v"(t));
    if (t < 256) {
        f32x4 v[8]; bool ok[8];
#pragma unroll
        for (int i = 0; i < 8; ++i) { pg8::Unit u; ok[i] = S.next(i, u); if (ok[i]) v[i] = *(const GAS f32x4*)(ssq + (size_t)(u.pm * 256 + t) * 4); }
#pragma unroll
        for (int i = 0; i < 8; ++i) if (ok[i]) tab[i * 256 + t] = 1.0f / sqrtf(((v[i].x + v[i].y) + (v[i].z + v[i].w)) * inv_n + NORM_EPS);
    }
    __syncthreads();
}
__global__ void __launch_bounds__(NWAVES * 64, 2) hyb_fwd(Args args) {
    extern __shared__ __attribute__((aligned(16))) unsigned char lds[];
    LAS unsigned char* L = (LAS unsigned char*)lds;
    volatile LAS unsigned* MISC = (volatile LAS unsigned*)(L + MISC_OFF);
    for (int u = threadIdx.x; u < (LDS_BYTES - LDSCTL_OFF) / 4; u += NWAVES * 64) ((LAS unsigned*)(L + LDSCTL_OFF))[u] = 0u;
    __syncthreads();
    if (MK_N_LAUNCHES == 1) { (void)xcd_barrier_post((unsigned*)(args.ws + WS_CTL) + CW_BAR, MISC + 8); }

    if (ph_in(0)) for (int rep = 0; rep < NREP(7); ++rep) {
        { ENV(); convert_group(ap, ws, 0, 0, L, gw, NGW, wave, lane_o); }
        { ENV(); if (!(CV_MID && gridDim.x == 256)) convert_group(ap, ws, 0, 1, L, gw, NGW, wave, lane_o); }
        { ENV(); const float* x_in = (const float*)ap->in[0]; bf16* XB = P_(bf16, WS_XB); float* SSQ = P_(float, WS_SSQ);
          for (int m = gw; m < MTOK; m += 2 * NGW) {
            f32x4 v[2][4]; float s[2];
#pragma unroll
            for (int k = 0; k < 2; ++k) { const GAS f32x4* xr = (const GAS f32x4*)(x_in + (size_t)(m + k * NGW) * DMODEL) + lane_o;
#pragma unroll
                for (int j = 0; j < 4; ++j) v[k][j] = __builtin_nontemporal_load(xr + 64 * j); }
#pragma unroll
            for (int k = 0; k < 2; ++k) { GAS unsigned long long* o8 = (GAS unsigned long long*)(XB + (size_t)(m + k * NGW) * DMODEL) + lane_o; s[k] = 0.f;
#pragma unroll
                for (int j = 0; j < 4; ++j) { const f32x4 w = v[k][j]; s[k] += (w.x * w.x + w.y * w.y) + (w.z * w.z + w.w * w.w); o8[64 * j] = (unsigned long long)pk2(w.x, w.y) | ((unsigned long long)pk2(w.z, w.w) << 32); }
                s[k] = wave_sum(s[k]);
                if (lane_o == 0) *(GAS f32x4*)(SSQ + (size_t)(m + k * NGW) * 4) = (f32x4){s[k], 0.f, 0.f, 0.f}; }
          } }
        { ENV(); const int* pos = (const int*)ap->in[1]; float* T64 = P_(float, WS_T64); float* TM = P_(float, WS_TM);
          for (int i = bx * (NWAVES * 64) + tid_o; i < MTOK * 32; i += G * NWAVES * 64) {
            const int row = i >> 5, f = i & 31; const float ang = (float)pos[row] * INVF[f];
            const double ad = (double)ang, kd = __builtin_rint(ad * 0.15915494309189535), rd = __builtin_fma(-kd, 6.283185307179586, ad);
            const float rev = (float)(rd * 0.15915494309189535), sn = __builtin_amdgcn_sinf(rev), cs = __builtin_amdgcn_cosf(rev);
            T64[(size_t)row * 64 + f] = cs; T64[(size_t)row * 64 + 32 + f] = sn;
            if ((f & 1) == 0) { TM[(size_t)row * 32 + (f >> 1)] = cs; TM[(size_t)row * 32 + 16 + (f >> 1)] = sn; }
          } }
    }
    grid_bar(0, L);

#pragma unroll 1
    for (int layer = 0; layer < DEPTH; ++layer) {
        const int P = 1 + 7 * layer;
        if (ph_in(P)) {
            ENV();
            pg8::Gemm g{P_(bf16, WS_XB), P_(const bf16, WS_WIN), MTOK, NIN, DMODEL}; pg8::StaticOrder S; S.init(MTOK, NIN, G, bx);
            prep_row_scales(S, P_(const float, WS_SSQ), 1.0f / 1024.0f, L);
            pg8::EpiG1 E{ws, layer, (const LAS float*)(L + RS_OFF)};
            for (int rep = 0; rep < NREP(0); ++rep) pg8::gemm_phase<pg8::EpiG1, pg8::StaticOrder, true, true>(L, g, S, E);
        }
        grid_bar(P, L);
        if (ph_in(P + 1)) {
            for (int rep = 0; rep < NREP(1); ++rep) {
            { ENV(); int K1 = 256; asm volatile("" : "+s"(K1));
              pg8::Gemm g{P_(bf16, WS_CQ), P_(const bf16, WS_WUQ), MTOK, 512, K1}; pg8::StaticOrder S; S.init(MTOK, 512, G, bx);
              pg8::EpiMQ E{ws}; pg8::gemm_phase<pg8::EpiMQ, pg8::StaticOrder, true, true>(L, g, S, E); }
            { ENV(); int K1 = 256; asm volatile("" : "+s"(K1));
              pg8::Gemm g{P_(bf16, WS_CKV), P_(const bf16, WS_WUKV), MTOK, 512, K1}; pg8::StaticOrder S; S.init(MTOK, 512, G, (bx + G / 2) % G);
              pg8::EpiMKV E{ws}; pg8::gemm_phase<pg8::EpiMKV, pg8::StaticOrder, true, true>(L, g, S, E); }
            for (int rs_ = 0; rs_ < PROBE_M1S; ++rs_) { ENV(); for (int u = bx; u < 256; u += G) ret::state_item(P_(bf16, WS_RK), P_(bf16, WS_RV), P_(float, WS_AST), u >> 7, (u >> 5) & 3, u & 31, (char*)lds); }
            }
        }
        const bool m1dep = M1_DEP && MK_N_LAUNCHES == 1 && gridDim.x == 256 && ph_in(P + 1) && ph_in(P + 2);
        if (m1dep) { ENV(); dep_arrive((gu32*)(ws + WS_CTL) + CW_KM + layer * 64); } else grid_bar(P + 1, L);
        bool m1ok = !m1dep;
#define M1_WAIT() do { if (!m1ok) { ENV(); dep_wait((gu32*)(ws + WS_CTL) + CW_KM + layer * 64, 256u, (gu32*)(ws + WS_CTL) + CW_TMO); m1ok = true; } } while (0)
        if (ph_in(P + 2)) {
            for (int rep = 0; rep < NREP(2); ++rep) {
            const unsigned myx = xb_xcc_id() & 7u;
            unsigned utag = 0u;
            const bool cvmid = CV_MID && gridDim.x == 256 && !(W1_EARLY && layer == 1) && (CV_MID_L1 || layer == 0); bool cvdone = !cvmid, started = false;
            for (unsigned s = 0; s < 8; ++s) { const unsigned xq = (myx + s) & 7u;
                gu32* qp; { ENV(); qp = (gu32*)(ws + WS_CTL) + CW_Q + layer * 1024 + rep * 512 + 64 * xq; }
#define POP_SYNC() do { int t0_ = threadIdx.x; asm volatile("" : "+v"(t0_)); __syncthreads(); if (t0_ == 0) MISC[0] = __hip_atomic_fetch_add(qp, 1u, __ATOMIC_RELAXED, __HIP_MEMORY_SCOPE_AGENT); __syncthreads(); idx = (unsigned)__builtin_amdgcn_readfirstlane((int)MISC[0]); } while (0)
                unsigned idx; POP_SYNC();
                while (idx < 128u) {
                    ENV();
                    if (!cvdone && started) { __syncthreads(); if (CV_PIPE) convert_grp1_pipe(ap, ws, layer, L, gw, NGW, wave, lane_o); else convert_group(ap, ws, layer, 1, L, gw, NGW, wave, lane_o); if (CV_G0_MID && layer == 0) convert_group(ap, ws, 1, 0, L, gw, NGW, wave, lane_o); __syncthreads(); cvdone = true; }
                    started = true;
                    if (idx >= 96u) { M1_WAIT(); ret::ret_unit(P_(bf16, WS_RQ), P_(bf16, WS_RK), P_(bf16, WS_RV), P_(bf16, WS_RG), P_(float, WS_AST), (const float*)ap->in[13] + layer * 256, (const float*)ap->in[14] + layer * 256,
                                                    P_(bf16, WS_MIX), (int)(xq >> 2), (int)(xq & 3u), 127 - (int)idx, (char*)lds); POP_SYNC(); continue; }
                    const int qb = 31 - (int)(idx / 3u), kind = (int)(idx % 3u), b = (int)(xq >> 2), head = (int)(xq & 3u);
                    const size_t r0 = (size_t)b * SEQ, rq = r0 + 256 * qb;
                    ++utag;
                    if (kind < 2) { const bf16* q_ = P_(bf16, WS_DQ) + rq * 512 + head * 128 + kind * 64; const bf16* k_ = P_(bf16, WS_DK) + r0 * 512 + head * 128 + kind * 64; const bf16* v_ = P_(bf16, WS_DV) + r0 * 512 + head * 128;
                        bf16* o_ = (bf16*)out + rq * 1024 + head * 256 + kind * 128;
                        idx = ATT::attn_unit<64, 128, 512, 512, 512, 1024, 1>(q_, k_, v_, o_, qb, (char*)lds, qp, MISC, nullptr, 0.f, utag);
                        if (idx & 0x80000000u) { idx &= 0x7fffffffu; (void)ATT::attn_unit<64, 128, 512, 512, 512, 1024, 0>(q_, k_, v_, o_, qb, (char*)lds, nullptr, MISC); } }
                    else { M1_WAIT(); const bf16* q_ = P_(bf16, WS_MQ) + rq * 384 + head * 96; const bf16* k_ = P_(bf16, WS_MK) + r0 * 384 + head * 96; const bf16* v_ = P_(bf16, WS_MV) + r0 * 256 + head * 64; bf16* o_ = P_(bf16, WS_MIX) + rq * 1024 + 512 + head * 64;
                        idx = ATT::attn_unit<96, 64, 384, 384, 256, 1024, 1>(q_, k_, v_, o_, qb, (char*)lds, qp, MISC, nullptr, 0.f, utag);
                        if (idx & 0x80000000u) { idx &= 0x7fffffffu; (void)ATT::attn_unit<96, 64, 384, 384, 256, 1024, 0>(q_, k_, v_, o_, qb, (char*)lds, nullptr, MISC); } }
                } }
            { ENV(); if (cvmid || (W1_EARLY && layer == 1 && G == 256)) { if (!cvdone) { __syncthreads(); convert_group(ap, ws, layer, 1, L, gw, NGW, wave, lane_o); if (CV_G0_MID && layer == 0) convert_group(ap, ws, 1, 0, L, gw, NGW, wave, lane_o); } }
              else if (layer == 1 || G != 256) convert_group(ap, ws, 1, layer == 0 ? 0 : 1, L, gw, NGW, wave, lane_o); }
            }
        }
        grid_bar(P + 2, L);
        if (ph_in(P + 4)) {
            ENV();
            pg8::Gemm g{P_(bf16, WS_MIX), P_(const bf16, WS_WOUT + (W1_EARLY && layer ? WS_W1D : 0)), MTOK, DMODEL, DMODEL}; pg8::StaticOrder S; S.init(MTOK, DMODEL, G, bx);
            if (G == 256) {
                pg8::Unit u0; (void)S.next(0, u0);
                { const float s1 = wave_sum(((const float*)ap->in[4])[layer * 64 + lane_o] * ((const float*)ap->in[5])[layer * 64 + lane_o]), s2 = wave_sum(((const float*)ap->in[6])[layer * 64 + lane_o] * ((const float*)ap->in[7])[layer * 64 + lane_o]);
                  const float lam_init = layer == 0 ? 0.2f : 0.35550906759096934f, lam = __builtin_amdgcn_exp2f(s1 * LOG2E) - __builtin_amdgcn_exp2f(s2 * LOG2E) + lam_init;
                  const float* subln = (const float*)ap->in[8] + layer * 128;
                  const size_t r0 = (size_t)u0.pm * 256 + (size_t)u0.pn * 64 + (size_t)wave * 8;
                  ret::combine_rows4((const bf16*)out, subln, lam, 1.0f - lam_init, P_(bf16, WS_MIX), r0, (size_t)1, lane_o);
                  ret::combine_rows4((const bf16*)out, subln, lam, 1.0f - lam_init, P_(bf16, WS_MIX), r0 + 4, (size_t)1, lane_o); }
                panel_barrier<false>((gu32*)(ws + WS_CTL) + CW_P + (layer * 64 + u0.pm) * 64, 4u, (gu32*)(ws + WS_CTL) + CW_TMO);
                pg8::EpiRes E{ws, 0, 0, nullptr, nullptr};
                for (int rep = 0; rep < NREP(4); ++rep) { E.dry = rep; pg8::gemm_phase<pg8::EpiRes, pg8::StaticOrder, false, true>(L, g, S, E); }
            }
        }
        grid_bar(P + 4, L);
        if (ph_in(P + 5)) {
            ENV();
            pg8::Gemm g{P_(bf16, WS_XB), P_(const bf16, WS_WGU + (W1_EARLY && layer ? WS_W1D : 0)), MTOK, NGU, DMODEL}; pg8::StaticOrder S; S.init(MTOK, NGU, G, bx);
            prep_row_scales(S, P_(const float, WS_SSQ), 1.0f / 1024.0f, L);
            pg8::EpiGU E{ws, (const LAS float*)(L + RS_OFF)};
            for (int rep = 0; rep < NREP(5); ++rep) pg8::gemm_phase<pg8::EpiGU, pg8::StaticOrder, true, true>(L, g, S, E);
            if (layer == 0 && G == 256 && bx >= 128 && !(CV_G0_MID && CV_MID)) { convert_group(ap, ws, 1, 0, L, (bx - 128) * NWAVES + wave, 128 * NWAVES, wave, lane_o); if (W1_EARLY) convert_group(ap, ws, 1, 1, L, (bx - 128) * NWAVES + wave, 128 * NWAVES, wave, lane_o); }
        }
        grid_bar(P + 5, L);
        if (ph_in(P + 6)) {
            ENV();
            pg8::Gemm g{P_(bf16, WS_H), P_(const bf16, WS_WDN + (W1_EARLY && layer ? WS_W1D : 0)), MTOK, DMODEL, FFH}; pg8::StaticOrder S; S.init(MTOK, DMODEL, G, bx);
            const bool ffin = layer == 1 && G == 256 && ph_in(15);
            pg8::EpiRes E{ws, 0, ffin ? 1 : 0, (const float*)ap->in[20], out};
            if (G == 256) for (int rep = 0; rep < NREP(6); ++rep) { E.dry = rep; pg8::gemm_phase<pg8::EpiRes, pg8::StaticOrder, false, true>(L, g, S, E); }
        }
        if (!(layer == 1 && gridDim.x == 256 && ph_in(P + 6))) grid_bar(P + 6, L);
    }
    if (ph_in(15) && !(gridDim.x == 256 && ph_in(14))) {
        for (int rep = NREP(8) - 1; rep >= 0; --rep) {
        ENV(); const float* fn = (const float*)ap->in[20]; const float* SSQ = P_(float, WS_SSQ);
        for (int m = gw; m < MTOK; m += 2 * NGW) {
            bf16x8 v[2][2]; f32x4 s4[2];
#pragma unroll
            for (int k = 0; k < 2; ++k) { const bf16* xr = P_(bf16, WS_XB) + (size_t)(m + k * NGW) * DMODEL + 8 * lane_o; s4[k] = *(const f32x4*)(SSQ + (size_t)(m + k * NGW) * 4);
                v[k][0] = *(const bf16x8*)xr; v[k][1] = *(const bf16x8*)(xr + 512); }
#pragma unroll
            for (int k = 0; k < 2; ++k) { float* orow = out + (size_t)(m + k * NGW) * DMODEL + 8 * lane_o;
                const float rs = 1.0f / sqrtf(((s4[k][0] + s4[k][1]) + (s4[k][2] + s4[k][3])) * (1.0f / 1024.0f) + NORM_EPS);
#pragma unroll
                for (int hh = 0; hh < 2; ++hh) { const f32x4 g0 = *(const f32x4*)(fn + hh * 512 + 8 * lane_o), g1 = *(const f32x4*)(fn + hh * 512 + 8 * lane_o + 4); const bf16x8 b = v[k][hh];
                    const f32x4 w0 = {at::bf2f(b[0]) * rs * g0[0], at::bf2f(b[1]) * rs * g0[1], at::bf2f(b[2]) * rs * g0[2], at::bf2f(b[3]) * rs * g0[3]}, w1 = {at::bf2f(b[4]) * rs * g1[0], at::bf2f(b[5]) * rs * g1[1], at::bf2f(b[6]) * rs * g1[2], at::bf2f(b[7]) * rs * g1[3]};
                    if (rep == 0) { *(f32x4*)(orow + hh * 512) = w0; *(f32x4*)(orow + hh * 512 + 4) = w1; } } }
        }
        }
    }
}

extern "C" void kernel_launch(void* const* d_in, const int* in_sizes, int n_in, void* d_out, int out_size, void* d_ws, size_t ws_size, hipStream_t stream) {
    static int grid = 0;
    if (grid == 0) {
        if (n_in != 21 || in_sizes[0] != MTOK * DMODEL || out_size != MTOK * DMODEL || ws_size < WS_END) { fprintf(stderr, "kernel_launch: unexpected shapes (n_in %d, in0 %d, out %d, ws %zu)\n", n_in, n_in > 0 ? in_sizes[0] : -1, out_size, ws_size); grid = -1; return; }
        int dev = 0, cus = 0, per_cu = 0;
        if (hipGetDevice(&dev) != hipSuccess || hipDeviceGetAttribute(&cus, hipDeviceAttributeMultiprocessorCount, dev) != hipSuccess) { grid = -1; return; }
        if (hipFuncSetAttribute((const void*)hyb_fwd, hipFuncAttributeMaxDynamicSharedMemorySize, LDS_BYTES) != hipSuccess) { fprintf(stderr, "kernel_launch: hipFuncSetAttribute failed\n"); grid = -1; return; }
        if (hipOccupancyMaxActiveBlocksPerMultiprocessor(&per_cu, (const void*)hyb_fwd, NWAVES * 64, LDS_BYTES) != hipSuccess) per_cu = 0;
        (void)hipGetLastError();
        if (per_cu < 1 || cus * per_cu < 256) { fprintf(stderr, "kernel_launch: %d CUs x %d resident workgroups cannot hold the 256-workgroup grid\n", cus, per_cu); grid = -1; return; }
        grid = 256;
    }
    if (grid < 0) return;
    (void)hipMemsetAsync((char*)d_ws + WS_CTL, 0, CTL_ZERO_BYTES, stream);
    Args a{};
    for (int i = 0; i < 21; ++i) a.in[i] = d_in[i];
    a.out = (float*)d_out; a.ws = (unsigned char*)d_ws;
    if (MK_N_LAUNCHES == 1) { a.ph_lo = 0; a.ph_hi = N_PHASES; hipLaunchKernelGGL(hyb_fwd, dim3(grid), dim3(NWAVES * 64), LDS_BYTES, stream, a); }
    else for (int p = 0; p < N_PHASES; ++p) { a.ph_lo = p; a.ph_hi = p + 1; hipLaunchKernelGGL(hyb_fwd, dim3(grid), dim3(NWAVES * 64), LDS_BYTES, stream, a); }
}
```
